# Optimizing an MI355X kernel written in HIP

```python
import jax, jax.numpy as jnp
from jax import lax
import numpy as np

D_MODEL = 2048
BATCH = 4
SEQ = 4096
DEPTH = 4

MEM_LEN = 256
G_CHUNK = 128
G_GROUPS = 8
G_GROUP_DIM = D_MODEL // 16
G_WIDTH = G_GROUPS * G_GROUP_DIM
M_HEADS = 4
M_QK_DIM = D_MODEL // 8
M_V_DIM = D_MODEL // 4
M_QK_WIDTH = M_HEADS * M_QK_DIM
M_V_WIDTH = M_HEADS * M_V_DIM
M_CHUNK = 64
M_CONV = 4
X_HEADS = 4
X_HEAD_DIM = D_MODEL // 8
X_WIDTH = X_HEADS * X_HEAD_DIM
N_BRANCH = 3
D_FF = ((-(-8 * D_MODEL // 3) + 255) // 256) * 256
ALPHA = (2 * DEPTH) ** 0.25
BETA = (8 * DEPTH) ** -0.25
IN_SPLITS = (G_WIDTH, G_WIDTH, 2 * M_QK_WIDTH, M_V_WIDTH, M_V_WIDTH,
             M_HEADS, M_HEADS, X_WIDTH, N_BRANCH * D_MODEL)
IN_WIDTH = sum(IN_SPLITS)
IN_OFFSETS = tuple(int(o) for o in np.cumsum(IN_SPLITS)[:-1])
F_GATE_OFFSET = sum(IN_SPLITS[:6])
LN_EPS = 1e-5

kernel_name = 'gmlp_mlstm_memxattn_deepnorm_hybrid'


def layer_norm(x, g, b):
    xf = x.astype(jnp.float32)
    mu = jnp.mean(xf, -1, keepdims=True)
    var = jnp.mean(jnp.square(xf - mu), -1, keepdims=True)
    return ((xf - mu) * lax.rsqrt(var + LN_EPS) * g + b).astype(x.dtype)


def head_norm(h):
    hf = h.astype(jnp.float32)
    mu = jnp.mean(hf, -1, keepdims=True)
    var = jnp.mean(jnp.square(hf - mu), -1, keepdims=True)
    return (hf - mu) * lax.rsqrt(var + LN_EPS)


def causal_depthwise_conv(x, w, b):
    k = w.shape[0]
    y = lax.conv_general_dilated(x, w[:, None, :], window_strides=(1,),
                                 padding=[(k - 1, 0)],
                                 dimension_numbers=('NWC', 'WIO', 'NWC'),
                                 feature_group_count=x.shape[-1])
    return y + b


def chunked_spatial_gating(u, v, ln_g, ln_b, w_s, b_s):
    B, S, _ = v.shape
    v = layer_norm(v, ln_g, ln_b)
    vc = v.reshape(B, S // G_CHUNK, G_CHUNK, G_GROUPS, G_GROUP_DIM)
    causal = jnp.tril(jnp.ones((G_CHUNK, G_CHUNK), dtype=bool))
    w = jnp.where(causal, w_s, 0)
    mixed = jnp.einsum('gts,bcsgd->bctgd', w, vc) + b_s.T[None, None, :, :, None]
    return u * mixed.reshape(B, S, G_WIDTH)


def mlstm_chunkwise(q, k, v, i_pre, f_pre):
    B, S, H, dk = q.shape
    dv = v.shape[-1]
    L = M_CHUNK
    NC = S // L
    f32 = jnp.float32

    def to_chunks(t):
        t = t.astype(f32).reshape((B, NC, L, H) + t.shape[3:])
        return jnp.moveaxis(t, (1, 3), (0, 2))

    qc = to_chunks(q)
    kc = to_chunks(k) * (dk ** -0.5)
    vc = to_chunks(v)
    ic = to_chunks(i_pre)
    lfc = to_chunks(jax.nn.log_sigmoid(f_pre.astype(f32)))
    causal = jnp.tril(jnp.ones((L, L), dtype=bool))

    def step(carry, xs):
        C, n, m = carry
        qb, kb, vb, ib, lfb = xs
        b = jnp.cumsum(lfb, axis=-1)
        D = jnp.where(causal, b[..., :, None] - b[..., None, :] + ib[..., None, :], -jnp.inf)
        m_inter = b + m[..., None]
        m_row = jnp.maximum(jnp.max(D, -1), m_inter)
        P = jnp.exp(D - m_row[..., None]) * jnp.einsum('bhtk,bhsk->bhts', qb, kb)
        w_inter = jnp.exp(m_inter - m_row)
        num = (jnp.einsum('bhts,bhsv->bhtv', P, vb)
               + w_inter[..., None] * jnp.einsum('bhtk,bhkv->bhtv', qb, C))
        den = jnp.sum(P, -1) + w_inter * jnp.einsum('bhtk,bhk->bht', qb, n)
        h = num / jnp.maximum(jnp.abs(den), jnp.exp(-m_row))[..., None]
        b_last = b[..., -1]
        g = b_last[..., None] - b + ib
        m_new = jnp.maximum(b_last + m, jnp.max(g, -1))
        w_state = jnp.exp(g - m_new[..., None])
        decay = jnp.exp(b_last + m - m_new)
        C = decay[..., None, None] * C + jnp.einsum('bhs,bhsk,bhsv->bhkv', w_state, kb, vb)
        n = decay[..., None] * n + jnp.einsum('bhs,bhsk->bhk', w_state, kb)
        return (C, n, m_new), h

    init = (jnp.zeros((B, H, dk, dv), f32), jnp.zeros((B, H, dk), f32), jnp.zeros((B, H), f32))
    _, h = lax.scan(step, init, (qc, kc, vc, ic, lfc))
    return jnp.moveaxis(h, (0, 2), (1, 3)).reshape(B, S, H, dv)


def memory_cross_attention(q, k, v):
    s = jnp.einsum('bshd,bmhd->bhsm', q, k).astype(jnp.float32) * (q.shape[-1] ** -0.5)
    p = jax.nn.softmax(s, axis=-1).astype(v.dtype)
    return jnp.einsum('bhsm,bmhd->bshd', p, v)


def token_mixer(x, mem_n, w_in, b_in, g_ln_g, g_ln_b, g_ws, g_bs, m_conv_w, m_conv_b,
                m_norm_g, x_w_kv, w_pa, w_pb, w_pc, w_out):
    B, S, _ = x.shape
    z = x @ w_in + b_in
    zu, zv, zqk, zvm, zo, zi, zf, zqx, zg = jnp.split(z, IN_OFFSETS, axis=-1)
    y_a = chunked_spatial_gating(jax.nn.gelu(zu), jax.nn.gelu(zv), g_ln_g, g_ln_b, g_ws, g_bs)
    qk = jax.nn.silu(causal_depthwise_conv(zqk, m_conv_w, m_conv_b))
    q_m, k_m = jnp.split(qk, 2, axis=-1)
    h = mlstm_chunkwise(q_m.reshape(B, S, M_HEADS, M_QK_DIM), k_m.reshape(B, S, M_HEADS, M_QK_DIM),
                        zvm.reshape(B, S, M_HEADS, M_V_DIM), zi, zf)
    h = head_norm(h).reshape(B, S, M_V_WIDTH) * m_norm_g
    y_b = (jax.nn.sigmoid(zo) * h).astype(x.dtype)
    k_x, v_x = jnp.split(mem_n @ x_w_kv, 2, axis=-1)
    y_c = memory_cross_attention(zqx.reshape(B, S, X_HEADS, X_HEAD_DIM),
                                 k_x.reshape(B, -1, X_HEADS, X_HEAD_DIM),
                                 v_x.reshape(B, -1, X_HEADS, X_HEAD_DIM)).reshape(B, S, X_WIDTH)
    gates = jax.nn.sigmoid(zg).reshape(B, S, N_BRANCH, D_MODEL)
    merged = (gates[:, :, 0] * (y_a @ w_pa) + gates[:, :, 1] * (y_b @ w_pb)
              + gates[:, :, 2] * (y_c @ w_pc))
    return merged @ w_out


def swiglu_ffn(x, w_gu, w_down):
    gate, up = jnp.split(x @ w_gu, 2, axis=-1)
    return (jax.nn.silu(gate) * up) @ w_down


def setup_inputs(seed: int = 0) -> dict:
    key = jax.random.key(seed)
    keys = iter(jax.random.split(key, 32))
    L = DEPTH

    def nrm(shape, scale):
        return scale * jax.random.normal(next(keys), shape, jnp.float32)

    x = nrm((BATCH, SEQ, D_MODEL), 1.0)
    mem = nrm((BATCH, MEM_LEN, D_MODEL), 1.0)
    mem_ln_g = 1.0 + nrm((D_MODEL,), 0.02)
    mem_ln_b = nrm((D_MODEL,), 0.02)
    w_in = nrm((L, D_MODEL, IN_WIDTH), D_MODEL ** -0.5)
    b_in = nrm((L, IN_WIDTH), 0.02)
    f_bias = jnp.linspace(3.0, 6.0, M_HEADS, dtype=jnp.float32)
    b_in = b_in.at[:, F_GATE_OFFSET:F_GATE_OFFSET + M_HEADS].add(f_bias)
    g_ln_g = 1.0 + nrm((L, G_WIDTH), 0.02)
    g_ln_b = nrm((L, G_WIDTH), 0.02)
    g_ws = nrm((L, G_GROUPS, G_CHUNK, G_CHUNK), G_CHUNK ** -0.5)
    g_bs = 1.0 + nrm((L, G_GROUPS, G_CHUNK), 0.02)
    m_conv_w = nrm((L, M_CONV, 2 * M_QK_WIDTH), M_CONV ** -0.5)
    m_conv_b = nrm((L, 2 * M_QK_WIDTH), 0.02)
    m_norm_g = 1.0 + nrm((L, M_V_WIDTH), 0.02)
    x_w_kv = nrm((L, D_MODEL, 2 * X_WIDTH), D_MODEL ** -0.5)
    w_pa = nrm((L, G_WIDTH, D_MODEL), G_WIDTH ** -0.5)
    w_pb = nrm((L, M_V_WIDTH, D_MODEL), M_V_WIDTH ** -0.5)
    w_pc = nrm((L, X_WIDTH, D_MODEL), X_WIDTH ** -0.5)
    w_out = nrm((L, D_MODEL, D_MODEL), BETA * D_MODEL ** -0.5)
    ln1_g = 1.0 + nrm((L, D_MODEL), 0.02)
    ln1_b = nrm((L, D_MODEL), 0.02)
    w_gu = nrm((L, D_MODEL, 2 * D_FF), D_MODEL ** -0.5)
    w_down = nrm((L, D_FF, D_MODEL), BETA * D_FF ** -0.5)
    ln2_g = 1.0 + nrm((L, D_MODEL), 0.02)
    ln2_b = nrm((L, D_MODEL), 0.02)
    return {'x': x, 'mem': mem, 'mem_ln_g': mem_ln_g, 'mem_ln_b': mem_ln_b,
            'w_in': w_in, 'b_in': b_in, 'g_ln_g': g_ln_g, 'g_ln_b': g_ln_b,
            'g_ws': g_ws, 'g_bs': g_bs, 'm_conv_w': m_conv_w, 'm_conv_b': m_conv_b,
            'm_norm_g': m_norm_g, 'x_w_kv': x_w_kv, 'w_pa': w_pa, 'w_pb': w_pb,
            'w_pc': w_pc, 'w_out': w_out, 'ln1_g': ln1_g, 'ln1_b': ln1_b,
            'w_gu': w_gu, 'w_down': w_down, 'ln2_g': ln2_g, 'ln2_b': ln2_b}


def reference(x, mem, mem_ln_g, mem_ln_b, w_in, b_in, g_ln_g, g_ln_b, g_ws, g_bs,
              m_conv_w, m_conv_b, m_norm_g, x_w_kv, w_pa, w_pb, w_pc, w_out,
              ln1_g, ln1_b, w_gu, w_down, ln2_g, ln2_b):
    mem_n = layer_norm(mem, mem_ln_g, mem_ln_b)
    for l in range(DEPTH):
        mix = token_mixer(x, mem_n, w_in[l], b_in[l], g_ln_g[l], g_ln_b[l], g_ws[l], g_bs[l],
                          m_conv_w[l], m_conv_b[l], m_norm_g[l], x_w_kv[l],
                          w_pa[l], w_pb[l], w_pc[l], w_out[l])
        x = layer_norm(ALPHA * x + mix, ln1_g[l], ln1_b[l])
        x = layer_norm(ALPHA * x + swiglu_ffn(x, w_gu[l], w_down[l]), ln2_g[l], ln2_b[l])
    return x
```

```cpp
#include <hip/hip_runtime.h>
#include <cstdio>
#include <cstdint>

#ifndef MK_PER_PHASE
#define MK_PER_PHASE 0
#endif

#define LAS __attribute__((address_space(3)))
#define GAS __attribute__((address_space(1)))
typedef unsigned short bf16_t;
typedef short bf16x8 __attribute__((ext_vector_type(8)));
typedef float f32x4 __attribute__((ext_vector_type(4)));
typedef float f32x2 __attribute__((ext_vector_type(2)));
typedef unsigned u32x4 __attribute__((ext_vector_type(4)));
typedef unsigned u32x2 __attribute__((ext_vector_type(2)));

constexpr int T = 16384, D = 2048, SEQ = 4096, NBATCH = 4, DEPTH = 4, MEMLEN = 256;
constexpr int INW = 15368, ZW = 15360, FF = 5632;
constexpr int ZU = 0, ZV = 1024, ZQK = 2048, ZVM = 4096, ZO = 6144, ZQX = 8192, ZG = 9216;
constexpr int SRC_GATE = 8192;
constexpr float LN_EPS = 1e-5f;
constexpr float ALPHA = 1.681792830507429f;

constexpr size_t MiB = 1u << 20;
constexpr size_t WS_CTL = 0, CTL_ZERO_BYTES = 1 * MiB;
constexpr size_t WS_WG = 1 * MiB;
constexpr size_t WS_BIN = 2 * MiB;
constexpr size_t WS_GATES = 3 * MiB;
constexpr size_t WS_STAT = 3 * MiB + 512 * 1024;
constexpr size_t WS_MEMN = 4 * MiB;
constexpr size_t WS_KMEM = 8 * MiB;
constexpr size_t WS_VMEM = 16 * MiB;
constexpr size_t WS_PAR = 24 * MiB;
constexpr int PAR_GWS = 0, PAR_GLNG = 524288, PAR_GLNB = 528384, PAR_GBS = 532480, PAR_CONVW = 536576, PAR_CONVB = 569344, PAR_MNG = 577536,
              PAR_LN1G = 585728, PAR_LN1B = 593920, PAR_LN2G = 602112, PAR_LN2B = 610304, PAR_GBIAS = 618496, PAR_ONE = 618528, PAR_ZERO = 620576, PAR_BQ = 622624, PAR_END = 626720;
constexpr size_t WS_WF32 = 28 * MiB;
constexpr size_t WS_C2 = 30 * MiB;
constexpr size_t WS_WKT = 32 * MiB;
constexpr size_t WS_WVT = 48 * MiB;
constexpr size_t WS_WL = 64 * MiB;
constexpr size_t WL_STRIDE = 150 * MiB;
constexpr size_t WL_IN = 0, WL_GU = 60 * MiB, WL_DN = 104 * MiB, WL_PA = 126 * MiB, WL_PB = 130 * MiB, WL_PC = 138 * MiB, WL_OUT = 142 * MiB;
constexpr size_t WS_XF = 664 * MiB;
constexpr size_t WS_PF = 792 * MiB;
constexpr size_t WS_XB = 920 * MiB;
constexpr size_t WS_Z = 984 * MiB;
constexpr size_t WS_MRG = 1464 * MiB;
constexpr size_t WS_WQK = 1528 * MiB;
constexpr size_t WS_VW01 = 1592 * MiB;
constexpr size_t WS_VW23 = 32 * MiB;
constexpr size_t WS_WQN = 984 * MiB;
constexpr size_t WS_BQK = 3 * MiB + 768 * 1024;
constexpr size_t WS_HRAW = 1624 * MiB;
constexpr size_t WS_QF = 1752 * MiB;
constexpr size_t WS_KF = 1784 * MiB;
constexpr size_t WS_PFR = 1816 * MiB;
constexpr size_t WS_VF = 1824 * MiB;
constexpr size_t WS_GS = 1888 * MiB;
constexpr int GS_BCUM = 0, GS_BV = 65536, GS_PMAX = 131072, GS_BLAST = 196608, GS_MAXB = 197632, GS_MPREV = 198656;
constexpr size_t WS_VSTAT = 1889 * MiB;
constexpr size_t WS_DEN = 1890 * MiB;
constexpr size_t WS_WIG = 1893 * MiB;
constexpr size_t WS_DUMMY = 1891 * MiB;
constexpr size_t WS_END = 1894 * MiB;
static_assert(WL_OUT + 8 * MiB == WL_STRIDE && WS_WL + 4 * WL_STRIDE == WS_XF, "weights map");

constexpr int CW_BAR = 4096;

constexpr int LDS_BYTES = 163840;
constexpr int RING_BYTES = 131072;
constexpr int MISC_OFF = LDS_BYTES - 256;

__device__ __forceinline__ unsigned f2bf(float f) { unsigned u = __builtin_bit_cast(unsigned, f); return (u + 0x7fffu + ((u >> 16) & 1u)) >> 16; }
__device__ __forceinline__ unsigned pk2(float lo, float hi) { return f2bf(lo) | (f2bf(hi) << 16); }
__device__ __forceinline__ float bf2f(unsigned b) { return __builtin_bit_cast(float, b << 16); }
__device__ __forceinline__ float bflo(unsigned w) { return __builtin_bit_cast(float, w << 16); }
__device__ __forceinline__ float bfhi(unsigned w) { return __builtin_bit_cast(float, w & 0xffff0000u); }
typedef __bf16 bf16x2_t __attribute__((ext_vector_type(2)));
__device__ __forceinline__ unsigned cvt_pk_bf16(float lo, float hi) { const f32x2 v = {lo, hi}; const bf16x2_t b = __builtin_convertvector(v, bf16x2_t); return __builtin_bit_cast(unsigned, b); }
__device__ __forceinline__ float fast_sigmoid(float x) { return __builtin_amdgcn_rcpf(1.0f + __builtin_amdgcn_exp2f(-1.4426950408889634f * x)); }
__device__ __forceinline__ float gelu_tanh(float v) { const float y = 1.5957691216057308f * (v + 0.044715f * v * v * v); return v * fast_sigmoid(y); }
__device__ __forceinline__ float shx(float v, int o, int lane) { return __builtin_bit_cast(float, __builtin_amdgcn_ds_bpermute((lane ^ o) << 2, __builtin_bit_cast(int, v))); }
__device__ __forceinline__ float shup(float v, int o, int lane) { return __builtin_bit_cast(float, __builtin_amdgcn_ds_bpermute((lane - o) << 2, __builtin_bit_cast(int, v))); }
__device__ __forceinline__ float rdlane(float v, int l) { return __builtin_bit_cast(float, __builtin_amdgcn_readlane(__builtin_bit_cast(int, v), l)); }
__device__ __forceinline__ f32x4 scale4(f32x4 v, float s) { asm volatile("v_mul_f32 %0, %0, %4\n\tv_mul_f32 %1, %1, %4\n\tv_mul_f32 %2, %2, %4\n\tv_mul_f32 %3, %3, %4" : "+v"(v[0]), "+v"(v[1]), "+v"(v[2]), "+v"(v[3]) : "v"(s)); return v; }
__device__ __forceinline__ bf16x8 pack8(f32x4 a, f32x4 b) { u32x4 o; o.x = cvt_pk_bf16(a[0], a[1]); o.y = cvt_pk_bf16(a[2], a[3]); o.z = cvt_pk_bf16(b[0], b[1]); o.w = cvt_pk_bf16(b[2], b[3]); return __builtin_bit_cast(bf16x8, o); }
__device__ __forceinline__ f32x4 mfma16(bf16x8 a, bf16x8 b, f32x4 c) { return __builtin_amdgcn_mfma_f32_16x16x32_bf16(a, b, c, 0, 0, 0); }
template <int CTRL> __device__ __forceinline__ float dpp_f(float v) { return __builtin_bit_cast(float, __builtin_amdgcn_update_dpp(0, __builtin_bit_cast(int, v), CTRL, 0xf, 0xf, true)); }
__device__ __forceinline__ float wave_sum(float v, int lane) {
    v += dpp_f<0xB1>(v); v += dpp_f<0x4E>(v); v += dpp_f<0x141>(v); v += dpp_f<0x140>(v);
    v += shx(v, 16, lane); v += shx(v, 32, lane);
    return v;
}
__device__ __forceinline__ float wave_max(float v, int lane) {
    v = fmaxf(v, dpp_f<0xB1>(v)); v = fmaxf(v, dpp_f<0x4E>(v)); v = fmaxf(v, dpp_f<0x141>(v)); v = fmaxf(v, dpp_f<0x140>(v));
    v = fmaxf(v, shx(v, 16, lane)); v = fmaxf(v, shx(v, 32, lane));
    return v;
}
#define LDS_WAIT() asm volatile("s_waitcnt lgkmcnt(0)" ::: "memory")
#define VM_WAIT() asm volatile("s_waitcnt vmcnt(0)" ::: "memory")

#define XB_TMO      128
#define XB_XCNT(j)  (256  + 64 * (j))
#define XB_XSUB(j)  (1280 + 64 * (j))
#define XB_XGEN(j)  (2304 + 64 * (j))
#define XB_TOP      3328
#define XB_TOPGEN   3392
#define XCD_BAR_WORDS 3456
#define XB_SPIN_CAP (1u << 22)
__device__ __forceinline__ unsigned xb_ld(unsigned* p)              { return __hip_atomic_load(p, __ATOMIC_RELAXED, __HIP_MEMORY_SCOPE_AGENT); }
__device__ __forceinline__ unsigned xb_add(unsigned* p, unsigned v) { return __hip_atomic_fetch_add(p, v, __ATOMIC_RELAXED, __HIP_MEMORY_SCOPE_AGENT); }
__device__ __forceinline__ unsigned xb_xcc_id() { return (unsigned)__builtin_amdgcn_s_getreg((3 << 11) | 20) & 0xFu; }
#define XB_SPIN(cond, bar) do { unsigned _sp = 0; while (cond) { __builtin_amdgcn_s_sleep(1); \
    if ((++_sp & 255u) == 0u) { if (xb_ld(&(bar)[XB_TMO])) break; if (_sp > XB_SPIN_CAP) { atomicAdd(&(bar)[XB_TMO], 1u); break; } } } } while (0)
__device__ __forceinline__ int fresh_tid(const int wv) { int l_; asm volatile("v_mbcnt_lo_u32_b32 %0, -1, 0\n\tv_mbcnt_hi_u32_b32 %0, -1, %0" : "=v"(l_)); return wv * 64 + l_; }
struct XcdBarrier { unsigned* bar; unsigned x; volatile LAS unsigned* st; };
__device__ __forceinline__ XcdBarrier xcd_barrier_post(unsigned* bar, volatile LAS unsigned* st) {
    XcdBarrier b; b.bar = bar; b.x = xb_xcc_id(); b.st = st;
    if (threadIdx.x == 0) (void)xb_add(&bar[XB_XCNT(b.x)], 1u);
    return b;
}
__device__ __forceinline__ void xcd_barrier_complete(unsigned* bar, unsigned x, unsigned& nloc, unsigned& nx) {
    const unsigned G = gridDim.x * gridDim.y * gridDim.z;
    unsigned sum, cnt, mine, sp = 0u;
    for (;;) {
        sum = 0u; cnt = 0u; mine = 0u;
#pragma unroll
        for (unsigned j = 0; j < 16; ++j) { const unsigned c = xb_ld(&bar[XB_XCNT(j)]); sum += c; cnt += (c > 0u) ? 1u : 0u; mine = (j == x) ? c : mine; }
        if (sum == G) break;
        __builtin_amdgcn_s_sleep(1);
        if ((++sp & 255u) == 0u) { if (xb_ld(&bar[XB_TMO])) break; if (sp > XB_SPIN_CAP) { atomicAdd(&bar[XB_TMO], 1u); break; } }
    }
    nloc = mine > 0u ? mine : 1u; nx = cnt > 0u ? cnt : 1u;
}
__device__ __forceinline__ void xcd_barrier(const XcdBarrier& b, const int tid_) {
    asm volatile("s_waitcnt vmcnt(0)" ::: "memory");
    __syncthreads();
    if (tid_ == 0) {
        unsigned* bar = b.bar;
        __builtin_amdgcn_s_waitcnt(0);
        unsigned nloc = b.st[0], nx = b.st[1];
        if (nloc == 0u) { xcd_barrier_complete(bar, b.x, nloc, nx); b.st[0] = nloc; b.st[1] = nx; }
        const unsigned old = xb_add(&bar[XB_XSUB(b.x)], 1u);
        const unsigned gen = old / nloc;
        if (old + 1u == (gen + 1u) * nloc) {
            __builtin_amdgcn_fence(__ATOMIC_RELEASE, "agent");
            asm volatile("s_waitcnt vmcnt(0)" ::: "memory");
            const unsigned og = xb_add(&bar[XB_TOP], 1u);
            const unsigned tg = og / nx;
            if (og + 1u == (tg + 1u) * nx) xb_add(&bar[XB_TOPGEN], 1u);
            else XB_SPIN(xb_ld(&bar[XB_TOPGEN]) == tg, bar);
            __builtin_amdgcn_fence(__ATOMIC_ACQUIRE, "agent");
            xb_add(&bar[XB_XGEN(b.x)], 1u);
            asm volatile("s_waitcnt vmcnt(0)" ::: "memory");
        } else {
            XB_SPIN(xb_ld(&bar[XB_XGEN(b.x)]) == gen, bar);
            __builtin_amdgcn_fence(__ATOMIC_ACQUIRE, "agent");
            asm volatile("s_waitcnt vmcnt(0)" ::: "memory");
        }
    }
    __syncthreads();
}

namespace pg8 {
constexpr int BM = 256, BK = 64, HALF = 128, HTB = HALF * BK * 2, STAGE_BYTES = 8 * HTB, NXCD = 8, WGM = 4;
__host__ __device__ __forceinline__ int lds_byte(int r, int c) { const int st = (r >> 4) * 2 + (c >> 5), rr = r & 15, cc = c & 31, ob = rr * 64 + cc * 2; return st * 1024 + (ob ^ (((ob >> 9) & 1) << 5)); }
__host__ __device__ __forceinline__ void stage_rc(int b, int& R, int& C) { const int st = b / 1024, sb = b % 1024, swz = sb ^ (((sb >> 9) & 1) << 5); R = (st >> 1) * 16 + swz / 64; C = (st & 1) * 32 + (swz % 64) / 2; }
__host__ __device__ __forceinline__ int perm32(int rho) { const int n = rho >> 4, i = rho & 15; return 8 * (i >> 2) + 4 * n + (i & 3); }
struct Unit { int pm, pn; };
template <int LDA_, int LDB_, int K_, long A_PM, long A_PN, long B_PB, long B_PN> struct GemmT { const bf16_t* A; const bf16_t* Bt;
    static constexpr int lda = LDA_, ldb = LDB_, K = K_;
    __device__ __forceinline__ const char* a_ptr(const Unit& u) const { return (const char*)(A + (size_t)((long)u.pm * A_PM + (long)u.pn * A_PN)); }
    __device__ __forceinline__ const char* b_ptr(const Unit& u) const { return (const char*)(Bt + (size_t)((long)(u.pm >> 4) * B_PB + (long)u.pn * B_PN)); } };
template <int LDA_, int LDB_, int K_> using GemmStd = GemmT<LDA_, LDB_, K_, 256L * LDA_, 0L, 0L, 256L * LDB_>;
template <int M_, int N_> struct StaticOrder {
    static constexpr int nM = M_ / BM, nN = N_ / BM, nwg = nM * nN;
    int G, c;
    __device__ __forceinline__ void init(int G_, int c_) { G = G_; c = c_; }
    __device__ __forceinline__ bool next(int i, Unit& u) const {
        const int L = i * G + c; if (L >= nwg) return false;
        int wgid = L; { constexpr int q = nwg / NXCD, r = nwg % NXCD; const int xcd = wgid % NXCD, off = wgid / NXCD; wgid = (xcd < r ? xcd * (q + 1) : r * (q + 1) + (xcd - r) * q) + off; }
        constexpr int nig = WGM * nN; const int gid = wgid / nig, fm = gid * WGM, gsz = (nM - fm) < WGM ? (nM - fm) : WGM;
        u.pm = fm + ((wgid % nig) % gsz); u.pn = (wgid % nig) / gsz; return true;
    }
};
template <class Epi, class GemmD, class Sched>
__device__ __forceinline__ void gemm_phase(LAS unsigned char* lds, const GemmD g, const Sched& S, const Epi& E, int tid) {
    asm volatile("" : "+v"(tid));
    const int wid = __builtin_amdgcn_readfirstlane(tid >> 6), lane = tid & 63, wr = wid >> 2, wc = wid & 3, fr = lane & 15, fq = lane >> 4;
    constexpr int K = GemmD::K, nt = K / BK;
    unsigned voffA[2], voffB[2];
#pragma unroll
    for (int i = 0; i < 2; ++i) { int R, C; stage_rc(tid * 16 + i * 8192, R, C); const int Rb = (R & ~31) + perm32(R & 31);
        voffA[i] = (unsigned)(R * GemmD::lda + C) * 2u; voffB[i] = (unsigned)(Rb * GemmD::ldb + C) * 2u; }
    constexpr size_t kstep = (size_t)(BK * 2);
    constexpr size_t hA = (size_t)HALF * GemmD::lda * 2, hB = (size_t)HALF * GemmD::ldb * 2;
    const unsigned ldsw = (unsigned)wid * 1024u;
    const int aoff = lds_byte(wr * 64 + fr, fq * 8), boff = lds_byte(wc * 32 + fr, fq * 8);
#define PG8_SA(b, h) (((b) * 2 + (h)) * HTB)
#define PG8_SB(b, h) ((4 + (b) * 2 + (h)) * HTB)
#define PG8_STAGE(bufoff, gbase, voff) do { _Pragma("unroll") for (int _i = 0; _i < 2; ++_i) \
        __builtin_amdgcn_global_load_lds((const unsigned*)((const char*)(gbase) + (voff)[_i]), (LAS unsigned*)(lds + (bufoff) + ldsw + _i * 8192), 16, 0, 0); } while (0)
#define PG8_LDA(dst, b, h) do { _Pragma("unroll") for (int m = 0; m < 4; ++m) _Pragma("unroll") for (int k = 0; k < 2; ++k) dst[m][k] = *(const LAS bf16x8*)(lds + PG8_SA(b, h) + aoff + m * 2048 + k * 1024); } while (0)
#define PG8_LDB(dst, b, h) do { _Pragma("unroll") for (int n = 0; n < 2; ++n) _Pragma("unroll") for (int k = 0; k < 2; ++k) dst[n][k] = *(const LAS bf16x8*)(lds + PG8_SB(b, h) + boff + n * 2048 + k * 1024); } while (0)
#define PG8_MMA(ai, bj, At, Bt) do { __builtin_amdgcn_s_setprio(1); _Pragma("unroll") for (int m = 0; m < 4; ++m) _Pragma("unroll") for (int n = 0; n < 2; ++n) _Pragma("unroll") for (int k = 0; k < 2; ++k) \
        acc[ai][bj][m][n] = __builtin_amdgcn_mfma_f32_16x16x32_bf16(Bt[n][k], At[m][k], acc[ai][bj][m][n], 0, 0, 0); __builtin_amdgcn_s_setprio(0); } while (0)
#define PG8_WAIT_V(n) asm volatile("s_waitcnt vmcnt(" #n ")" ::: "memory")
#define PG8_WAIT_L(n) asm volatile("s_waitcnt lgkmcnt(" #n ")" ::: "memory")
#define PG8_BAR __builtin_amdgcn_s_barrier()
#define PG8_SCHED __builtin_amdgcn_sched_barrier(0)
    Unit cur, nxt; int ui = 0;
    if (!S.next(0, cur)) return;
    f32x4 acc[2][2][4][2];
#pragma unroll
    for (int a = 0; a < 2; ++a)
#pragma unroll
        for (int b = 0; b < 2; ++b)
#pragma unroll
            for (int m = 0; m < 4; ++m)
#pragma unroll
                for (int n = 0; n < 2; ++n) acc[a][b][m][n] = (f32x4){0.f, 0.f, 0.f, 0.f};
    bf16x8 At[4][2], B0[2][2], B1[2][2];
    const char* cA = g.a_ptr(cur); const char* cB = g.b_ptr(cur);
    PG8_STAGE(PG8_SB(0, 0), cB, voffB); PG8_STAGE(PG8_SB(0, 1), cB + hB, voffB); PG8_STAGE(PG8_SA(0, 0), cA, voffA); PG8_STAGE(PG8_SA(0, 1), cA + hA, voffA);
    if (wr == 1) PG8_BAR;
    PG8_WAIT_V(2); PG8_BAR;
    PG8_STAGE(PG8_SB(1, 0), cB + kstep, voffB); PG8_STAGE(PG8_SA(1, 0), cA + kstep, voffA); PG8_STAGE(PG8_SB(1, 1), cB + hB + kstep, voffB);
    PG8_WAIT_V(6); PG8_BAR;
    for (;;) {
        const bool has_next = S.next(ui + 1, nxt);
        const char* nA = has_next ? g.a_ptr(nxt) : cA; const char* nB = has_next ? g.b_ptr(nxt) : cB;
#pragma nounroll
        for (int t = 0; t < nt; t += 2) {
            const bool last = (t == nt - 2);
            const char* a1 = cA + (size_t)(t + 1) * kstep;
            const char* a2 = last ? nA : cA + (size_t)(t + 2) * kstep; const char* b2 = last ? nB : cB + (size_t)(t + 2) * kstep;
            const char* a3 = a2 + kstep; const char* b3 = b2 + kstep;
            PG8_LDB(B0, 0, 0); PG8_LDB(B1, 0, 1); PG8_SCHED; PG8_LDA(At, 0, 0); PG8_STAGE(PG8_SA(1, 1), a1 + hA, voffA);
            PG8_WAIT_V(8); PG8_WAIT_L(0); PG8_BAR; PG8_MMA(0, 0, At, B0); PG8_MMA(0, 1, At, B1); PG8_BAR; PG8_SCHED;
            PG8_LDA(At, 0, 1); PG8_STAGE(PG8_SB(0, 0), b2, voffB); PG8_STAGE(PG8_SB(0, 1), b2 + hB, voffB); PG8_STAGE(PG8_SA(0, 0), a2, voffA);
            PG8_WAIT_V(8); PG8_WAIT_L(0); PG8_BAR; PG8_MMA(1, 0, At, B0); PG8_MMA(1, 1, At, B1); PG8_BAR; PG8_SCHED;
            PG8_LDB(B0, 1, 0); PG8_LDB(B1, 1, 1); PG8_SCHED; PG8_LDA(At, 1, 0); PG8_STAGE(PG8_SA(0, 1), a2 + hA, voffA);
            PG8_WAIT_V(8); PG8_WAIT_L(0); PG8_BAR; PG8_MMA(0, 0, At, B0); PG8_MMA(0, 1, At, B1); PG8_BAR; PG8_SCHED;
            PG8_LDA(At, 1, 1); PG8_STAGE(PG8_SB(1, 0), b3, voffB); PG8_STAGE(PG8_SB(1, 1), b3 + hB, voffB); PG8_STAGE(PG8_SA(1, 0), a3, voffA);
            PG8_WAIT_V(8); PG8_WAIT_L(0); PG8_BAR; PG8_MMA(1, 0, At, B0); PG8_MMA(1, 1, At, B1); PG8_BAR; PG8_SCHED;
        }
        if (wr == 0) PG8_BAR;
        E(acc, cur, wr, wc, fr, fq);
        if (!has_next) break;
#pragma unroll
        for (int a = 0; a < 2; ++a)
#pragma unroll
            for (int b = 0; b < 2; ++b)
#pragma unroll
                for (int m = 0; m < 4; ++m)
#pragma unroll
                    for (int n = 0; n < 2; ++n) acc[a][b][m][n] = (f32x4){0.f, 0.f, 0.f, 0.f};
        cur = nxt; cA = nA; cB = nB; ++ui;
        if (wr == 1) PG8_BAR;
    }
    PG8_WAIT_V(0);
    PG8_BAR;
#undef PG8_SA
#undef PG8_SB
#undef PG8_STAGE
#undef PG8_LDA
#undef PG8_LDB
#undef PG8_MMA
#undef PG8_WAIT_V
#undef PG8_WAIT_L
#undef PG8_BAR
#undef PG8_SCHED
}

typedef f32x4 Acc[2][2][4][2];
struct EpiIn { bf16_t* Z; const float* bias; const float* bqk; LAS float* red;
    __device__ __forceinline__ void operator()(Acc& acc, const Unit& u, int wr, int wc, int fr, int fq) const {
        const int pn = u.pn; const int act = (pn < 8) ? 1 : (pn < 24) ? 0 : (pn < 32) ? 2 : (pn < 36) ? 3 : 2;
        const int row0 = u.pm * BM + wr * 64 + fr, col0 = pn * BM + wc * 32 + 8 * fq;
        if (act == 3) {
            const int lane = fq * 16 + fr; const float* bp = bqk + (u.pm >> 4) * 1024 + (pn - 32) * BM + wc * 32 + 8 * fq;
            LAS float* RM = red; LAS float* RS = red + 1024;
#pragma unroll
            for (int bj = 0; bj < 2; ++bj) { const f32x4 b0 = *(const f32x4*)(bp + bj * HALF), b1 = *(const f32x4*)(bp + bj * HALF + 4);
#pragma unroll
                for (int ai = 0; ai < 2; ++ai)
#pragma unroll
                    for (int m = 0; m < 4; ++m) { acc[ai][bj][m][0] += b0; acc[ai][bj][m][1] += b1; } }
#pragma unroll
            for (int ai = 0; ai < 2; ++ai)
#pragma unroll
                for (int m = 0; m < 4; ++m) { float mx = -3.0e38f;
#pragma unroll
                    for (int bj = 0; bj < 2; ++bj)
#pragma unroll
                        for (int n = 0; n < 2; ++n) { const f32x4 v = acc[ai][bj][m][n]; mx = fmaxf(mx, fmaxf(fmaxf(v[0], v[1]), fmaxf(v[2], v[3]))); }
                    mx = fmaxf(mx, shx(mx, 16, lane)); mx = fmaxf(mx, shx(mx, 32, lane));
                    if (fq == 0) RM[(ai * HALF + wr * 64 + m * 16 + fr) * 4 + wc] = mx; }
            asm volatile("s_waitcnt lgkmcnt(0)" ::: "memory"); __builtin_amdgcn_s_barrier(); asm volatile("" ::: "memory");
#pragma unroll
            for (int ai = 0; ai < 2; ++ai)
#pragma unroll
                for (int m = 0; m < 4; ++m) { const f32x4 m4 = *(const LAS f32x4*)(RM + (ai * HALF + wr * 64 + m * 16 + fr) * 4); const float mx = fmaxf(fmaxf(m4[0], m4[1]), fmaxf(m4[2], m4[3])); float sm = 0.f;
#pragma unroll
                    for (int bj = 0; bj < 2; ++bj)
#pragma unroll
                        for (int n = 0; n < 2; ++n) { f32x4 v = acc[ai][bj][m][n];
#pragma unroll
                            for (int j = 0; j < 4; ++j) { v[j] = __builtin_amdgcn_exp2f(v[j] - mx); sm += v[j]; }
                            acc[ai][bj][m][n] = v; }
                    sm += shx(sm, 16, lane); sm += shx(sm, 32, lane);
                    if (fq == 0) RS[(ai * HALF + wr * 64 + m * 16 + fr) * 4 + wc] = sm; }
            asm volatile("s_waitcnt lgkmcnt(0)" ::: "memory"); __builtin_amdgcn_s_barrier(); asm volatile("" ::: "memory");
#pragma unroll
            for (int ai = 0; ai < 2; ++ai)
#pragma unroll
                for (int m = 0; m < 4; ++m) { const f32x4 s4 = *(const LAS f32x4*)(RS + (ai * HALF + wr * 64 + m * 16 + fr) * 4); const float inv = 1.f / ((s4[0] + s4[1]) + (s4[2] + s4[3]));
                    bf16_t* rowp = Z + (size_t)(row0 + ai * HALF + m * 16) * ZW + col0;
#pragma unroll
                    for (int bj = 0; bj < 2; ++bj) { const f32x4 v0 = acc[ai][bj][m][0] * inv, v1 = acc[ai][bj][m][1] * inv;
                        u32x4 w; w.x = cvt_pk_bf16(v0[0], v0[1]); w.y = cvt_pk_bf16(v0[2], v0[3]); w.z = cvt_pk_bf16(v1[0], v1[1]); w.w = cvt_pk_bf16(v1[2], v1[3]);
                        *(u32x4*)(rowp + bj * HALF) = w; } }
            return;
        }
#pragma unroll
        for (int bj = 0; bj < 2; ++bj) {
            const f32x4 b0 = *(const f32x4*)(bias + col0 + bj * HALF), b1 = *(const f32x4*)(bias + col0 + bj * HALF + 4);
#pragma unroll
            for (int ai = 0; ai < 2; ++ai)
#pragma unroll
                for (int m = 0; m < 4; ++m) { bf16_t* rowp = Z + (size_t)(row0 + ai * HALF + m * 16) * ZW + col0 + bj * HALF;
                    f32x4 v0 = acc[ai][bj][m][0] + b0, v1 = acc[ai][bj][m][1] + b1;
                    if (act == 1) {
#pragma unroll
                        for (int j = 0; j < 4; ++j) { v0[j] = gelu_tanh(v0[j]); v1[j] = gelu_tanh(v1[j]); } }
                    else if (act == 2) {
#pragma unroll
                        for (int j = 0; j < 4; ++j) { v0[j] = fast_sigmoid(v0[j]); v1[j] = fast_sigmoid(v1[j]); } }
                    u32x4 w; w.x = cvt_pk_bf16(v0[0], v0[1]); w.y = cvt_pk_bf16(v0[2], v0[3]); w.z = cvt_pk_bf16(v1[0], v1[1]); w.w = cvt_pk_bf16(v1[2], v1[3]);
                    *(u32x4*)rowp = w; }
        }
    }
};
__device__ __forceinline__ void store_tile_bf16(const Acc& acc, bf16_t* base, int ldc, float sc, int wr, int wc, int fr, int fq) {
#pragma unroll
    for (int ai = 0; ai < 2; ++ai)
#pragma unroll
        for (int m = 0; m < 4; ++m) { bf16_t* rowp = base + (size_t)(wr * 64 + fr + ai * HALF + m * 16) * ldc + wc * 32 + 8 * fq;
#pragma unroll
            for (int bj = 0; bj < 2; ++bj) { const f32x4 v0 = acc[ai][bj][m][0] * sc, v1 = acc[ai][bj][m][1] * sc;
                u32x4 w; w.x = cvt_pk_bf16(v0[0], v0[1]); w.y = cvt_pk_bf16(v0[2], v0[3]); w.z = cvt_pk_bf16(v1[0], v1[1]); w.w = cvt_pk_bf16(v1[2], v1[3]);
                *(u32x4*)(rowp + bj * HALF) = w; } }
}
constexpr float SCORE_SCALE = 0.0625f * 1.4426950408889634f;
struct GemmQK { const bf16_t* Km; const bf16_t* Wqn; static constexpr int lda = 4096, ldb = 1024, K = 256;
    __device__ __forceinline__ const char* a_ptr(const Unit& u) const { return (const char*)(Km + (size_t)(u.pm & 3) * 256 * 4096 + (size_t)(u.pm >> 2) * 256); }
    __device__ __forceinline__ const char* b_ptr(const Unit& u) const { return (const char*)(Wqn + (size_t)(u.pm >> 4) * 2048 * 1024 + (size_t)((u.pm >> 2) & 3) * 256 + (size_t)u.pn * 256 * 1024); } };
struct EpiQK { bf16_t* O;
    __device__ __forceinline__ void operator()(const Acc& acc, const Unit& u, int wr, int wc, int fr, int fq) const {
        store_tile_bf16(acc, O + ((size_t)((u.pm >> 4) * 4 + (u.pm & 3)) * 1024 + (size_t)((u.pm >> 2) & 3) * 256) * 2048 + (size_t)u.pn * 256, 2048, SCORE_SCALE, wr, wc, fr, fq); } };
struct GemmVW { const unsigned char* wl0; const bf16_t* Vm; static constexpr int lda = 1024, ldb = 4096, K = 256;
    __device__ __forceinline__ const char* a_ptr(const Unit& u) const { const int lbh = u.pm >> 3; return (const char*)((const bf16_t*)(wl0 + (size_t)(lbh >> 4) * WL_STRIDE + WL_PC) + (size_t)(u.pm & 7) * 256 * 1024 + (size_t)(lbh & 3) * 256); }
    __device__ __forceinline__ const char* b_ptr(const Unit& u) const { const int lbh = u.pm >> 3; return (const char*)(Vm + (size_t)((lbh >> 2) & 3) * 256 * 4096 + (size_t)(lbh >> 4) * 1024 + (size_t)(lbh & 3) * 256); } };
struct EpiVW { unsigned char* wsb;
    __device__ __forceinline__ void operator()(const Acc& acc, const Unit& u, int wr, int wc, int fr, int fq) const {
        const int lbh = u.pm >> 3, l = lbh >> 4, b = (lbh >> 2) & 3, h = lbh & 3;
        bf16_t* vw = (bf16_t*)(wsb + (l < 2 ? WS_VW01 + (size_t)l * 16 * MiB : WS_VW23 + (size_t)(l - 2) * 16 * MiB));
        store_tile_bf16(acc, vw + ((size_t)b * 2048 + (size_t)(u.pm & 7) * 256) * 1024 + h * 256, 1024, 1.0f, wr, wc, fr, fq); } };
struct GemmIn { const bf16_t* A; const bf16_t* W; const bf16_t* Wqk; static constexpr int lda = D, ldb = D, K = D;
    __device__ __forceinline__ const char* a_ptr(const Unit& u) const { return (const char*)(A + (size_t)u.pm * 256 * D); }
    __device__ __forceinline__ const char* b_ptr(const Unit& u) const { return (u.pn >= 32 && u.pn < 36) ? (const char*)(Wqk + ((size_t)(u.pm >> 4) * 1024 + (size_t)(u.pn - 32) * 256) * D) : (const char*)(W + (size_t)u.pn * 256 * D); } };
struct EpiF32 { float* C; int ldc;
    __device__ __forceinline__ void operator()(const Acc& acc, const Unit& u, int wr, int wc, int fr, int fq) const {
        const int row0 = u.pm * BM + wr * 64 + fr, col0 = u.pn * BM + wc * 32 + 8 * fq;
#pragma unroll
        for (int ai = 0; ai < 2; ++ai)
#pragma unroll
            for (int m = 0; m < 4; ++m) { float* rowp = C + (size_t)(row0 + ai * HALF + m * 16) * ldc + col0;
#pragma unroll
                for (int bj = 0; bj < 2; ++bj)
#pragma unroll
                    for (int n = 0; n < 2; ++n) *(f32x4*)(rowp + bj * HALF + 4 * n) = acc[ai][bj][m][n]; }
    }
};
struct EpiBf16 { bf16_t* O; int ldc;
    __device__ __forceinline__ void operator()(const Acc& acc, const Unit& u, int wr, int wc, int fr, int fq) const {
        const int row0 = u.pm * BM + wr * 64 + fr, col0 = u.pn * BM + wc * 32 + 8 * fq;
#pragma unroll
        for (int ai = 0; ai < 2; ++ai)
#pragma unroll
            for (int m = 0; m < 4; ++m) { bf16_t* rowp = O + (size_t)(row0 + ai * HALF + m * 16) * ldc + col0;
#pragma unroll
                for (int bj = 0; bj < 2; ++bj) { const f32x4 v0 = acc[ai][bj][m][0], v1 = acc[ai][bj][m][1];
                    u32x4 w; w.x = cvt_pk_bf16(v0[0], v0[1]); w.y = cvt_pk_bf16(v0[2], v0[3]); w.z = cvt_pk_bf16(v1[0], v1[1]); w.w = cvt_pk_bf16(v1[2], v1[3]);
                    *(u32x4*)(rowp + bj * HALF) = w; } }
    }
};
template <int MODE> struct EpiGate { const bf16_t* Gz; bf16_t* mrg;
    __device__ __forceinline__ void operator()(const Acc& acc, const Unit& u, int wr, int wc, int fr, int fq) const {
        const int row0 = u.pm * BM + wr * 64 + fr, col0 = u.pn * BM + wc * 32 + 8 * fq;
#pragma unroll
        for (int ai = 0; ai < 2; ++ai) {
            u32x4 gw[4][2], pw[4][2];
#pragma unroll
            for (int m = 0; m < 4; ++m) { const size_t r = (size_t)(row0 + ai * HALF + m * 16);
#pragma unroll
                for (int bj = 0; bj < 2; ++bj) { const int c = col0 + bj * HALF; gw[m][bj] = *(const u32x4*)(Gz + r * ZW + c); if (MODE != 0) pw[m][bj] = *(const u32x4*)(mrg + r * D + c); else pw[m][bj] = (u32x4){0u, 0u, 0u, 0u}; } }
            __builtin_amdgcn_sched_barrier(0);
#pragma unroll
            for (int m = 0; m < 4; ++m) { const size_t r = (size_t)(row0 + ai * HALF + m * 16);
#pragma unroll
                for (int bj = 0; bj < 2; ++bj) { const int c = col0 + bj * HALF; const u32x4 g4 = gw[m][bj];
                    f32x4 v0 = acc[ai][bj][m][0], v1 = acc[ai][bj][m][1];
                    v0[0] *= bflo(g4.x); v0[1] *= bfhi(g4.x); v0[2] *= bflo(g4.y); v0[3] *= bfhi(g4.y);
                    v1[0] *= bflo(g4.z); v1[1] *= bfhi(g4.z); v1[2] *= bflo(g4.w); v1[3] *= bfhi(g4.w);
                    if (MODE != 0) { const u32x4 p4 = pw[m][bj];
                        v0[0] += bflo(p4.x); v0[1] += bfhi(p4.x); v0[2] += bflo(p4.y); v0[3] += bfhi(p4.y); v1[0] += bflo(p4.z); v1[1] += bfhi(p4.z); v1[2] += bflo(p4.w); v1[3] += bfhi(p4.w); }
                    u32x4 w; w.x = cvt_pk_bf16(v0[0], v0[1]); w.y = cvt_pk_bf16(v0[2], v0[3]); w.z = cvt_pk_bf16(v1[0], v1[1]); w.w = cvt_pk_bf16(v1[2], v1[3]);
                    *(u32x4*)(mrg + r * D + c) = w; } }
            __builtin_amdgcn_sched_barrier(0);
        }
    }
};
struct EpiResid { float* P; const float* stat; const float* g; const float* b;
    __device__ __forceinline__ void operator()(const Acc& acc, const Unit& u, int wr, int wc, int fr, int fq) const {
        const int row0 = u.pm * BM + wr * 64 + fr, col0 = u.pn * BM + wc * 32 + 8 * fq;
        f32x4 g4[2][2], b4[2][2];
#pragma unroll
        for (int bj = 0; bj < 2; ++bj)
#pragma unroll
            for (int n = 0; n < 2; ++n) { const int c = col0 + bj * HALF + 4 * n; g4[bj][n] = *(const f32x4*)(g + c); b4[bj][n] = *(const f32x4*)(b + c); }
#pragma unroll
        for (int q = 0; q < 4; ++q) {
            const int ai = q >> 1, mb = (q & 1) * 2;
            f32x2 st[2]; f32x4 px[2][2][2];
#pragma unroll
            for (int mm = 0; mm < 2; ++mm) { const int row = row0 + ai * HALF + (mb + mm) * 16; const float* pp = P + (size_t)row * D + col0; st[mm] = *(const f32x2*)(stat + 2 * row);
#pragma unroll
                for (int bj = 0; bj < 2; ++bj)
#pragma unroll
                    for (int n = 0; n < 2; ++n) px[mm][bj][n] = *(const f32x4*)(pp + bj * HALF + 4 * n); }
            __builtin_amdgcn_sched_barrier(0);
#pragma unroll
            for (int mm = 0; mm < 2; ++mm) { const int row = row0 + ai * HALF + (mb + mm) * 16; float* pp = P + (size_t)row * D + col0;
#pragma unroll
                for (int bj = 0; bj < 2; ++bj)
#pragma unroll
                    for (int n = 0; n < 2; ++n) { const f32x4 x = (px[mm][bj][n] - st[mm].x) * st[mm].y * g4[bj][n] + b4[bj][n]; *(f32x4*)(pp + bj * HALF + 4 * n) = x * ALPHA + acc[ai][bj][mb + mm][n]; } }
            __builtin_amdgcn_sched_barrier(0);
        }
    }
};
struct EpiSwiglu { bf16_t* H;
    __device__ __forceinline__ void operator()(const Acc& acc, const Unit& u, int wr, int wc, int fr, int fq) const {
        const int row0 = u.pm * BM + wr * 64 + fr, col0 = u.pn * HALF + wc * 32 + 8 * fq;
#pragma unroll
        for (int ai = 0; ai < 2; ++ai)
#pragma unroll
            for (int m = 0; m < 4; ++m) { bf16_t* rowp = H + (size_t)(row0 + ai * HALF + m * 16) * FF + col0;
                f32x4 h0, h1;
#pragma unroll
                for (int j = 0; j < 4; ++j) { const float g0 = acc[ai][0][m][0][j], g1 = acc[ai][0][m][1][j];
                    h0[j] = g0 * fast_sigmoid(g0) * acc[ai][1][m][0][j]; h1[j] = g1 * fast_sigmoid(g1) * acc[ai][1][m][1][j]; }
                u32x4 w; w.x = cvt_pk_bf16(h0[0], h0[1]); w.y = cvt_pk_bf16(h0[2], h0[3]); w.z = cvt_pk_bf16(h1[0], h1[1]); w.w = cvt_pk_bf16(h1[2], h1[3]);
                *(u32x4*)rowp = w; }
    }
};
}

struct Args { const float* in[24]; float* out; unsigned char* ws; int ph_lo, ph_hi; };

struct Frame { LAS unsigned char* lds; int tid, lane, wave, gw, ngw, G, bid; };

__device__ __forceinline__ void transpose_tile(const float* src, size_t ldw, bf16_t* dst, size_t ldwt, LAS float* scr, int lane) {
    float tv[32];
#pragma unroll
    for (int i = 0; i < 32; ++i) tv[i] = src[(size_t)(2 * i + (lane >> 5)) * ldw + (lane & 31)];
#pragma unroll
    for (int i = 0; i < 32; ++i) scr[(2 * i + (lane >> 5)) * 33 + (lane & 31)] = tv[i];
    LDS_WAIT(); asm volatile("" ::: "memory");
    const int c = lane & 7;
#pragma unroll
    for (int j = 0; j < 4; ++j) { const int n = (lane >> 3) + 8 * j; const LAS float* s = scr + (8 * c) * 33 + n;
        u32x4 o; o.x = pk2(s[0 * 33], s[1 * 33]); o.y = pk2(s[2 * 33], s[3 * 33]); o.z = pk2(s[4 * 33], s[5 * 33]); o.w = pk2(s[6 * 33], s[7 * 33]);
        *(u32x4*)(dst + (size_t)n * ldwt + 8 * c) = o; }
    LDS_WAIT(); asm volatile("" ::: "memory");
}
__device__ __forceinline__ void transpose_item(const float* W, int ldw, int N, bf16_t* WT, int K, int item, LAS float* scr, int lane, int mode) {
    const int nblk = N / 32, kb = item / nblk, nb = item % nblk, k0 = 64 * kb, n0 = 32 * nb;
    int r0 = n0;
    if (mode == 1) { r0 = (n0 < FF) ? 256 * (n0 / 128) + (n0 % 128) : 256 * ((n0 - FF) / 128) + 128 + ((n0 - FF) % 128); }
    transpose_tile(W + (size_t)k0 * ldw + n0, (size_t)ldw, WT + (size_t)r0 * K + k0, (size_t)K, scr, lane);
}

struct TItem { const float* src; size_t ldw; bf16_t* dst; size_t ldwt; };
__device__ __forceinline__ void tt_load(f32x4 (&tv)[8], const TItem& t, int lane) {
#pragma unroll
    for (int i = 0; i < 8; ++i) tv[i] = *(const f32x4*)(t.src + (size_t)((lane >> 3) + 8 * i) * t.ldw + 4 * (lane & 7));
}
__device__ __forceinline__ void tt_store(const f32x4 (&tv)[8], const TItem& t, LAS float* scr, int lane) {
#pragma unroll
    for (int i = 0; i < 8; ++i) { LAS float* p = scr + ((lane >> 3) + 8 * i) * 33 + 4 * (lane & 7); p[0] = tv[i][0]; p[1] = tv[i][1]; p[2] = tv[i][2]; p[3] = tv[i][3]; }
    LDS_WAIT(); asm volatile("" ::: "memory");
    const int c = lane & 7;
#pragma unroll
    for (int j = 0; j < 4; ++j) { const int n = (lane >> 3) + 8 * j; const LAS float* s = scr + (8 * c) * 33 + n;
        u32x4 o; o.x = pk2(s[0 * 33], s[1 * 33]); o.y = pk2(s[2 * 33], s[3 * 33]); o.z = pk2(s[4 * 33], s[5 * 33]); o.w = pk2(s[6 * 33], s[7 * 33]);
        *(u32x4*)(t.dst + (size_t)n * t.ldwt + 8 * c) = o; }
    LDS_WAIT(); asm volatile("" ::: "memory");
}
__device__ __forceinline__ TItem titem(const float* W, int ldw, int nblk, int nb0, bf16_t* WT, int K, int item, int mode) {
    const int kb = item / nblk, nb = nb0 + item % nblk, k0 = 64 * kb, n0 = 32 * nb;
    int r0 = n0;
    if (mode == 1) { r0 = (n0 < FF) ? 256 * (n0 / 128) + (n0 % 128) : 256 * ((n0 - FF) / 128) + 128 + ((n0 - FF) % 128); }
    TItem t; t.src = W + (size_t)k0 * ldw + n0; t.ldw = (size_t)ldw; t.dst = WT + (size_t)r0 * K + k0; t.ldwt = (size_t)K; return t;
}
__device__ __forceinline__ void row_load(const float* src, f32x4 (&v)[8], int lane) {
#pragma unroll
    for (int j = 0; j < 8; ++j) v[j] = *(const f32x4*)(src + 256 * j + 4 * lane);
}
__device__ __forceinline__ void row_finish(f32x4 (&v)[8], bool do_ln, const float* lg, const float* lb, float* xf, bf16_t* xb, const LAS float* wg, const float* gb, float* gates, int lane, float* stat = nullptr) {
    if (do_ln) {
        float s = 0.f;
#pragma unroll
        for (int j = 0; j < 8; ++j) s += (v[j].x + v[j].y) + (v[j].z + v[j].w);
        const float mean = wave_sum(s, lane) * (1.f / D); float s2 = 0.f;
#pragma unroll
        for (int j = 0; j < 8; ++j) { v[j] = v[j] - mean; s2 += (v[j].x * v[j].x + v[j].y * v[j].y) + (v[j].z * v[j].z + v[j].w * v[j].w); }
        const float rstd = 1.f / sqrtf(wave_sum(s2, lane) * (1.f / D) + LN_EPS);
        if (stat && lane == 0) { stat[0] = mean; stat[1] = rstd; }
#pragma unroll
        for (int j = 0; j < 8; ++j) { const f32x4 g4 = *(const f32x4*)(lg + 256 * j + 4 * lane), b4 = *(const f32x4*)(lb + 256 * j + 4 * lane); v[j] = v[j] * rstd * g4 + b4; }
    }
    if (xf) {
#pragma unroll
        for (int j = 0; j < 8; ++j) *(f32x4*)(xf + 256 * j + 4 * lane) = v[j];
    }
    if (xb) {
#pragma unroll
        for (int j = 0; j < 8; ++j) { u32x2 w; w.x = cvt_pk_bf16(v[j].x, v[j].y); w.y = cvt_pk_bf16(v[j].z, v[j].w); *(u32x2*)(xb + 256 * j + 4 * lane) = w; }
    }
    if (gates) {
        asm volatile("" : "+s"(wg));
        float myg = 0.f;
#pragma unroll
        for (int q = 0; q < 8; ++q) { float s = 0.f;
#pragma unroll
            for (int j = 0; j < 8; ++j) { const f32x4 w4 = *(const LAS f32x4*)(wg + q * D + 256 * j + 4 * lane); s += (v[j].x * w4.x + v[j].y * w4.y) + (v[j].z * w4.z + v[j].w * w4.w); }
            s = wave_sum(s, lane); if (lane == q) myg = s + gb[q]; }
        if (lane < 8) gates[lane] = myg;
    }
}
__device__ __forceinline__ void row_pass(const float* src, bool do_ln, const float* lg, const float* lb, float* xf, bf16_t* xb, const LAS float* wg, const float* gb, float* gates, int lane, float* stat = nullptr) {
    f32x4 v[8]; row_load(src, v, lane); row_finish(v, do_ln, lg, lb, xf, xb, wg, gb, gates, lane, stat);
}
__device__ __forceinline__ void load_gate_w(const Frame& F, const float* WGl) {
    LAS float* wg = (LAS float*)F.lds;
    for (int i = F.tid; i < 8 * D / 4; i += 512) *(LAS f32x4*)(wg + 4 * i) = *(const f32x4*)(WGl + 4 * i);
    __syncthreads();
}

__global__ void __launch_bounds__(512, 2) fwd_kernel(Args args) {
    extern __shared__ __attribute__((aligned(16))) unsigned char lds_raw[];
    LAS unsigned char* const lds_base = (LAS unsigned char*)lds_raw;
    unsigned char* const ws = args.ws;
    volatile LAS unsigned* MISC = (volatile LAS unsigned*)(lds_base + MISC_OFF);
    if (threadIdx.x < 64) MISC[threadIdx.x] = 0u;
    const int wv0 = __builtin_amdgcn_readfirstlane((int)threadIdx.x >> 6);
    __syncthreads();
#if MK_PER_PHASE
    XcdBarrier bar; bar.bar = (unsigned*)(ws + WS_CTL) + CW_BAR; bar.x = 0; bar.st = nullptr;
#define GRID_BAR() do { } while (0)
#else
    XcdBarrier bar = xcd_barrier_post((unsigned*)(ws + WS_CTL) + CW_BAR, MISC + 8);
#define GRID_BAR() do { XcdBarrier b_ = bar; asm volatile("" : "+s"(b_.bar), "+s"(b_.x)); xcd_barrier(b_, fresh_tid(wv0)); } while (0)
#endif
#define IN(k) true
#define SEAM(k) GRID_BAR()
#define PHASE_CTX \
    unsigned char* wsb; { GAS unsigned char* g_ = (GAS unsigned char*)ws; asm volatile("" : "+s"(g_)); wsb = (unsigned char*)g_; }     \
    Frame F; { int t_ = fresh_tid(wv0); F.lds = lds_base; F.tid = t_; F.lane = t_ & 63; F.wave = __builtin_amdgcn_readfirstlane(t_ >> 6); \
      int g_ = gridDim.x, b_ = blockIdx.x; asm volatile("" : "+s"(g_), "+s"(b_)); F.G = g_; F.bid = b_; F.gw = b_ * 8 + F.wave; F.ngw = g_ * 8; }
#define WG ((float*)(wsb + WS_WG))
#define BIN ((float*)(wsb + WS_BIN))
#define GATES ((float*)(wsb + WS_GATES))
#define STAT ((float*)(wsb + WS_STAT))
#define MEMN ((bf16_t*)(wsb + WS_MEMN))
#define KMEM ((bf16_t*)(wsb + WS_KMEM))
#define VMEM ((bf16_t*)(wsb + WS_VMEM))
#define WQK ((bf16_t*)(wsb + WS_WQK))
#define WQN ((bf16_t*)(wsb + WS_WQN))
#define BQK ((float*)(wsb + WS_BQK))
#define WKT ((bf16_t*)(wsb + WS_WKT))
#define WVT ((bf16_t*)(wsb + WS_WVT))
#define PAR ((float*)(wsb + WS_PAR))
#define XF ((float*)(wsb + WS_XF))
#define PF ((float*)(wsb + WS_PF))
#define XB ((bf16_t*)(wsb + WS_XB))
#define Z ((bf16_t*)(wsb + WS_Z))
#define HFF ((bf16_t*)(wsb + WS_Z))
#define MRG ((bf16_t*)(wsb + WS_MRG))
#define HRAW ((bf16_t*)(wsb + WS_HRAW))
#define QF ((bf16_t*)(wsb + WS_QF))
#define KF ((bf16_t*)(wsb + WS_KF))
#define PFR ((bf16_t*)(wsb + WS_PFR))
#define VF ((bf16_t*)(wsb + WS_VF))
#define GS ((float*)(wsb + WS_GS))
#define DEN ((float*)(wsb + WS_DEN))
#define VSTAT ((float*)(wsb + WS_VSTAT))
#define WIG ((float*)(wsb + WS_WIG))
#define WF32 ((float*)(wsb + WS_WF32))
#define C2A ((float*)(wsb + WS_C2))

    if (IN(0)) {
        PHASE_CTX
        const float* x_in = args.in[0]; const float* w_in = args.in[4]; const float* b_in = args.in[5];
        LAS float* scr = (LAS float*)(F.lds + F.wave * 16384);
        {
            constexpr int I_IN1 = 32 * 256, I_IN2 = 32 * 192, I_GU = 32 * 352, I_DN = 88 * 64, I_PA = 16 * 64, I_PB = 32 * 64, I_PC = 16 * 64, I_OUT = 32 * 64, I_KV = 32 * 64;
            constexpr int NIT = I_IN1 + I_IN2 + I_GU + I_DN + I_PA + I_PB + I_PC + I_OUT + I_KV, NALL = DEPTH * NIT;
            auto decode = [&](int itx) -> TItem {
                const int l = itx / NIT; int r = itx - l * NIT;
                unsigned char* wl = wsb + WS_WL + (size_t)l * WL_STRIDE; const float* win_l = w_in + (size_t)l * D * INW;
                if (r < I_IN1) return titem(win_l, INW, 256, 0, (bf16_t*)(wl + WL_IN), D, r, 0); r -= I_IN1;
                if (r < I_IN2) return titem(win_l + 8200, INW, 192, 32, (bf16_t*)(wl + WL_IN) + (size_t)8192 * D, D, r, 0); r -= I_IN2;
                if (r < I_GU) return titem(args.in[20] + (size_t)l * D * 2 * FF, 2 * FF, 352, 0, (bf16_t*)(wl + WL_GU), D, r, 1); r -= I_GU;
                if (r < I_DN) return titem(args.in[21] + (size_t)l * FF * D, D, 64, 0, (bf16_t*)(wl + WL_DN), FF, r, 0); r -= I_DN;
                if (r < I_PA) return titem(args.in[14] + (size_t)l * 1024 * D, D, 64, 0, (bf16_t*)(wl + WL_PA), 1024, r, 0); r -= I_PA;
                if (r < I_PB) return titem(args.in[15] + (size_t)l * 2048 * D, D, 64, 0, (bf16_t*)(wl + WL_PB), 2048, r, 0); r -= I_PB;
                if (r < I_PC) return titem(args.in[16] + (size_t)l * 1024 * D, D, 64, 0, (bf16_t*)(wl + WL_PC), 1024, r, 0); r -= I_PC;
                if (r < I_OUT) return titem(args.in[17] + (size_t)l * D * D, D, 64, 0, (bf16_t*)(wl + WL_OUT), D, r, 0); r -= I_OUT;
                const int kb = r / 64, nb = r % 64, k0 = 64 * kb, n0 = 32 * nb;
                TItem t; t.src = args.in[13] + (size_t)l * D * 2048 + (size_t)k0 * 2048 + n0; t.ldw = 2048;
                t.dst = ((n0 < 1024) ? WKT + (size_t)(l * 1024 + n0) * D : WVT + (size_t)(l * 1024 + n0 - 1024) * D) + k0; t.ldwt = D; return t;
            };
            f32x4 ta[8], tb[8];
            int it = F.gw;
            TItem ca = decode(it < NALL ? it : NALL - 1), cb = ca;
            tt_load(ta, ca, F.lane);
#pragma nounroll
            while (it < NALL) {
                const int n1 = it + F.ngw; cb = decode(n1 < NALL ? n1 : NALL - 1); tt_load(tb, cb, F.lane);
                tt_store(ta, ca, scr, F.lane);
                if (n1 >= NALL) break;
                const int n2 = n1 + F.ngw; ca = decode(n2 < NALL ? n2 : NALL - 1); tt_load(ta, ca, F.lane);
                tt_store(tb, cb, scr, F.lane);
                it = n2;
            }
        }
        const int gt = F.bid * 512 + F.tid, ngt = F.G * 512;
        for (int i = gt; i < DEPTH * 8 * D; i += ngt) { const int l = i / (8 * D), q = (i / D) % 8, k = i % D; WG[i] = w_in[((size_t)l * D + k) * INW + SRC_GATE + q]; }
        for (int i = gt; i < DEPTH * ZW; i += ngt) { const int l = i / ZW, c = i % ZW; BIN[i] = b_in[(size_t)l * INW + (c < 8192 ? c : c + 8)]; }
        if (gt < 32) PAR[PAR_GBIAS + gt] = b_in[(size_t)(gt >> 3) * INW + SRC_GATE + (gt & 7)];
        if (gt < D) { PAR[PAR_ONE + gt] = 1.f; PAR[PAR_ZERO + gt] = 0.f; }
#define CPY(dst, src, n) do { const float* _s = (src); for (int i = gt; i < (n); i += ngt) PAR[(dst) + i] = _s[i]; } while (0)
        CPY(PAR_GWS, args.in[8], DEPTH * 8 * 128 * 128); CPY(PAR_GLNG, args.in[6], DEPTH * 1024); CPY(PAR_GLNB, args.in[7], DEPTH * 1024); CPY(PAR_GBS, args.in[9], DEPTH * 8 * 128);
        CPY(PAR_CONVW, args.in[10], DEPTH * 4 * 2048); CPY(PAR_CONVB, args.in[11], DEPTH * 2048); CPY(PAR_MNG, args.in[12], DEPTH * 2048);
        CPY(PAR_LN1G, args.in[18], DEPTH * D); CPY(PAR_LN1B, args.in[19], DEPTH * D); CPY(PAR_LN2G, args.in[22], DEPTH * D); CPY(PAR_LN2B, args.in[23], DEPTH * D);
#undef CPY
        { const float* gws = args.in[8];
          for (int i = gt; i < DEPTH * 8 * 16384; i += ngt) { const int lg = i >> 14, f = (i >> 9) & 31, ln = (i >> 3) & 63, j = i & 7; const int t = 16 * (f >> 2) + (ln & 15), sx = 32 * (f & 3) + 8 * (ln >> 4) + j;
              WF32[i] = (sx <= t) ? gws[((size_t)lg * 128 + t) * 128 + sx] : 0.f; }
          for (int i = gt; i < DEPTH * 8 * 128; i += ngt) { const int t = i & 127; const float* wr_ = gws + (size_t)i * 128; float sm = 0.f; for (int sx = 0; sx <= t; ++sx) sm += wr_[sx]; C2A[i] = sm; } }
        for (int i = gt; i < DEPTH * D * 256; i += ngt) { const int l = i / (D * 256), k = (i / 256) % D, c4 = (i & 255) * 4; const f32x4 v = *(const f32x4*)(w_in + ((size_t)l * D + k) * INW + 8200 + c4);
            u32x2 o; o.x = pk2(v.x, v.y); o.y = pk2(v.z, v.w); *(u32x2*)(WQN + ((size_t)l * D + k) * 1024 + c4) = o; }
        for (int i = gt; i < DEPTH * 1024; i += ngt) PAR[PAR_BQ + i] = b_in[(size_t)(i >> 10) * INW + 8200 + (i & 1023)];
        for (int m = F.gw; m < NBATCH * MEMLEN; m += F.ngw) row_pass(args.in[1] + (size_t)m * D, true, args.in[2], args.in[3], nullptr, MEMN + (size_t)m * D, nullptr, nullptr, nullptr, F.lane);
        __syncthreads();
        { LAS float* wg = (LAS float*)F.lds;
          for (int i = F.tid; i < 8 * D; i += 512) { const int q = i / D, k = i % D; wg[i] = w_in[(size_t)k * INW + SRC_GATE + q]; }
          __syncthreads();
          { f32x4 va[8], vb[8]; int m = F.gw; row_load(x_in + (size_t)m * D, va, F.lane);
            for (; m < T; m += F.ngw) { const int mn = (m + F.ngw < T) ? m + F.ngw : m; row_load(x_in + (size_t)mn * D, vb, F.lane);
                row_finish(va, false, nullptr, nullptr, PF + (size_t)m * D, XB + (size_t)m * D, wg, b_in + SRC_GATE, GATES + (size_t)m * 8, F.lane); if (F.lane == 0) { STAT[2 * m] = 0.f; STAT[2 * m + 1] = 1.f; }
#pragma unroll
                for (int j = 0; j < 8; ++j) va[j] = vb[j]; } }
          __syncthreads(); }
    }
    SEAM(0);
    if (IN(1)) {
        PHASE_CTX
        if (F.bid < 64) { pg8::GemmStd<D, D, D> g{MEMN, WKT}; pg8::StaticOrder<1024, 4096> S; S.init(64, F.bid); pg8::EpiBf16 E{KMEM, 4096};
          pg8::gemm_phase(F.lds, g, S, E, F.tid); }
        else if (F.bid < 128) { pg8::GemmStd<D, D, D> g{MEMN, WVT}; pg8::StaticOrder<1024, 4096> S; S.init(64, F.bid - 64); pg8::EpiBf16 E{VMEM, 4096};
          pg8::gemm_phase(F.lds, g, S, E, F.tid); }
    }
    SEAM(1);
    {
        PHASE_CTX
        { pg8::GemmQK g{KMEM, WQN}; pg8::StaticOrder<64 * 256, 2048> S; S.init(F.G, F.bid); pg8::EpiQK E{WQK};
          pg8::gemm_phase(F.lds, g, S, E, F.tid); }
        { pg8::GemmVW g{wsb + WS_WL, VMEM}; pg8::StaticOrder<512 * 256, 256> S; S.init(F.G, F.bid); pg8::EpiVW E{wsb};
          pg8::gemm_phase(F.lds, g, S, E, F.tid); }
        for (int i = F.bid * 512 + F.tid; i < DEPTH * 4 * 1024; i += F.G * 512) {
            const int l = i >> 12, b = (i >> 10) & 3, hm = i & 1023, h = hm >> 8, m = hm & 255;
            const bf16_t* kp = KMEM + (size_t)(b * 256 + m) * 4096 + l * 1024 + h * 256; const float* bq = PAR + PAR_BQ + l * 1024 + h * 256; float sm = 0.f;
            for (int d8 = 0; d8 < 256; d8 += 8) { const u32x4 kv = *(const u32x4*)(kp + d8); const f32x4 q0 = *(const f32x4*)(bq + d8), q1 = *(const f32x4*)(bq + d8 + 4);
                sm += bflo(kv.x) * q0[0] + bfhi(kv.x) * q0[1] + bflo(kv.y) * q0[2] + bfhi(kv.y) * q0[3] + bflo(kv.z) * q1[0] + bfhi(kv.z) * q1[1] + bflo(kv.w) * q1[2] + bfhi(kv.w) * q1[3]; }
            BQK[i] = sm * pg8::SCORE_SCALE; }
    }
    GRID_BAR();

    for (int lyr = 0; lyr < DEPTH; ++lyr) {
        const int pb = 2 + 10 * lyr;
#define LAYER_CTX PHASE_CTX int l = lyr; asm volatile("" : "+s"(l)); unsigned char* wl = wsb + WS_WL + (size_t)l * WL_STRIDE; (void)wl;
        if (IN(pb + 0)) {
            LAYER_CTX
            for (int ch = F.gw; ch < 1024; ch += F.ngw) {
                const int bh = ch >> 6, c = ch & 63, b = bh >> 2, h = bh & 3;
                const size_t row = (size_t)b * SEQ + 64 * c + F.lane;
                const float gi = GATES[row * 8 + h], gf = GATES[row * 8 + 4 + h];
                float bc = fminf(gf, 0.f) - log1pf(expf(-fabsf(gf)));
#pragma unroll
                for (int o = 1; o < 64; o <<= 1) { const float y = shup(bc, o, F.lane); if (F.lane >= o) bc += y; }
                const float bv = gi - bc; float pm = bv;
#pragma unroll
                for (int o = 1; o < 64; o <<= 1) { const float y = shup(pm, o, F.lane); if (F.lane >= o) pm = fmaxf(pm, y); }
                const int pos = bh * 4096 + 64 * c + F.lane;
                GS[GS_BCUM + pos] = bc; GS[GS_BV + pos] = bv; GS[GS_PMAX + pos] = pm;
                if (F.lane == 63) { GS[GS_BLAST + ch] = bc; GS[GS_MAXB + ch] = pm; }
            }
            pg8::GemmIn g{XB, (const bf16_t*)(wl + WL_IN), WQK + (size_t)l * 4 * 1024 * D}; pg8::StaticOrder<T, ZW> S; S.init(F.G, F.bid);
            pg8::EpiIn E{Z, BIN + (size_t)l * ZW, BQK + (size_t)l * 4096, (LAS float*)(F.lds + RING_BYTES)};
            pg8::gemm_phase(F.lds, g, S, E, F.tid);
        }
        SEAM(pb + 0);
        if (IN(pb + 1)) {
            LAYER_CTX
            {
                LAS bf16_t* QL = (LAS bf16_t*)F.lds; LAS bf16_t* KL = QL + 64 * 264; LAS bf16_t* PL = KL + 64 * 264;
                LAS float* WSL = (LAS float*)(PL + 64 * 72);
                LAS bf16_t* VTL = (LAS bf16_t*)(WSL + 64);
                const int w = F.wave, fr = F.lane & 15, fq = F.lane >> 4;
                for (int ch = F.bid; ch < 1024; ch += F.G) {
                    const int bh = ch >> 6, c = ch & 63, b = bh >> 2, h = bh & 3; const size_t row0 = (size_t)b * SEQ + 64 * c; const int pos0 = bh * 4096 + 64 * c;
                    float mp = 0.f;
                    { const float bl = GS[GS_BLAST + bh * 64 + F.lane], mb = GS[GS_MAXB + bh * 64 + F.lane];
                      for (int cc = 0; cc < c; ++cc) mp = rdlane(bl, cc) + fmaxf(mp, rdlane(mb, cc)); }
                    const float mm = fmaxf(mp, GS[GS_MAXB + ch]);
                    if (F.tid == 0) GS[GS_MPREV + ch] = mp;
                    if (F.tid < 64) { WSL[F.tid] = expf(GS[GS_BV + pos0 + F.tid] - mm); WIG[(size_t)ch * 256 + F.tid] = expf(mp - fmaxf(GS[GS_PMAX + pos0 + F.tid], mp)); }
                    if (F.tid == 64) WIG[(size_t)ch * 256 + 64] = expf(mp - mm);
                    {
                      const int cg = F.tid & 63, rg = F.tid >> 6; const int chz = (cg < 32) ? h * 256 + 8 * cg : 1024 + h * 256 + 8 * (cg - 32);
                      const float* cwp = PAR + PAR_CONVW + l * 4 * 2048 + chz; const float* cbp = PAR + PAR_CONVB + l * 2048 + chz;
                      f32x4 cw[4][2], cb2[2];
#pragma unroll
                      for (int j = 0; j < 4; ++j) { cw[j][0] = *(const f32x4*)(cwp + j * 2048); cw[j][1] = *(const f32x4*)(cwp + j * 2048 + 4); }
                      cb2[0] = *(const f32x4*)cbp; cb2[1] = *(const f32x4*)(cbp + 4);
                      const float osc = (cg < 32) ? 1.0f : 0.0625f;
                      const bf16_t* zp = Z + (row0 + 8 * rg) * ZW + ZQK + chz;
                      u32x4 zr[11];
#pragma unroll
                      for (int k = 0; k < 11; ++k) { if (k >= 3 || rg > 0 || c > 0) zr[k] = *(const u32x4*)(zp + (ptrdiff_t)(k - 3) * ZW); else zr[k] = (u32x4){0u, 0u, 0u, 0u}; }
                      f32x4 zf[11][2];
#pragma unroll
                      for (int k = 0; k < 11; ++k) { zf[k][0] = (f32x4){bflo(zr[k].x), bfhi(zr[k].x), bflo(zr[k].y), bfhi(zr[k].y)}; zf[k][1] = (f32x4){bflo(zr[k].z), bfhi(zr[k].z), bflo(zr[k].w), bfhi(zr[k].w)}; }
                      LAS bf16_t* dst = ((cg < 32) ? QL : KL) + (8 * rg) * 264 + 8 * (cg & 31);
#pragma unroll
                      for (int rr = 0; rr < 8; ++rr) { f32x4 y0 = cb2[0], y1 = cb2[1];
#pragma unroll
                          for (int j = 0; j < 4; ++j) { y0 += cw[j][0] * zf[rr + j][0]; y1 += cw[j][1] * zf[rr + j][1]; }
#pragma unroll
                          for (int e = 0; e < 4; ++e) { y0[e] = y0[e] * fast_sigmoid(y0[e]) * osc; y1[e] = y1[e] * fast_sigmoid(y1[e]) * osc; }
                          u32x4 o; o.x = cvt_pk_bf16(y0[0], y0[1]); o.y = cvt_pk_bf16(y0[2], y0[3]); o.z = cvt_pk_bf16(y1[0], y1[1]); o.w = cvt_pk_bf16(y1[2], y1[3]);
                          *(LAS u32x4*)(dst + rr * 264) = o; } }
                    {
                      const int sx = F.tid & 63, cq = F.tid >> 6; const bf16_t* vp = Z + (row0 + sx) * ZW + ZVM + h * 512 + 64 * cq;
#pragma unroll
                      for (int q = 0; q < 8; ++q) { const u32x4 a = *(const u32x4*)(vp + 8 * q); LAS bf16_t* d0 = VTL + (64 * cq + 8 * q) * 72 + sx;
                          d0[0] = (bf16_t)(a.x & 0xffffu); d0[72] = (bf16_t)(a.x >> 16); d0[2 * 72] = (bf16_t)(a.y & 0xffffu); d0[3 * 72] = (bf16_t)(a.y >> 16);
                          d0[4 * 72] = (bf16_t)(a.z & 0xffffu); d0[5 * 72] = (bf16_t)(a.z >> 16); d0[6 * 72] = (bf16_t)(a.w & 0xffffu); d0[7 * 72] = (bf16_t)(a.w >> 16); } }
                    __syncthreads();
                    const int tb = w >> 1, half = w & 1;
                    bf16x8 qa[8];
#pragma unroll
                    for (int i = 0; i < 8; ++i) qa[i] = *(const LAS bf16x8*)(QL + (16 * tb + fr) * 264 + 32 * i + 8 * fq);
                    { bf16_t* qf = QF + ((size_t)ch * 32 + tb * 8 + 4 * half) * 512 + F.lane * 8;
                      const float wir = expf(mp - fmaxf(GS[GS_PMAX + pos0 + 16 * tb + fr], mp));
#pragma unroll
                      for (int ii = 0; ii < 4; ++ii) { const int i = 4 * half + ii; const LAS bf16_t* qp = QL + (16 * tb + fr) * 264 + 32 * i + 4 * fq;
                          u32x4 o; const u32x2 lo = *(const LAS u32x2*)qp, hi = *(const LAS u32x2*)(qp + 16);
                          o.x = cvt_pk_bf16(bflo(lo.x) * wir, bfhi(lo.x) * wir); o.y = cvt_pk_bf16(bflo(lo.y) * wir, bfhi(lo.y) * wir); o.z = cvt_pk_bf16(bflo(hi.x) * wir, bfhi(hi.x) * wir); o.w = cvt_pk_bf16(bflo(hi.y) * wir, bfhi(hi.y) * wir);
                          *(u32x4*)(qf + ii * 512) = o; } }
                    const f32x4 pm4 = *(const f32x4*)(GS + GS_PMAX + pos0 + 16 * tb + 4 * fq);
#pragma unroll
                    for (int sbi = 0; sbi < 2; ++sbi) { const int sb = 2 * half + sbi; f32x4 acc = (f32x4){0.f, 0.f, 0.f, 0.f};
                        if (sb <= tb) {
#pragma unroll
                            for (int i = 0; i < 8; ++i) { const bf16x8 kb = *(const LAS bf16x8*)(KL + (16 * sb + fr) * 264 + 32 * i + 8 * fq); acc = mfma16(qa[i], kb, acc); }
                            const float Bs = GS[GS_BV + pos0 + 16 * sb + fr]; const int sx = 16 * sb + fr;
#pragma unroll
                            for (int r = 0; r < 4; ++r) { const int t = 16 * tb + 4 * fq + r; const float At = -fmaxf(pm4[r], mp); acc[r] = (sx <= t) ? expf(At + Bs) * acc[r] : 0.f; } }
#pragma unroll
                        for (int r = 0; r < 4; ++r) PL[(16 * tb + 4 * fq + r) * 72 + 16 * sb + fr] = (bf16_t)f2bf(acc[r]); }
                    __syncthreads();
                    { const int i = w & 1; const bf16x8 pf = *(const LAS bf16x8*)(PL + (16 * tb + fr) * 72 + 32 * i + 8 * fq);
                      *(bf16x8*)(PFR + ((size_t)ch * 8 + tb * 2 + i) * 512 + F.lane * 8) = pf; }
#pragma unroll
                    for (int dbi = 0; dbi < 2; ++dbi)
#pragma unroll
                        for (int i = 0; i < 2; ++i) { const int db = 2 * w + dbi; float kv[8];
#pragma unroll
                            for (int j = 0; j < 8; ++j) { const int sx = 32 * i + 8 * fq + j; kv[j] = WSL[sx] * bf2f(KL[sx * 264 + 16 * db + fr]); }
                            u32x4 o; o.x = pk2(kv[0], kv[1]); o.y = pk2(kv[2], kv[3]); o.z = pk2(kv[4], kv[5]); o.w = pk2(kv[6], kv[7]);
                            *(u32x4*)(KF + ((size_t)ch * 32 + db * 2 + i) * 512 + F.lane * 8) = o; }
#pragma unroll
                    for (int vi = 0; vi < 4; ++vi)
#pragma unroll
                        for (int i = 0; i < 2; ++i) { const int vblk = 4 * w + vi; const u32x4 o = *(const LAS u32x4*)(VTL + (16 * vblk + fr) * 72 + 32 * i + 8 * fq);
                            *(u32x4*)(VF + ((size_t)ch * 64 + vblk * 2 + i) * 512 + F.lane * 8) = o; }
                    __syncthreads();
                }
            }
            for (int m0 = F.gw * 8; m0 < T; m0 += F.ngw * 8) {
                u32x4 ra[8], rbv[8];
#pragma unroll
                for (int rr = 0; rr < 8; ++rr) { const bf16_t* vp = Z + (size_t)(m0 + rr) * ZW + ZV; ra[rr] = *(const u32x4*)(vp + 8 * F.lane); rbv[rr] = *(const u32x4*)(vp + 512 + 8 * F.lane); }
                float s1[8], s2[8];
#pragma unroll
                for (int rr = 0; rr < 8; ++rr) { const u32x4 a = ra[rr], b = rbv[rr];
                    const float e[16] = {bflo(a.x), bfhi(a.x), bflo(a.y), bfhi(a.y), bflo(a.z), bfhi(a.z), bflo(a.w), bfhi(a.w), bflo(b.x), bfhi(b.x), bflo(b.y), bfhi(b.y), bflo(b.z), bfhi(b.z), bflo(b.w), bfhi(b.w)};
                    float t1 = 0.f, t2 = 0.f;
#pragma unroll
                    for (int j = 0; j < 16; ++j) { t1 += e[j]; t2 += e[j] * e[j]; }
                    s1[rr] = t1; s2[rr] = t2; }
#pragma unroll
                for (int rr = 0; rr < 8; ++rr) { s1[rr] = wave_sum(s1[rr], F.lane); s2[rr] = wave_sum(s2[rr], F.lane); }
#pragma unroll
                for (int rr = 0; rr < 8; ++rr) { const float mean = s1[rr] * (1.f / 1024.f); const float var = fmaxf(s2[rr] * (1.f / 1024.f) - mean * mean, 0.f);
                    if (F.lane == 0) { VSTAT[2 * (m0 + rr)] = mean; VSTAT[2 * (m0 + rr) + 1] = 1.f / sqrtf(var + LN_EPS); } }
            }
        }
        SEAM(pb + 1);
        {
            LAYER_CTX
            if (F.bid < 80) {
            LAS unsigned char* RG = F.lds;
            const int w = F.wave, fr = F.lane & 15, fq = F.lane >> 4;
            const bool is_den = F.bid >= 64;
            const int it = is_den ? F.bid - 64 : F.bid;
            const int bh = is_den ? (it & 7) * 2 + (it >> 3) : (it & 7) * 2 + (it >> 5), jq = is_den ? 0 : (it >> 3) & 3, b = bh >> 2, h = bh & 3;
            const bool active = w < 4 && (!is_den || w == 0);
            bf16x8 ones; { const short o1 = (fr == 0) ? (short)0x3f80 : (short)0; ones = (bf16x8){o1, o1, o1, o1, o1, o1, o1, o1}; }
            const int lo8 = F.lane * 8;
            f32x4 CA[16], CB[16];
#pragma unroll
            for (int i = 0; i < 16; ++i) { CA[i] = (f32x4){0.f, 0.f, 0.f, 0.f}; CB[i] = (f32x4){0.f, 0.f, 0.f, 0.f}; }
            bf16x8 vA[2], vB[2];
            vA[0] = ones; vA[1] = ones; vB[0] = ones; vB[1] = ones;
            float* const dmy = (float*)(wsb + WS_DUMMY) + ((size_t)F.bid * 512 + F.tid) * 4;
#define SC_DMA(c_, sl_) do { const size_t chh = (size_t)bh * 64 + (c_); int wd_ = w - 4; asm volatile("" : "+s"(wd_));        \
                _Pragma("unroll") for (int i = 0; i < 18; ++i) { const int p_ = 18 * wd_ + i; \
                    const bf16_t* src_ = (p_ < 32) ? QF + (chh * 32 + p_) * 512 : (p_ < 40) ? PFR + (chh * 8 + (p_ - 32)) * 512 : KF + (chh * 32 + (p_ - 40)) * 512; \
                    __builtin_amdgcn_global_load_lds((const unsigned*)(src_ + lo8), (LAS unsigned*)(RG + (sl_) * 74752 + p_ * 1024), 16, 0, 0); } \
                if (wd_ == 0) { int l4_ = lo8; asm volatile("" : "+v"(l4_)); l4_ >>= 1; __builtin_amdgcn_global_load_lds((const unsigned*)(WIG + chh * 256 + l4_), (LAS unsigned*)(RG + (sl_) * 74752 + 72 * 1024), 16, 0, 0); } } while (0)
#define SC_LOADV(c_) do { if (active && !is_den) { const bf16_t* v_ = VF + (((size_t)bh * 64 + (c_)) * 64 + (8 * jq + 2 * w) * 2) * 512 + lo8; \
                vA[0] = *(const bf16x8*)v_; vA[1] = *(const bf16x8*)(v_ + 512); vB[0] = *(const bf16x8*)(v_ + 1024); vB[1] = *(const bf16x8*)(v_ + 1536); } } while (0)
#define SC_SB __builtin_amdgcn_sched_barrier(0)
#define SC_RD4(dst, p0, p1, p2, p3) do { dst[0] = *(const LAS bf16x8*)(sb_ + (p0) * 1024); dst[1] = *(const LAS bf16x8*)(sb_ + (p1) * 1024); dst[2] = *(const LAS bf16x8*)(sb_ + (p2) * 1024); dst[3] = *(const LAS bf16x8*)(sb_ + (p3) * 1024); SC_SB; } while (0)
#define SC_W4 do { asm volatile("s_waitcnt lgkmcnt(4)" ::: "memory"); SC_SB; } while (0)
#define SC_INTER2(j, cur) do { \
                { const bf16x8 ca_ = pack8(CA[4 * (j)], CA[4 * (j) + 1]), cb_ = pack8(CB[4 * (j)], CB[4 * (j) + 1]); a0A = mfma16(cur[0], ca_, a0A); a0B = mfma16(cur[0], cb_, a0B); a1A = mfma16(cur[2], ca_, a1A); a1B = mfma16(cur[2], cb_, a1B); } \
                { const bf16x8 ca_ = pack8(CA[4 * (j) + 2], CA[4 * (j) + 3]), cb_ = pack8(CB[4 * (j) + 2], CB[4 * (j) + 3]); a0A = mfma16(cur[1], ca_, a0A); a0B = mfma16(cur[1], cb_, a0B); a1A = mfma16(cur[3], ca_, a1A); a1B = mfma16(cur[3], cb_, a1B); } SC_SB; } while (0)
#define SC_INTRA2(cur) do { a0A = mfma16(cur[0], vA[0], a0A); a0B = mfma16(cur[0], vB[0], a0B); a1A = mfma16(cur[2], vA[0], a1A); a1B = mfma16(cur[2], vB[0], a1B); \
                a0A = mfma16(cur[1], vA[1], a0A); a0B = mfma16(cur[1], vB[1], a0B); a1A = mfma16(cur[3], vA[1], a1A); a1B = mfma16(cur[3], vB[1], a1B); SC_SB; } while (0)
#define SC_OUT(p) do { if (!is_den) { bf16_t* hp = HRAW + (row0 + 32 * (p)) * 2048 + h * 512 + 128 * jq + 32 * w + ((4 * fq) * 2048 + fr); \
                    _Pragma("unroll") for (int r = 0; r < 4; ++r) { hp[r * 2048] = (bf16_t)f2bf(a0A[r]); hp[r * 2048 + 16] = (bf16_t)f2bf(a0B[r]); hp[(16 + r) * 2048] = (bf16_t)f2bf(a1A[r]); hp[(16 + r) * 2048 + 16] = (bf16_t)f2bf(a1B[r]); } } \
                else { float* dp = (fr == 0) ? DEN + (row0 + 32 * (p)) * 4 + h + (4 * fq) * 4 : dmy; const int ds_ = (fr == 0) ? 4 : 0; \
                    _Pragma("unroll") for (int r = 0; r < 4; ++r) { dp[r * ds_] = a0A[r]; dp[(16 + r) * ds_] = a1A[r]; } } \
                SC_SB; } while (0)
#define SC_ZERO do { a0A = (f32x4){0.f, 0.f, 0.f, 0.f}; a0B = a0A; a1A = a0A; a1B = a0A; } while (0)
#define SC_UPD(u, cur) do { f32x4 t0_ = scale4(CA[2 * (u)], dec), t1_ = scale4(CB[2 * (u)], dec), t2_ = scale4(CA[2 * (u) + 1], dec), t3_ = scale4(CB[2 * (u) + 1], dec); \
                t0_ = mfma16(cur[0], vA[0], t0_); t1_ = mfma16(cur[0], vB[0], t1_); t2_ = mfma16(cur[2], vA[0], t2_); t3_ = mfma16(cur[2], vB[0], t3_); \
                CA[2 * (u)] = mfma16(cur[1], vA[1], t0_); CB[2 * (u)] = mfma16(cur[1], vB[1], t1_); CA[2 * (u) + 1] = mfma16(cur[3], vA[1], t2_); CB[2 * (u) + 1] = mfma16(cur[3], vB[1], t3_); SC_SB; } while (0)
#define SC_STEP(c_, sl_, cn_, sn_) do { const size_t row0 = (size_t)b * SEQ + 64 * (c_); \
                const LAS unsigned char* sb_ = RG + (sl_) * 74752 + F.lane * 16; const LAS float* wip_ = (const LAS float*)(RG + (sl_) * 74752 + 72 * 1024); \
                if (active) { \
                const float dec = wip_[64]; \
                f32x4 a0A, a0B, a1A, a1B; bf16x8 fa[4], fb[4]; \
                SC_ZERO; \
                SC_RD4(fa, 0, 1, 8, 9); \
                SC_RD4(fb, 2, 3, 10, 11); SC_W4; SC_INTER2(0, fa); \
                SC_RD4(fa, 4, 5, 12, 13); SC_W4; SC_INTER2(1, fb); \
                SC_RD4(fb, 6, 7, 14, 15); SC_W4; SC_INTER2(2, fa); \
                SC_RD4(fa, 32, 33, 34, 35); SC_W4; SC_INTER2(3, fb); \
                SC_RD4(fb, 16, 17, 24, 25); SC_W4; SC_INTRA2(fa); SC_OUT(0); SC_ZERO; \
                _Pragma("unroll") for (int i = 0; i < 16; ++i) asm volatile("" : "+v"(CA[i]), "+v"(CB[i]));        \
                SC_RD4(fa, 18, 19, 26, 27); SC_W4; SC_INTER2(0, fb); \
                SC_RD4(fb, 20, 21, 28, 29); SC_W4; SC_INTER2(1, fa); \
                SC_RD4(fa, 22, 23, 30, 31); SC_W4; SC_INTER2(2, fb); \
                SC_RD4(fb, 36, 37, 38, 39); SC_W4; SC_INTER2(3, fa); \
                SC_RD4(fa, 40, 41, 42, 43); SC_W4; SC_INTRA2(fb); SC_OUT(1); \
                SC_RD4(fb, 44, 45, 46, 47); SC_W4; SC_UPD(0, fa); \
                SC_RD4(fa, 48, 49, 50, 51); SC_W4; SC_UPD(1, fb); \
                SC_RD4(fb, 52, 53, 54, 55); SC_W4; SC_UPD(2, fa); \
                SC_RD4(fa, 56, 57, 58, 59); SC_W4; SC_UPD(3, fb); \
                SC_RD4(fb, 60, 61, 62, 63); SC_W4; SC_UPD(4, fa); \
                SC_RD4(fa, 64, 65, 66, 67); SC_W4; SC_UPD(5, fb); \
                SC_RD4(fb, 68, 69, 70, 71); SC_W4; SC_UPD(6, fa); \
                asm volatile("s_waitcnt lgkmcnt(0)" ::: "memory"); SC_SB; SC_UPD(7, fb); \
                } else if (w >= 4) { SC_DMA(cn_, sn_); asm volatile("" ::: "memory"); __builtin_amdgcn_s_waitcnt(0x0070); }       \
                __builtin_amdgcn_s_barrier(); asm volatile("" ::: "memory"); } while (0)
            if (w >= 4) { SC_DMA(0, 0); }
            asm volatile("" ::: "memory"); __builtin_amdgcn_s_waitcnt(0x0070); __builtin_amdgcn_s_barrier(); asm volatile("" ::: "memory");
#define SC_TRIP(c) do { { SC_LOADV((c)); SC_STEP((c), 0, (c) + 1, 1); } \
                { const int cnx_ = (c) + 2 < 64 ? (c) + 2 : 63; SC_LOADV((c) + 1); SC_STEP((c) + 1, 1, cnx_, 0); } } while (0)
#pragma nounroll
            for (int c = 0; c < 64; c += 2) SC_TRIP(c);
#undef SC_TRIP
#undef SC_STEP
#undef SC_UPD
#undef SC_ZERO
#undef SC_OUT
#undef SC_INTRA2
#undef SC_INTER2
#undef SC_W4
#undef SC_RD4
#undef SC_SB
#undef SC_LOADV
#undef SC_DMA
            asm volatile("s_waitcnt vmcnt(0)" ::: "memory");
            __syncthreads();
            } else {
            {
                LAS bf16_t* VT = (LAS bf16_t*)F.lds;
                LAS float* ST = (LAS float*)(F.lds + 128 * 136 * 2);
                LAS float* C1 = ST + 256;
                const int w = F.wave, fr = F.lane & 15, fq = F.lane >> 4, nst = (w >> 1) + 1;
                for (int un = F.bid - 80; un < 256; un += 176) {
                    const int cc = un >> 1, hf = un & 1; const size_t r0 = (size_t)cc * 128;
                    if (F.tid < 128) { const f32x2 sv = *(const f32x2*)(VSTAT + 2 * (r0 + F.tid)); ST[F.tid] = sv.x; ST[128 + F.tid] = sv.y; }
                    __syncthreads();
                    u32x4 ta[4]; f32x4 wa[4][2]; unsigned short uvA[8][4];
#pragma unroll
                    for (int i = 0; i < 4; ++i) { ta[i] = (u32x4){0u, 0u, 0u, 0u}; wa[i][0] = (f32x4){0.f, 0.f, 0.f, 0.f}; wa[i][1] = (f32x4){0.f, 0.f, 0.f, 0.f}; }
#pragma unroll
                    for (int db = 0; db < 8; ++db)
#pragma unroll
                        for (int r = 0; r < 4; ++r) uvA[db][r] = 0;
#define BRA_LOAD_TW(gi_) do { const int gq_ = 4 * hf + (gi_), lg_ = l * 8 + gq_; const bf16_t* vp = Z + (r0 + (F.tid & 127)) * ZW + ZV + gq_ * 128 + (F.tid >> 7) * 32; \
                        _Pragma("unroll") for (int q = 0; q < 4; ++q) ta[q] = *(const u32x4*)(vp + 8 * q); \
                        _Pragma("unroll") for (int i = 0; i < 4; ++i) if (i < nst) { const float* wp = WF32 + ((size_t)lg_ * 32 + w * 4 + i) * 512 + F.lane * 8; wa[i][0] = *(const f32x4*)wp; wa[i][1] = *(const f32x4*)(wp + 4); } } while (0)
#define BRA_LOAD_UV(gi_, UV) do { const bf16_t* up0 = Z + (r0 + 16 * w + 4 * fq) * ZW + ZU + (4 * hf + (gi_)) * 128 + fr; \
                        _Pragma("unroll") for (int db = 0; db < 8; ++db) _Pragma("unroll") for (int r = 0; r < 4; ++r) UV[db][r] = up0[(size_t)r * ZW + 16 * db]; } while (0)
                    BRA_LOAD_TW(0); BRA_LOAD_UV(0, uvA);
#pragma nounroll
                    for (int gi = 0; gi < 4; ++gi) { const int gq = 4 * hf + gi, lg = l * 8 + gq;
                        { const int sx = F.tid & 127, c0 = (F.tid >> 7) * 32;
#pragma unroll
                          for (int q = 0; q < 4; ++q) { const u32x4 a = ta[q]; LAS bf16_t* d0 = VT + (c0 + 8 * q) * 136 + sx;
                              d0[0] = (bf16_t)(a.x & 0xffffu); d0[136] = (bf16_t)(a.x >> 16); d0[2 * 136] = (bf16_t)(a.y & 0xffffu); d0[3 * 136] = (bf16_t)(a.y >> 16);
                              d0[4 * 136] = (bf16_t)(a.z & 0xffffu); d0[5 * 136] = (bf16_t)(a.z >> 16); d0[6 * 136] = (bf16_t)(a.w & 0xffffu); d0[7 * 136] = (bf16_t)(a.w >> 16); } }
                        bf16x8 af[4]; float c1p = 0.f;
#pragma unroll
                        for (int i = 0; i < 4; ++i) { u32x4 o = (u32x4){0u, 0u, 0u, 0u};
                            if (i < nst) { const f32x4 w0 = wa[i][0], w1 = wa[i][1];
                                const LAS float* sp = ST + 32 * i + 8 * fq; const f32x4 m0 = *(const LAS f32x4*)sp, m1 = *(const LAS f32x4*)(sp + 4), q0 = *(const LAS f32x4*)(sp + 128), q1 = *(const LAS f32x4*)(sp + 132);
                                const f32x4 p0 = w0 * q0, p1 = w1 * q1;
                                o.x = pk2(p0[0], p0[1]); o.y = pk2(p0[2], p0[3]); o.z = pk2(p1[0], p1[1]); o.w = pk2(p1[2], p1[3]);
                                c1p += bflo(o.x) * m0[0] + bfhi(o.x) * m0[1] + bflo(o.y) * m0[2] + bfhi(o.y) * m0[3] + bflo(o.z) * m1[0] + bfhi(o.z) * m1[1] + bflo(o.w) * m1[2] + bfhi(o.w) * m1[3]; }
                            af[i] = __builtin_bit_cast(bf16x8, o); }
                        c1p += shx(c1p, 16, F.lane); c1p += shx(c1p, 32, F.lane);
                        if (fq == 0) C1[w * 16 + fr] = c1p;
                        __syncthreads();
                        if (gi < 3) BRA_LOAD_TW(gi + 1);
                        const f32x4 c14 = *(const LAS f32x4*)(C1 + w * 16 + 4 * fq);
                        const f32x4 c24 = *(const f32x4*)(C2A + lg * 128 + 16 * w + 4 * fq), bs4 = *(const f32x4*)(PAR + PAR_GBS + lg * 128 + 16 * w + 4 * fq);
#pragma unroll
                        for (int db = 0; db < 8; ++db) { f32x4 acc = (f32x4){0.f, 0.f, 0.f, 0.f};
#pragma unroll
                            for (int i = 0; i < 4; ++i) if (i < nst) { const bf16x8 bb = *(const LAS bf16x8*)(VT + (16 * db + fr) * 136 + 32 * i + 8 * fq); acc = mfma16(af[i], bb, acc); }
                            const int dcol = gq * 128 + 16 * db + fr; const float gg = PAR[PAR_GLNG + l * 1024 + dcol], bbv = PAR[PAR_GLNB + l * 1024 + dcol];
                            bf16_t* up = Z + (r0 + 16 * w + 4 * fq) * ZW + ZU + dcol;
#pragma unroll
                            for (int r = 0; r < 4; ++r) { const float mixed = gg * (acc[r] - c14[r]) + bbv * c24[r] + bs4[r]; up[(size_t)r * ZW] = (bf16_t)f2bf(bf2f(uvA[db][r]) * mixed); } }
                        asm volatile("" ::: "memory");
                        if (gi < 3) BRA_LOAD_UV(gi + 1, uvA);
                        __syncthreads();
                    }
#undef BRA_LOAD_TW
#undef BRA_LOAD_UV
                }
            }
                __syncthreads();
                { pg8::GemmT<ZW, 1024, 1024, 256L * ZW, 0L, 2048L * 1024, 256L * 1024> g{Z + ZQX, (const bf16_t*)(wsb + (l < 2 ? WS_VW01 + (size_t)l * 16 * MiB : WS_VW23 + (size_t)(l - 2) * 16 * MiB))};
                  pg8::StaticOrder<T, D> S; S.init(176, F.bid - 80); pg8::EpiGate<0> E{Z + ZG + 4096, MRG};
                  pg8::gemm_phase(F.lds, g, S, E, F.tid); }
            }
        }
        GRID_BAR();
        if (IN(pb + 2)) {
            LAYER_CTX
            for (int it0 = F.gw; it0 < T * 4; it0 += 4 * F.ngw) {
                u32x4 hw[4], ow[4]; float g0_[4], g1_[4], g2_[4], dnr[4]; f32x4 ga[4], gb[4];
#pragma unroll
                for (int q = 0; q < 4; ++q) { const int it = it0 + q * F.ngw; const size_t r = (size_t)(it >> 2); const int hq = it & 3; const int c0 = hq * 512 + 8 * F.lane;
                    hw[q] = *(const u32x4*)(HRAW + r * 2048 + c0); ow[q] = *(const u32x4*)(Z + r * ZW + ZO + c0);
                    const int bh = (int)(r >> 12) * 4 + hq, tp = (int)(r & 4095), pos = bh * 4096 + tp;
                    g0_[q] = GS[GS_BCUM + pos]; g1_[q] = GS[GS_PMAX + pos]; g2_[q] = GS[GS_MPREV + bh * 64 + (tp >> 6)]; dnr[q] = DEN[r * 4 + hq];
                    ga[q] = *(const f32x4*)(PAR + PAR_MNG + l * 2048 + c0); gb[q] = *(const f32x4*)(PAR + PAR_MNG + l * 2048 + c0 + 4); }
#pragma unroll
                for (int q = 0; q < 4; ++q) { const int it = it0 + q * F.ngw; const size_t r = (size_t)(it >> 2); const int hq = it & 3; const int c0 = hq * 512 + 8 * F.lane;
                    f32x4 a = (f32x4){bflo(hw[q].x), bfhi(hw[q].x), bflo(hw[q].y), bfhi(hw[q].y)}, b4 = (f32x4){bflo(hw[q].z), bfhi(hw[q].z), bflo(hw[q].w), bfhi(hw[q].w)};
                    { const float mrow = g0_[q] + fmaxf(g1_[q], g2_[q]); const float dn = 1.f / fmaxf(fabsf(dnr[q]), expf(-mrow)); a = a * dn; b4 = b4 * dn; }
                    const float mean = wave_sum((a.x + a.y) + (a.z + a.w) + (b4.x + b4.y) + (b4.z + b4.w), F.lane) * (1.f / 512.f);
                    const f32x4 da = a - mean, db = b4 - mean;
                    const float var = wave_sum((da.x * da.x + da.y * da.y) + (da.z * da.z + da.w * da.w) + (db.x * db.x + db.y * db.y) + (db.z * db.z + db.w * db.w), F.lane) * (1.f / 512.f);
                    const float rstd = 1.f / sqrtf(var + LN_EPS);
                    const f32x4 ya = da * rstd * ga[q], yb = db * rstd * gb[q]; const u32x4 o4 = ow[q];
                    u32x4 w; w.x = pk2(ya.x * bflo(o4.x), ya.y * bfhi(o4.x)); w.y = pk2(ya.z * bflo(o4.y), ya.w * bfhi(o4.y)); w.z = pk2(yb.x * bflo(o4.z), yb.y * bfhi(o4.z)); w.w = pk2(yb.z * bflo(o4.w), yb.w * bfhi(o4.w));
                    *(u32x4*)(Z + r * ZW + ZO + c0) = w; }
            }
        }
        SEAM(pb + 2);
        if (IN(pb + 4)) {
            LAYER_CTX
            { pg8::GemmStd<ZW, 1024, 1024> g{Z + ZU, (const bf16_t*)(wl + WL_PA)}; pg8::StaticOrder<T, D> S; S.init(F.G, F.bid); pg8::EpiGate<1> E{Z + ZG, MRG};
              pg8::gemm_phase(F.lds, g, S, E, F.tid); }
            { pg8::GemmStd<ZW, 2048, 2048> g{Z + ZO, (const bf16_t*)(wl + WL_PB)}; pg8::StaticOrder<T, D> S; S.init(F.G, F.bid); pg8::EpiGate<1> E{Z + ZG + 2048, MRG};
              pg8::gemm_phase(F.lds, g, S, E, F.tid); }
        }
        SEAM(pb + 4);
        if (IN(pb + 5)) {
            LAYER_CTX
            pg8::GemmStd<D, D, D> g{MRG, (const bf16_t*)(wl + WL_OUT)}; pg8::StaticOrder<T, D> S; S.init(F.G, F.bid);
            pg8::EpiResid E{PF, STAT, l ? PAR + PAR_LN2G + (l - 1) * D : PAR + PAR_ONE, l ? PAR + PAR_LN2B + (l - 1) * D : PAR + PAR_ZERO};
            pg8::gemm_phase(F.lds, g, S, E, F.tid);
        }
        SEAM(pb + 5);
        if (IN(pb + 6)) {
            LAYER_CTX
            { f32x4 va[8], vb[8]; int m = F.gw; row_load(PF + (size_t)m * D, va, F.lane);
              for (; m < T; m += F.ngw) { const int mn = (m + F.ngw < T) ? m + F.ngw : m; row_load(PF + (size_t)mn * D, vb, F.lane);
                  row_finish(va, true, PAR + PAR_LN1G + l * D, PAR + PAR_LN1B + l * D, nullptr, XB + (size_t)m * D, nullptr, nullptr, nullptr, F.lane, STAT + 2 * (size_t)m);
#pragma unroll
                  for (int j = 0; j < 8; ++j) va[j] = vb[j]; } }
        }
        SEAM(pb + 6);
        if (IN(pb + 7)) {
            LAYER_CTX
            pg8::GemmStd<D, D, D> g{XB, (const bf16_t*)(wl + WL_GU)}; pg8::StaticOrder<T, 2 * FF> S; S.init(F.G, F.bid); pg8::EpiSwiglu E{HFF};
            pg8::gemm_phase(F.lds, g, S, E, F.tid);
        }
        SEAM(pb + 7);
        if (IN(pb + 8)) {
            LAYER_CTX
            pg8::GemmStd<FF, FF, FF> g{HFF, (const bf16_t*)(wl + WL_DN)}; pg8::StaticOrder<T, D> S; S.init(F.G, F.bid); pg8::EpiResid E{PF, STAT, PAR + PAR_LN1G + l * D, PAR + PAR_LN1B + l * D};
            pg8::gemm_phase(F.lds, g, S, E, F.tid);
        }
        SEAM(pb + 8);
        if (IN(pb + 9)) {
            LAYER_CTX
            const bool lastl = (l == DEPTH - 1);
            if (!lastl) load_gate_w(F, WG + (size_t)(l + 1) * 8 * D);
            { f32x4 va[8], vb[8]; int m = F.gw; row_load(PF + (size_t)m * D, va, F.lane);
              for (; m < T; m += F.ngw) { const int mn = (m + F.ngw < T) ? m + F.ngw : m; row_load(PF + (size_t)mn * D, vb, F.lane);
                  row_finish(va, true, PAR + PAR_LN2G + l * D, PAR + PAR_LN2B + l * D, lastl ? args.out + (size_t)m * D : nullptr, lastl ? nullptr : XB + (size_t)m * D,
                             (const LAS float*)F.lds, lastl ? nullptr : PAR + PAR_GBIAS + (l + 1) * 8, lastl ? nullptr : GATES + (size_t)m * 8, F.lane, STAT + 2 * (size_t)m);
#pragma unroll
                  for (int j = 0; j < 8; ++j) va[j] = vb[j]; } }
            __syncthreads();
        }
        if (lyr != DEPTH - 1) GRID_BAR();
    }
#undef IN
#undef SEAM
#undef GRID_BAR
#undef PHASE_CTX
#undef LAYER_CTX
#undef WG
#undef BIN
#undef GATES
#undef STAT
#undef MEMN
#undef KMEM
#undef VMEM
#undef WQK
#undef WQN
#undef BQK
#undef WKT
#undef WVT
#undef PAR
#undef XF
#undef PF
#undef XB
#undef Z
#undef HFF
#undef MRG
#undef HRAW
#undef QF
#undef KF
#undef PFR
#undef VF
#undef GS
#undef DEN
#undef VSTAT
#undef WIG
#undef WF32
#undef C2A
}

extern "C" void kernel_launch(void* const* d_in, const int* in_sizes, int n_in, void* d_out, int out_size, void* d_ws, size_t ws_size, hipStream_t stream) {
    static int grid = 0;
    if (grid == 0) {
        if (n_in != 24 || out_size != T * D || ws_size < WS_END) { fprintf(stderr, "kernel_launch: unexpected shapes (n_in %d, out %d, ws %zu < %zu)\n", n_in, out_size, ws_size, (size_t)WS_END); grid = -1; return; }
        int dev = 0, cus = 0, per_cu = 0;
        if (hipGetDevice(&dev) != hipSuccess || hipDeviceGetAttribute(&cus, hipDeviceAttributeMultiprocessorCount, dev) != hipSuccess) { grid = -1; return; }
        if (hipFuncSetAttribute((const void*)fwd_kernel, hipFuncAttributeMaxDynamicSharedMemorySize, LDS_BYTES) != hipSuccess) { fprintf(stderr, "kernel_launch: hipFuncSetAttribute failed\n"); grid = -1; return; }
        if (hipOccupancyMaxActiveBlocksPerMultiprocessor(&per_cu, (const void*)fwd_kernel, 512, LDS_BYTES) != hipSuccess || per_cu < 1) fprintf(stderr, "kernel_launch: occupancy query says %d\n", per_cu);
        (void)hipGetLastError();
        grid = cus;
    }
    if (grid < 0) return;
    (void)hipMemsetAsync((char*)d_ws + WS_CTL, 0, CTL_ZERO_BYTES, stream);
    Args a{};
    for (int i = 0; i < 24; ++i) a.in[i] = (const float*)d_in[i];
    a.out = (float*)d_out; a.ws = (unsigned char*)d_ws;
    constexpr int NPH = 2 + 10 * DEPTH;
#if MK_PER_PHASE
    for (int p = 0; p < NPH; ++p) { a.ph_lo = p; a.ph_hi = p + 1; hipLaunchKernelGGL(fwd_kernel, dim3(grid), dim3(512), LDS_BYTES, stream, a); }
#else
    a.ph_lo = 0; a.ph_hi = NPH;
    hipLaunchKernelGGL(fwd_kernel, dim3(grid), dim3(512), LDS_BYTES, stream, a);
#endif
    const hipError_t le = hipPeekAtLastError();
    if (le != hipSuccess) fprintf(stderr, "kernel_launch: launch failed: %s\n", hipGetErrorName(le));
}
```

```cpp
#include <hip/hip_runtime.h>
#include <cstdio>
#include <cstdint>

#ifndef MK_PER_PHASE
#define MK_PER_PHASE 0
#endif

#define LAS __attribute__((address_space(3)))
#define GAS __attribute__((address_space(1)))
typedef unsigned short bf16_t;
typedef short bf16x8 __attribute__((ext_vector_type(8)));
typedef float f32x4 __attribute__((ext_vector_type(4)));
typedef float f32x2 __attribute__((ext_vector_type(2)));
typedef unsigned u32x4 __attribute__((ext_vector_type(4)));
typedef unsigned u32x2 __attribute__((ext_vector_type(2)));

constexpr int T = 16384, D = 2048, SEQ = 4096, NBATCH = 4, DEPTH = 4, MEMLEN = 256;
constexpr int INW = 15368, ZW = 15360, FF = 5632;
constexpr int ZU = 0, ZV = 1024, ZQK = 2048, ZVM = 4096, ZO = 6144, ZQX = 8192, ZG = 9216;
constexpr int SRC_GATE = 8192;
constexpr float LN_EPS = 1e-5f;
constexpr float ALPHA = 1.681792830507429f;

constexpr size_t MiB = 1u << 20;
constexpr size_t WS_CTL = 0, CTL_ZERO_BYTES = 1 * MiB;
constexpr size_t WS_WG = 1 * MiB;
constexpr size_t WS_BIN = 2 * MiB;
constexpr size_t WS_GATES = 3 * MiB;
constexpr size_t WS_STAT = 3 * MiB + 512 * 1024;
constexpr size_t WS_MEMN = 4 * MiB;
constexpr size_t WS_KMEM = 8 * MiB;
constexpr size_t WS_VMEM = 16 * MiB;
constexpr size_t WS_PAR = 24 * MiB;
constexpr int PAR_GWS = 0, PAR_GLNG = 524288, PAR_GLNB = 528384, PAR_GBS = 532480, PAR_CONVW = 536576, PAR_CONVB = 569344, PAR_MNG = 577536,
              PAR_LN1G = 585728, PAR_LN1B = 593920, PAR_LN2G = 602112, PAR_LN2B = 610304, PAR_GBIAS = 618496, PAR_ONE = 618528, PAR_ZERO = 620576, PAR_BQ = 622624, PAR_END = 626720;
constexpr size_t WS_WF32 = 28 * MiB;
constexpr size_t WS_C2 = 30 * MiB;
constexpr size_t WS_WKT = 32 * MiB;
constexpr size_t WS_WVT = 48 * MiB;
constexpr size_t WS_WL = 64 * MiB;
constexpr size_t WL_STRIDE = 150 * MiB;
constexpr size_t WL_IN = 0, WL_GU = 60 * MiB, WL_DN = 104 * MiB, WL_PA = 126 * MiB, WL_PB = 130 * MiB, WL_PC = 138 * MiB, WL_OUT = 142 * MiB;
constexpr size_t WS_XF = 664 * MiB;
constexpr size_t WS_PF = 792 * MiB;
constexpr size_t WS_XB = 920 * MiB;
constexpr size_t WS_Z = 984 * MiB;
constexpr size_t WS_MRG = 1464 * MiB;
constexpr size_t WS_WQK = 1528 * MiB;
constexpr size_t WS_VW01 = 1592 * MiB;
constexpr size_t WS_VW23 = 32 * MiB;
constexpr size_t WS_WQN = 984 * MiB;
constexpr size_t WS_BQK = 3 * MiB + 768 * 1024;
constexpr size_t WS_HRAW = 1624 * MiB;
constexpr size_t WS_QF = 1752 * MiB;
constexpr size_t WS_KF = 1784 * MiB;
constexpr size_t WS_PFR = 1816 * MiB;
constexpr size_t WS_VF = 1824 * MiB;
constexpr size_t WS_GS = 1888 * MiB;
constexpr int GS_BCUM = 0, GS_BV = 65536, GS_PMAX = 131072, GS_BLAST = 196608, GS_MAXB = 197632, GS_MPREV = 198656;
constexpr size_t WS_VSTAT = 1889 * MiB;
constexpr size_t WS_DEN = 1890 * MiB;
constexpr size_t WS_WIG = 1893 * MiB;
constexpr size_t WS_DUMMY = 1891 * MiB;
constexpr size_t WS_END = 1894 * MiB;
static_assert(WL_OUT + 8 * MiB == WL_STRIDE && WS_WL + 4 * WL_STRIDE == WS_XF, "weights map");

constexpr int CW_BAR = 4096;

constexpr int LDS_BYTES = 163840;
constexpr int RING_BYTES = 131072;
constexpr int MISC_OFF = LDS_BYTES - 256;

__device__ __forceinline__ unsigned f2bf(float f) { unsigned u = __builtin_bit_cast(unsigned, f); return (u + 0x7fffu + ((u >> 16) & 1u)) >> 16; }
__device__ __forceinline__ unsigned pk2(float lo, float hi) { return f2bf(lo) | (f2bf(hi) << 16); }
__device__ __forceinline__ float bf2f(unsigned b) { return __builtin_bit_cast(float, b << 16); }
__device__ __forceinline__ float bflo(unsigned w) { return __builtin_bit_cast(float, w << 16); }
__device__ __forceinline__ float bfhi(unsigned w) { return __builtin_bit_cast(float, w & 0xffff0000u); }
typedef __bf16 bf16x2_t __attribute__((ext_vector_type(2)));
__device__ __forceinline__ unsigned cvt_pk_bf16(float lo, float hi) { const f32x2 v = {lo, hi}; const bf16x2_t b = __builtin_convertvector(v, bf16x2_t); return __builtin_bit_cast(unsigned, b); }
__device__ __forceinline__ float fast_sigmoid(float x) { return __builtin_amdgcn_rcpf(1.0f + __builtin_amdgcn_exp2f(-1.4426950408889634f * x)); }
__device__ __forceinline__ float gelu_tanh(float v) { const float y = 1.5957691216057308f * (v + 0.044715f * v * v * v); return v * fast_sigmoid(y); }
__device__ __forceinline__ float shx(float v, int o, int lane) { return __builtin_bit_cast(float, __builtin_amdgcn_ds_bpermute((lane ^ o) << 2, __builtin_bit_cast(int, v))); }
__device__ __forceinline__ float shup(float v, int o, int lane) { return __builtin_bit_cast(float, __builtin_amdgcn_ds_bpermute((lane - o) << 2, __builtin_bit_cast(int, v))); }
__device__ __forceinline__ float rdlane(float v, int l) { return __builtin_bit_cast(float, __builtin_amdgcn_readlane(__builtin_bit_cast(int, v), l)); }
__device__ __forceinline__ f32x4 scale4(f32x4 v, float s) { asm volatile("v_mul_f32 %0, %0, %4\n\tv_mul_f32 %1, %1, %4\n\tv_mul_f32 %2, %2, %4\n\tv_mul_f32 %3, %3, %4" : "+v"(v[0]), "+v"(v[1]), "+v"(v[2]), "+v"(v[3]) : "v"(s)); return v; }
__device__ __forceinline__ bf16x8 pack8(f32x4 a, f32x4 b) { u32x4 o; o.x = cvt_pk_bf16(a[0], a[1]); o.y = cvt_pk_bf16(a[2], a[3]); o.z = cvt_pk_bf16(b[0], b[1]); o.w = cvt_pk_bf16(b[2], b[3]); return __builtin_bit_cast(bf16x8, o); }
__device__ __forceinline__ f32x4 mfma16(bf16x8 a, bf16x8 b, f32x4 c) { return __builtin_amdgcn_mfma_f32_16x16x32_bf16(a, b, c, 0, 0, 0); }
template <int CTRL> __device__ __forceinline__ float dpp_f(float v) { return __builtin_bit_cast(float, __builtin_amdgcn_update_dpp(0, __builtin_bit_cast(int, v), CTRL, 0xf, 0xf, true)); }
__device__ __forceinline__ float wave_sum(float v, int lane) {
    v += dpp_f<0xB1>(v); v += dpp_f<0x4E>(v); v += dpp_f<0x141>(v); v += dpp_f<0x140>(v);
    v += shx(v, 16, lane); v += shx(v, 32, lane);
    return v;
}
__device__ __forceinline__ float wave_max(float v, int lane) {
    v = fmaxf(v, dpp_f<0xB1>(v)); v = fmaxf(v, dpp_f<0x4E>(v)); v = fmaxf(v, dpp_f<0x141>(v)); v = fmaxf(v, dpp_f<0x140>(v));
    v = fmaxf(v, shx(v, 16, lane)); v = fmaxf(v, shx(v, 32, lane));
    return v;
}
#define LDS_WAIT() asm volatile("s_waitcnt lgkmcnt(0)" ::: "memory")
#define VM_WAIT() asm volatile("s_waitcnt vmcnt(0)" ::: "memory")

#define XB_TMO      128
#define XB_XCNT(j)  (256  + 64 * (j))
#define XB_XSUB(j)  (1280 + 64 * (j))
#define XB_XGEN(j)  (2304 + 64 * (j))
#define XB_TOP      3328
#define XB_TOPGEN   3392
#define XCD_BAR_WORDS 3456
#define XB_SPIN_CAP (1u << 22)
__device__ __forceinline__ unsigned xb_ld(unsigned* p)              { return __hip_atomic_load(p, __ATOMIC_RELAXED, __HIP_MEMORY_SCOPE_AGENT); }
__device__ __forceinline__ unsigned xb_add(unsigned* p, unsigned v) { return __hip_atomic_fetch_add(p, v, __ATOMIC_RELAXED, __HIP_MEMORY_SCOPE_AGENT); }
__device__ __forceinline__ unsigned xb_xcc_id() { return (unsigned)__builtin_amdgcn_s_getreg((3 << 11) | 20) & 0xFu; }
#define XB_SPIN(cond, bar) do { unsigned _sp = 0; while (cond) { __builtin_amdgcn_s_sleep(1); \
    if ((++_sp & 255u) == 0u) { if (xb_ld(&(bar)[XB_TMO])) break; if (_sp > XB_SPIN_CAP) { atomicAdd(&(bar)[XB_TMO], 1u); break; } } } } while (0)
__device__ __forceinline__ int fresh_tid(const int wv) { int l_; asm volatile("v_mbcnt_lo_u32_b32 %0, -1, 0\n\tv_mbcnt_hi_u32_b32 %0, -1, %0" : "=v"(l_)); return wv * 64 + l_; }
struct XcdBarrier { unsigned* bar; unsigned x; volatile LAS unsigned* st; };
__device__ __forceinline__ XcdBarrier xcd_barrier_post(unsigned* bar, volatile LAS unsigned* st) {
    XcdBarrier b; b.bar = bar; b.x = xb_xcc_id(); b.st = st;
    if (threadIdx.x == 0) (void)xb_add(&bar[XB_XCNT(b.x)], 1u);
    return b;
}
__device__ __forceinline__ void xcd_barrier_complete(unsigned* bar, unsigned x, unsigned& nloc, unsigned& nx) {
    const unsigned G = gridDim.x * gridDim.y * gridDim.z;
    unsigned sum, cnt, mine, sp = 0u;
    for (;;) {
        sum = 0u; cnt = 0u; mine = 0u;
#pragma unroll
        for (unsigned j = 0; j < 16; ++j) { const unsigned c = xb_ld(&bar[XB_XCNT(j)]); sum += c; cnt += (c > 0u) ? 1u : 0u; mine = (j == x) ? c : mine; }
        if (sum == G) break;
        __builtin_amdgcn_s_sleep(1);
        if ((++sp & 255u) == 0u) { if (xb_ld(&bar[XB_TMO])) break; if (sp > XB_SPIN_CAP) { atomicAdd(&bar[XB_TMO], 1u); break; } }
    }
    nloc = mine > 0u ? mine : 1u; nx = cnt > 0u ? cnt : 1u;
}
__device__ __forceinline__ void xcd_barrier(const XcdBarrier& b, const int tid_) {
    asm volatile("s_waitcnt vmcnt(0)" ::: "memory");
    __syncthreads();
    if (tid_ == 0) {
        unsigned* bar = b.bar;
        __builtin_amdgcn_s_waitcnt(0);
        unsigned nloc = b.st[0], nx = b.st[1];
        if (nloc == 0u) { xcd_barrier_complete(bar, b.x, nloc, nx); b.st[0] = nloc; b.st[1] = nx; }
        const unsigned old = xb_add(&bar[XB_XSUB(b.x)], 1u);
        const unsigned gen = old / nloc;
        if (old + 1u == (gen + 1u) * nloc) {
            __builtin_amdgcn_fence(__ATOMIC_RELEASE, "agent");
            asm volatile("s_waitcnt vmcnt(0)" ::: "memory");
            const unsigned og = xb_add(&bar[XB_TOP], 1u);
            const unsigned tg = og / nx;
            if (og + 1u == (tg + 1u) * nx) xb_add(&bar[XB_TOPGEN], 1u);
            else XB_SPIN(xb_ld(&bar[XB_TOPGEN]) == tg, bar);
            __builtin_amdgcn_fence(__ATOMIC_ACQUIRE, "agent");
            xb_add(&bar[XB_XGEN(b.x)], 1u);
            asm volatile("s_waitcnt vmcnt(0)" ::: "memory");
        } else {
            XB_SPIN(xb_ld(&bar[XB_XGEN(b.x)]) == gen, bar);
            __builtin_amdgcn_fence(__ATOMIC_ACQUIRE, "agent");
            asm volatile("s_waitcnt vmcnt(0)" ::: "memory");
        }
    }
    __syncthreads();
}

namespace pg8 {
constexpr int BM = 256, BK = 64, HALF = 128, HTB = HALF * BK * 2, STAGE_BYTES = 8 * HTB, NXCD = 8, WGM = 4;
__host__ __device__ __forceinline__ int lds_byte(int r, int c) { const int st = (r >> 4) * 2 + (c >> 5), rr = r & 15, cc = c & 31, ob = rr * 64 + cc * 2; return st * 1024 + (ob ^ (((ob >> 9) & 1) << 5)); }
__host__ __device__ __forceinline__ void stage_rc(int b, int& R, int& C) { const int st = b / 1024, sb = b % 1024, swz = sb ^ (((sb >> 9) & 1) << 5); R = (st >> 1) * 16 + swz / 64; C = (st & 1) * 32 + (swz % 64) / 2; }
__host__ __device__ __forceinline__ int perm32(int rho) { const int n = rho >> 4, i = rho & 15; return 8 * (i >> 2) + 4 * n + (i & 3); }
struct Unit { int pm, pn; };
template <int LDA_, int LDB_, int K_, long A_PM, long A_PN, long B_PB, long B_PN> struct GemmT { const bf16_t* A; const bf16_t* Bt;
    static constexpr int lda = LDA_, ldb = LDB_, K = K_;
    __device__ __forceinline__ const char* a_ptr(const Unit& u) const { return (const char*)(A + (size_t)((long)u.pm * A_PM + (long)u.pn * A_PN)); }
    __device__ __forceinline__ const char* b_ptr(const Unit& u) const { return (const char*)(Bt + (size_t)((long)(u.pm >> 4) * B_PB + (long)u.pn * B_PN)); } };
template <int LDA_, int LDB_, int K_> using GemmStd = GemmT<LDA_, LDB_, K_, 256L * LDA_, 0L, 0L, 256L * LDB_>;
template <int M_, int N_> struct StaticOrder {
    static constexpr int nM = M_ / BM, nN = N_ / BM, nwg = nM * nN;
    int G, c;
    __device__ __forceinline__ void init(int G_, int c_) { G = G_; c = c_; }
    __device__ __forceinline__ bool next(int i, Unit& u) const {
        const int L = i * G + c; if (L >= nwg) return false;
        int wgid = L; { constexpr int q = nwg / NXCD, r = nwg % NXCD; const int xcd = wgid % NXCD, off = wgid / NXCD; wgid = (xcd < r ? xcd * (q + 1) : r * (q + 1) + (xcd - r) * q) + off; }
        constexpr int nig = WGM * nN; const int gid = wgid / nig, fm = gid * WGM, gsz = (nM - fm) < WGM ? (nM - fm) : WGM;
        u.pm = fm + ((wgid % nig) % gsz); u.pn = (wgid % nig) / gsz; return true;
    }
};
template <class Epi, class GemmD, class Sched>
__device__ __forceinline__ void gemm_phase(LAS unsigned char* lds, const GemmD g, const Sched& S, const Epi& E, int tid) {
    asm volatile("" : "+v"(tid));
    const int wid = __builtin_amdgcn_readfirstlane(tid >> 6), lane = tid & 63, wr = wid >> 2, wc = wid & 3, fr = lane & 15, fq = lane >> 4;
    constexpr int K = GemmD::K, nt = K / BK;
    unsigned voffA[2], voffB[2];
#pragma unroll
    for (int i = 0; i < 2; ++i) { int R, C; stage_rc(tid * 16 + i * 8192, R, C); const int Rb = (R & ~31) + perm32(R & 31);
        voffA[i] = (unsigned)(R * GemmD::lda + C) * 2u; voffB[i] = (unsigned)(Rb * GemmD::ldb + C) * 2u; }
    constexpr size_t kstep = (size_t)(BK * 2);
    constexpr size_t hA = (size_t)HALF * GemmD::lda * 2, hB = (size_t)HALF * GemmD::ldb * 2;
    const unsigned ldsw = (unsigned)wid * 1024u;
    const int aoff = lds_byte(wr * 64 + fr, fq * 8), boff = lds_byte(wc * 32 + fr, fq * 8);
#define PG8_SA(b, h) (((b) * 2 + (h)) * HTB)
#define PG8_SB(b, h) ((4 + (b) * 2 + (h)) * HTB)
#define PG8_STAGE(bufoff, gbase, voff) do { _Pragma("unroll") for (int _i = 0; _i < 2; ++_i) \
        __builtin_amdgcn_global_load_lds((const unsigned*)((const char*)(gbase) + (voff)[_i]), (LAS unsigned*)(lds + (bufoff) + ldsw + _i * 8192), 16, 0, 0); } while (0)
#define PG8_LDA(dst, b, h) do { _Pragma("unroll") for (int m = 0; m < 4; ++m) _Pragma("unroll") for (int k = 0; k < 2; ++k) dst[m][k] = *(const LAS bf16x8*)(lds + PG8_SA(b, h) + aoff + m * 2048 + k * 1024); } while (0)
#define PG8_LDB(dst, b, h) do { _Pragma("unroll") for (int n = 0; n < 2; ++n) _Pragma("unroll") for (int k = 0; k < 2; ++k) dst[n][k] = *(const LAS bf16x8*)(lds + PG8_SB(b, h) + boff + n * 2048 + k * 1024); } while (0)
#define PG8_MMA(ai, bj, At, Bt) do { __builtin_amdgcn_s_setprio(1); _Pragma("unroll") for (int m = 0; m < 4; ++m) _Pragma("unroll") for (int n = 0; n < 2; ++n) _Pragma("unroll") for (int k = 0; k < 2; ++k) \
        acc[ai][bj][m][n] = __builtin_amdgcn_mfma_f32_16x16x32_bf16(Bt[n][k], At[m][k], acc[ai][bj][m][n], 0, 0, 0); __builtin_amdgcn_s_setprio(0); } while (0)
#define PG8_WAIT_V(n) asm volatile("s_waitcnt vmcnt(" #n ")" ::: "memory")
#define PG8_WAIT_L(n) asm volatile("s_waitcnt lgkmcnt(" #n ")" ::: "memory")
#define PG8_BAR __builtin_amdgcn_s_barrier()
#define PG8_SCHED __builtin_amdgcn_sched_barrier(0)
    Unit cur, nxt; int ui = 0;
    if (!S.next(0, cur)) return;
    f32x4 acc[2][2][4][2];
#pragma unroll
    for (int a = 0; a < 2; ++a)
#pragma unroll
        for (int b = 0; b < 2; ++b)
#pragma unroll
            for (int m = 0; m < 4; ++m)
#pragma unroll
                for (int n = 0; n < 2; ++n) acc[a][b][m][n] = (f32x4){0.f, 0.f, 0.f, 0.f};
    bf16x8 At[4][2], B0[2][2], B1[2][2];
    const char* cA = g.a_ptr(cur); const char* cB = g.b_ptr(cur);
    PG8_STAGE(PG8_SB(0, 0), cB, voffB); PG8_STAGE(PG8_SB(0, 1), cB + hB, voffB); PG8_STAGE(PG8_SA(0, 0), cA, voffA); PG8_STAGE(PG8_SA(0, 1), cA + hA, voffA);
    if (wr == 1) PG8_BAR;
    PG8_WAIT_V(2); PG8_BAR;
    PG8_STAGE(PG8_SB(1, 0), cB + kstep, voffB); PG8_STAGE(PG8_SA(1, 0), cA + kstep, voffA); PG8_STAGE(PG8_SB(1, 1), cB + hB + kstep, voffB);
    PG8_WAIT_V(6); PG8_BAR;
    for (;;) {
        const bool has_next = S.next(ui + 1, nxt);
        const char* nA = has_next ? g.a_ptr(nxt) : cA; const char* nB = has_next ? g.b_ptr(nxt) : cB;
#pragma nounroll
        for (int t = 0; t < nt; t += 2) {
            const bool last = (t == nt - 2);
            const char* a1 = cA + (size_t)(t + 1) * kstep;
            const char* a2 = last ? nA : cA + (size_t)(t + 2) * kstep; const char* b2 = last ? nB : cB + (size_t)(t + 2) * kstep;
            const char* a3 = a2 + kstep; const char* b3 = b2 + kstep;
            PG8_LDB(B0, 0, 0); PG8_LDB(B1, 0, 1); PG8_SCHED; PG8_LDA(At, 0, 0); PG8_STAGE(PG8_SA(1, 1), a1 + hA, voffA);
            PG8_WAIT_V(8); PG8_WAIT_L(0); PG8_BAR; PG8_MMA(0, 0, At, B0); PG8_MMA(0, 1, At, B1); PG8_BAR; PG8_SCHED;
            PG8_LDA(At, 0, 1); PG8_STAGE(PG8_SB(0, 0), b2, voffB); PG8_STAGE(PG8_SB(0, 1), b2 + hB, voffB); PG8_STAGE(PG8_SA(0, 0), a2, voffA);
            PG8_WAIT_V(8); PG8_WAIT_L(0); PG8_BAR; PG8_MMA(1, 0, At, B0); PG8_MMA(1, 1, At, B1); PG8_BAR; PG8_SCHED;
            PG8_LDB(B0, 1, 0); PG8_LDB(B1, 1, 1); PG8_SCHED; PG8_LDA(At, 1, 0); PG8_STAGE(PG8_SA(0, 1), a2 + hA, voffA);
            PG8_WAIT_V(8); PG8_WAIT_L(0); PG8_BAR; PG8_MMA(0, 0, At, B0); PG8_MMA(0, 1, At, B1); PG8_BAR; PG8_SCHED;
            PG8_LDA(At, 1, 1); PG8_STAGE(PG8_SB(1, 0), b3, voffB); PG8_STAGE(PG8_SB(1, 1), b3 + hB, voffB); PG8_STAGE(PG8_SA(1, 0), a3, voffA);
            PG8_WAIT_V(8); PG8_WAIT_L(0); PG8_BAR; PG8_MMA(1, 0, At, B0); PG8_MMA(1, 1, At, B1); PG8_BAR; PG8_SCHED;
        }
        if (wr == 0) PG8_BAR;
        E(acc, cur, wr, wc, fr, fq);
        if (!has_next) break;
#pragma unroll
        for (int a = 0; a < 2; ++a)
#pragma unroll
            for (int b = 0; b < 2; ++b)
#pragma unroll
                for (int m = 0; m < 4; ++m)
#pragma unroll
                    for (int n = 0; n < 2; ++n) acc[a][b][m][n] = (f32x4){0.f, 0.f, 0.f, 0.f};
        cur = nxt; cA = nA; cB = nB; ++ui;
        if (wr == 1) PG8_BAR;
    }
    PG8_WAIT_V(0);
    PG8_BAR;
#undef PG8_SA
#undef PG8_SB
#undef PG8_STAGE
#undef PG8_LDA
#undef PG8_LDB
#undef PG8_MMA
#undef PG8_WAIT_V
#undef PG8_WAIT_L
#undef PG8_BAR
#undef PG8_SCHED
}

typedef f32x4 Acc[2][2][4][2];
struct EpiIn { bf16_t* Z; const float* bias; const float* bqk; LAS float* red;
    __device__ __forceinline__ void operator()(Acc& acc, const Unit& u, int wr, int wc, int fr, int fq) const {
        const int pn = u.pn; const int act = (pn < 8) ? 1 : (pn < 24) ? 0 : (pn < 32) ? 2 : (pn < 36) ? 3 : 2;
        const int row0 = u.pm * BM + wr * 64 + fr, col0 = pn * BM + wc * 32 + 8 * fq;
        if (act == 3) {
            const int lane = fq * 16 + fr; const float* bp = bqk + (u.pm >> 4) * 1024 + (pn - 32) * BM + wc * 32 + 8 * fq;
            LAS float* RM = red; LAS float* RS = red + 1024;
#pragma unroll
            for (int bj = 0; bj < 2; ++bj) { const f32x4 b0 = *(const f32x4*)(bp + bj * HALF), b1 = *(const f32x4*)(bp + bj * HALF + 4);
#pragma unroll
                for (int ai = 0; ai < 2; ++ai)
#pragma unroll
                    for (int m = 0; m < 4; ++m) { acc[ai][bj][m][0] += b0; acc[ai][bj][m][1] += b1; } }
#pragma unroll
            for (int ai = 0; ai < 2; ++ai)
#pragma unroll
                for (int m = 0; m < 4; ++m) { float mx = -3.0e38f;
#pragma unroll
                    for (int bj = 0; bj < 2; ++bj)
#pragma unroll
                        for (int n = 0; n < 2; ++n) { const f32x4 v = acc[ai][bj][m][n]; mx = fmaxf(mx, fmaxf(fmaxf(v[0], v[1]), fmaxf(v[2], v[3]))); }
                    mx = fmaxf(mx, shx(mx, 16, lane)); mx = fmaxf(mx, shx(mx, 32, lane));
                    if (fq == 0) RM[(ai * HALF + wr * 64 + m * 16 + fr) * 4 + wc] = mx; }
            asm volatile("s_waitcnt lgkmcnt(0)" ::: "memory"); __builtin_amdgcn_s_barrier(); asm volatile("" ::: "memory");
#pragma unroll
            for (int ai = 0; ai < 2; ++ai)
#pragma unroll
                for (int m = 0; m < 4; ++m) { const f32x4 m4 = *(const LAS f32x4*)(RM + (ai * HALF + wr * 64 + m * 16 + fr) * 4); const float mx = fmaxf(fmaxf(m4[0], m4[1]), fmaxf(m4[2], m4[3])); float sm = 0.f;
#pragma unroll
                    for (int bj = 0; bj < 2; ++bj)
#pragma unroll
                        for (int n = 0; n < 2; ++n) { f32x4 v = acc[ai][bj][m][n];
#pragma unroll
                            for (int j = 0; j < 4; ++j) { v[j] = __builtin_amdgcn_exp2f(v[j] - mx); sm += v[j]; }
                            acc[ai][bj][m][n] = v; }
                    sm += shx(sm, 16, lane); sm += shx(sm, 32, lane);
                    if (fq == 0) RS[(ai * HALF + wr * 64 + m * 16 + fr) * 4 + wc] = sm; }
            asm volatile("s_waitcnt lgkmcnt(0)" ::: "memory"); __builtin_amdgcn_s_barrier(); asm volatile("" ::: "memory");
#pragma unroll
            for (int ai = 0; ai < 2; ++ai)
#pragma unroll
                for (int m = 0; m < 4; ++m) { const f32x4 s4 = *(const LAS f32x4*)(RS + (ai * HALF + wr * 64 + m * 16 + fr) * 4); const float inv = 1.f / ((s4[0] + s4[1]) + (s4[2] + s4[3]));
                    bf16_t* rowp = Z + (size_t)(row0 + ai * HALF + m * 16) * ZW + col0;
#pragma unroll
                    for (int bj = 0; bj < 2; ++bj) { const f32x4 v0 = acc[ai][bj][m][0] * inv, v1 = acc[ai][bj][m][1] * inv;
                        u32x4 w; w.x = cvt_pk_bf16(v0[0], v0[1]); w.y = cvt_pk_bf16(v0[2], v0[3]); w.z = cvt_pk_bf16(v1[0], v1[1]); w.w = cvt_pk_bf16(v1[2], v1[3]);
                        *(u32x4*)(rowp + bj * HALF) = w; } }
            return;
        }
#pragma unroll
        for (int bj = 0; bj < 2; ++bj) {
            const f32x4 b0 = *(const f32x4*)(bias + col0 + bj * HALF), b1 = *(const f32x4*)(bias + col0 + bj * HALF + 4);
#pragma unroll
            for (int ai = 0; ai < 2; ++ai)
#pragma unroll
                for (int m = 0; m < 4; ++m) { bf16_t* rowp = Z + (size_t)(row0 + ai * HALF + m * 16) * ZW + col0 + bj * HALF;
                    f32x4 v0 = acc[ai][bj][m][0] + b0, v1 = acc[ai][bj][m][1] + b1;
                    if (act == 1) {
#pragma unroll
                        for (int j = 0; j < 4; ++j) { v0[j] = gelu_tanh(v0[j]); v1[j] = gelu_tanh(v1[j]); } }
                    else if (act == 2) {
#pragma unroll
                        for (int j = 0; j < 4; ++j) { v0[j] = fast_sigmoid(v0[j]); v1[j] = fast_sigmoid(v1[j]); } }
                    u32x4 w; w.x = cvt_pk_bf16(v0[0], v0[1]); w.y = cvt_pk_bf16(v0[2], v0[3]); w.z = cvt_pk_bf16(v1[0], v1[1]); w.w = cvt_pk_bf16(v1[2], v1[3]);
                    *(u32x4*)rowp = w; }
        }
    }
};
__device__ __forceinline__ void store_tile_bf16(const Acc& acc, bf16_t* base, int ldc, float sc, int wr, int wc, int fr, int fq) {
#pragma unroll
    for (int ai = 0; ai < 2; ++ai)
#pragma unroll
        for (int m = 0; m < 4; ++m) { bf16_t* rowp = base + (size_t)(wr * 64 + fr + ai * HALF + m * 16) * ldc + wc * 32 + 8 * fq;
#pragma unroll
            for (int bj = 0; bj < 2; ++bj) { const f32x4 v0 = acc[ai][bj][m][0] * sc, v1 = acc[ai][bj][m][1] * sc;
                u32x4 w; w.x = cvt_pk_bf16(v0[0], v0[1]); w.y = cvt_pk_bf16(v0[2], v0[3]); w.z = cvt_pk_bf16(v1[0], v1[1]); w.w = cvt_pk_bf16(v1[2], v1[3]);
                *(u32x4*)(rowp + bj * HALF) = w; } }
}
constexpr float SCORE_SCALE = 0.0625f * 1.4426950408889634f;
struct GemmQK { const bf16_t* Km; const bf16_t* Wqn; static constexpr int lda = 4096, ldb = 1024, K = 256;
    __device__ __forceinline__ const char* a_ptr(const Unit& u) const { return (const char*)(Km + (size_t)(u.pm & 3) * 256 * 4096 + (size_t)(u.pm >> 2) * 256); }
    __device__ __forceinline__ const char* b_ptr(const Unit& u) const { return (const char*)(Wqn + (size_t)(u.pm >> 4) * 2048 * 1024 + (size_t)((u.pm >> 2) & 3) * 256 + (size_t)u.pn * 256 * 1024); } };
struct EpiQK { bf16_t* O;
    __device__ __forceinline__ void operator()(const Acc& acc, const Unit& u, int wr, int wc, int fr, int fq) const {
        store_tile_bf16(acc, O + ((size_t)((u.pm >> 4) * 4 + (u.pm & 3)) * 1024 + (size_t)((u.pm >> 2) & 3) * 256) * 2048 + (size_t)u.pn * 256, 2048, SCORE_SCALE, wr, wc, fr, fq); } };
struct GemmVW { const unsigned char* wl0; const bf16_t* Vm; static constexpr int lda = 1024, ldb = 4096, K = 256;
    __device__ __forceinline__ const char* a_ptr(const Unit& u) const { const int lbh = u.pm >> 3; return (const char*)((const bf16_t*)(wl0 + (size_t)(lbh >> 4) * WL_STRIDE + WL_PC) + (size_t)(u.pm & 7) * 256 * 1024 + (size_t)(lbh & 3) * 256); }
    __device__ __forceinline__ const char* b_ptr(const Unit& u) const { const int lbh = u.pm >> 3; return (const char*)(Vm + (size_t)((lbh >> 2) & 3) * 256 * 4096 + (size_t)(lbh >> 4) * 1024 + (size_t)(lbh & 3) * 256); } };
struct EpiVW { unsigned char* wsb;
    __device__ __forceinline__ void operator()(const Acc& acc, const Unit& u, int wr, int wc, int fr, int fq) const {
        const int lbh = u.pm >> 3, l = lbh >> 4, b = (lbh >> 2) & 3, h = lbh & 3;
        bf16_t* vw = (bf16_t*)(wsb + (l < 2 ? WS_VW01 + (size_t)l * 16 * MiB : WS_VW23 + (size_t)(l - 2) * 16 * MiB));
        store_tile_bf16(acc, vw + ((size_t)b * 2048 + (size_t)(u.pm & 7) * 256) * 1024 + h * 256, 1024, 1.0f, wr, wc, fr, fq); } };
struct GemmIn { const bf16_t* A; const bf16_t* W; const bf16_t* Wqk; static constexpr int lda = D, ldb = D, K = D;
    __device__ __forceinline__ const char* a_ptr(const Unit& u) const { return (const char*)(A + (size_t)u.pm * 256 * D); }
    __device__ __forceinline__ const char* b_ptr(const Unit& u) const { return (u.pn >= 32 && u.pn < 36) ? (const char*)(Wqk + ((size_t)(u.pm >> 4) * 1024 + (size_t)(u.pn - 32) * 256) * D) : (const char*)(W + (size_t)u.pn * 256 * D); } };
struct EpiF32 { float* C; int ldc;
    __device__ __forceinline__ void operator()(const Acc& acc, const Unit& u, int wr, int wc, int fr, int fq) const {
        const int row0 = u.pm * BM + wr * 64 + fr, col0 = u.pn * BM + wc * 32 + 8 * fq;
#pragma unroll
        for (int ai = 0; ai < 2; ++ai)
#pragma unroll
            for (int m = 0; m < 4; ++m) { float* rowp = C + (size_t)(row0 + ai * HALF + m * 16) * ldc + col0;
#pragma unroll
                for (int bj = 0; bj < 2; ++bj)
#pragma unroll
                    for (int n = 0; n < 2; ++n) *(f32x4*)(rowp + bj * HALF + 4 * n) = acc[ai][bj][m][n]; }
    }
};
struct EpiBf16 { bf16_t* O; int ldc;
    __device__ __forceinline__ void operator()(const Acc& acc, const Unit& u, int wr, int wc, int fr, int fq) const {
        const int row0 = u.pm * BM + wr * 64 + fr, col0 = u.pn * BM + wc * 32 + 8 * fq;
#pragma unroll
        for (int ai = 0; ai < 2; ++ai)
#pragma unroll
            for (int m = 0; m < 4; ++m) { bf16_t* rowp = O + (size_t)(row0 + ai * HALF + m * 16) * ldc + col0;
#pragma unroll
                for (int bj = 0; bj < 2; ++bj) { const f32x4 v0 = acc[ai][bj][m][0], v1 = acc[ai][bj][m][1];
                    u32x4 w; w.x = cvt_pk_bf16(v0[0], v0[1]); w.y = cvt_pk_bf16(v0[2], v0[3]); w.z = cvt_pk_bf16(v1[0], v1[1]); w.w = cvt_pk_bf16(v1[2], v1[3]);
                    *(u32x4*)(rowp + bj * HALF) = w; } }
    }
};
template <int MODE> struct EpiGate { const bf16_t* Gz; bf16_t* mrg;
    __device__ __forceinline__ void operator()(const Acc& acc, const Unit& u, int wr, int wc, int fr, int fq) const {
        const int row0 = u.pm * BM + wr * 64 + fr, col0 = u.pn * BM + wc * 32 + 8 * fq;
#pragma unroll
        for (int ai = 0; ai < 2; ++ai) {
            u32x4 gw[4][2], pw[4][2];
#pragma unroll
            for (int m = 0; m < 4; ++m) { const size_t r = (size_t)(row0 + ai * HALF + m * 16);
#pragma unroll
                for (int bj = 0; bj < 2; ++bj) { const int c = col0 + bj * HALF; gw[m][bj] = *(const u32x4*)(Gz + r * ZW + c); if (MODE != 0) pw[m][bj] = *(const u32x4*)(mrg + r * D + c); else pw[m][bj] = (u32x4){0u, 0u, 0u, 0u}; } }
            __builtin_amdgcn_sched_barrier(0);
#pragma unroll
            for (int m = 0; m < 4; ++m) { const size_t r = (size_t)(row0 + ai * HALF + m * 16);
#pragma unroll
                for (int bj = 0; bj < 2; ++bj) { const int c = col0 + bj * HALF; const u32x4 g4 = gw[m][bj];
                    f32x4 v0 = acc[ai][bj][m][0], v1 = acc[ai][bj][m][1];
                    v0[0] *= bflo(g4.x); v0[1] *= bfhi(g4.x); v0[2] *= bflo(g4.y); v0[3] *= bfhi(g4.y);
                    v1[0] *= bflo(g4.z); v1[1] *= bfhi(g4.z); v1[2] *= bflo(g4.w); v1[3] *= bfhi(g4.w);
                    if (MODE != 0) { const u32x4 p4 = pw[m][bj];
                        v0[0] += bflo(p4.x); v0[1] += bfhi(p4.x); v0[2] += bflo(p4.y); v0[3] += bfhi(p4.y); v1[0] += bflo(p4.z); v1[1] += bfhi(p4.z); v1[2] += bflo(p4.w); v1[3] += bfhi(p4.w); }
                    u32x4 w; w.x = cvt_pk_bf16(v0[0], v0[1]); w.y = cvt_pk_bf16(v0[2], v0[3]); w.z = cvt_pk_bf16(v1[0], v1[1]); w.w = cvt_pk_bf16(v1[2], v1[3]);
                    *(u32x4*)(mrg + r * D + c) = w; } }
            __builtin_amdgcn_sched_barrier(0);
        }
    }
};
struct EpiResid { float* P; const float* stat; const float* g; const float* b;
    __device__ __forceinline__ void operator()(const Acc& acc, const Unit& u, int wr, int wc, int fr, int fq) const {
        const int row0 = u.pm * BM + wr * 64 + fr, col0 = u.pn * BM + wc * 32 + 8 * fq;
        f32x4 g4[2][2], b4[2][2];
#pragma unroll
        for (int bj = 0; bj < 2; ++bj)
#pragma unroll
            for (int n = 0; n < 2; ++n) { const int c = col0 + bj * HALF + 4 * n; g4[bj][n] = *(const f32x4*)(g + c); b4[bj][n] = *(const f32x4*)(b + c); }
#pragma unroll
        for (int q = 0; q < 4; ++q) {
            const int ai = q >> 1, mb = (q & 1) * 2;
            f32x2 st[2]; f32x4 px[2][2][2];
#pragma unroll
            for (int mm = 0; mm < 2; ++mm) { const int row = row0 + ai * HALF + (mb + mm) * 16; const float* pp = P + (size_t)row * D + col0; st[mm] = *(const f32x2*)(stat + 2 * row);
#pragma unroll
                for (int bj = 0; bj < 2; ++bj)
#pragma unroll
                    for (int n = 0; n < 2; ++n) px[mm][bj][n] = *(const f32x4*)(pp + bj * HALF + 4 * n); }
            __builtin_amdgcn_sched_barrier(0);
#pragma unroll
            for (int mm = 0; mm < 2; ++mm) { const int row = row0 + ai * HALF + (mb + mm) * 16; float* pp = P + (size_t)row * D + col0;
#pragma unroll
                for (int bj = 0; bj < 2; ++bj)
#pragma unroll
                    for (int n = 0; n < 2; ++n) { const f32x4 x = (px[mm][bj][n] - st[mm].x) * st[mm].y * g4[bj][n] + b4[bj][n]; *(f32x4*)(pp + bj * HALF + 4 * n) = x * ALPHA + acc[ai][bj][mb + mm][n]; } }
            __builtin_amdgcn_sched_barrier(0);
        }
    }
};
struct EpiSwiglu { bf16_t* H;
    __device__ __forceinline__ void operator()(const Acc& acc, const Unit& u, int wr, int wc, int fr, int fq) const {
        const int row0 = u.pm * BM + wr * 64 + fr, col0 = u.pn * HALF + wc * 32 + 8 * fq;
#pragma unroll
        for (int ai = 0; ai < 2; ++ai)
#pragma unroll
            for (int m = 0; m < 4; ++m) { bf16_t* rowp = H + (size_t)(row0 + ai * HALF + m * 16) * FF + col0;
                f32x4 h0, h1;
#pragma unroll
                for (int j = 0; j < 4; ++j) { const float g0 = acc[ai][0][m][0][j], g1 = acc[ai][0][m][1][j];
                    h0[j] = g0 * fast_sigmoid(g0) * acc[ai][1][m][0][j]; h1[j] = g1 * fast_sigmoid(g1) * acc[ai][1][m][1][j]; }
                u32x4 w; w.x = cvt_pk_bf16(h0[0], h0[1]); w.y = cvt_pk_bf16(h0[2], h0[3]); w.z = cvt_pk_bf16(h1[0], h1[1]); w.w = cvt_pk_bf16(h1[2], h1[3]);
                *(u32x4*)rowp = w; }
    }
};
}

struct Args { const float* in[24]; float* out; unsigned char* ws; int ph_lo, ph_hi; };

struct Frame { LAS unsigned char* lds; int tid, lane, wave, gw, ngw, G, bid; };

__device__ __forceinline__ void transpose_tile(const float* src, size_t ldw, bf16_t* dst, size_t ldwt, LAS float* scr, int lane) {
    float tv[32];
#pragma unroll
    for (int i = 0; i < 32; ++i) tv[i] = src[(size_t)(2 * i + (lane >> 5)) * ldw + (lane & 31)];
#pragma unroll
    for (int i = 0; i < 32; ++i) scr[(2 * i + (lane >> 5)) * 33 + (lane & 31)] = tv[i];
    LDS_WAIT(); asm volatile("" ::: "memory");
    const int c = lane & 7;
#pragma unroll
    for (int j = 0; j < 4; ++j) { const int n = (lane >> 3) + 8 * j; const LAS float* s = scr + (8 * c) * 33 + n;
        u32x4 o; o.x = pk2(s[0 * 33], s[1 * 33]); o.y = pk2(s[2 * 33], s[3 * 33]); o.z = pk2(s[4 * 33], s[5 * 33]); o.w = pk2(s[6 * 33], s[7 * 33]);
        *(u32x4*)(dst + (size_t)n * ldwt + 8 * c) = o; }
    LDS_WAIT(); asm volatile("" ::: "memory");
}
__device__ __forceinline__ void transpose_item(const float* W, int ldw, int N, bf16_t* WT, int K, int item, LAS float* scr, int lane, int mode) {
    const int nblk = N / 32, kb = item / nblk, nb = item % nblk, k0 = 64 * kb, n0 = 32 * nb;
    int r0 = n0;
    if (mode == 1) { r0 = (n0 < FF) ? 256 * (n0 / 128) + (n0 % 128) : 256 * ((n0 - FF) / 128) + 128 + ((n0 - FF) % 128); }
    transpose_tile(W + (size_t)k0 * ldw + n0, (size_t)ldw, WT + (size_t)r0 * K + k0, (size_t)K, scr, lane);
}

struct TItem { const float* src; size_t ldw; bf16_t* dst; size_t ldwt; };
__device__ __forceinline__ void tt_load(f32x4 (&tv)[8], const TItem& t, int lane) {
#pragma unroll
    for (int i = 0; i < 8; ++i) tv[i] = *(const f32x4*)(t.src + (size_t)((lane >> 3) + 8 * i) * t.ldw + 4 * (lane & 7));
}
__device__ __forceinline__ void tt_store(const f32x4 (&tv)[8], const TItem& t, LAS float* scr, int lane) {
#pragma unroll
    for (int i = 0; i < 8; ++i) { LAS float* p = scr + ((lane >> 3) + 8 * i) * 33 + 4 * (lane & 7); p[0] = tv[i][0]; p[1] = tv[i][1]; p[2] = tv[i][2]; p[3] = tv[i][3]; }
    LDS_WAIT(); asm volatile("" ::: "memory");
    const int c = lane & 7;
#pragma unroll
    for (int j = 0; j < 4; ++j) { const int n = (lane >> 3) + 8 * j; const LAS float* s = scr + (8 * c) * 33 + n;
        u32x4 o; o.x = pk2(s[0 * 33], s[1 * 33]); o.y = pk2(s[2 * 33], s[3 * 33]); o.z = pk2(s[4 * 33], s[5 * 33]); o.w = pk2(s[6 * 33], s[7 * 33]);
        *(u32x4*)(t.dst + (size_t)n * t.ldwt + 8 * c) = o; }
    LDS_WAIT(); asm volatile("" ::: "memory");
}
__device__ __forceinline__ TItem titem(const float* W, int ldw, int nblk, int nb0, bf16_t* WT, int K, int item, int mode) {
    const int kb = item / nblk, nb = nb0 + item % nblk, k0 = 64 * kb, n0 = 32 * nb;
    int r0 = n0;
    if (mode == 1) { r0 = (n0 < FF) ? 256 * (n0 / 128) + (n0 % 128) : 256 * ((n0 - FF) / 128) + 128 + ((n0 - FF) % 128); }
    TItem t; t.src = W + (size_t)k0 * ldw + n0; t.ldw = (size_t)ldw; t.dst = WT + (size_t)r0 * K + k0; t.ldwt = (size_t)K; return t;
}
__device__ __forceinline__ void row_load(const float* src, f32x4 (&v)[8], int lane) {
#pragma unroll
    for (int j = 0; j < 8; ++j) v[j] = *(const f32x4*)(src + 256 * j + 4 * lane);
}
__device__ __forceinline__ void row_finish(f32x4 (&v)[8], bool do_ln, const float* lg, const float* lb, float* xf, bf16_t* xb, const LAS float* wg, const float* gb, float* gates, int lane, float* stat = nullptr) {
    if (do_ln) {
        float s = 0.f;
#pragma unroll
        for (int j = 0; j < 8; ++j) s += (v[j].x + v[j].y) + (v[j].z + v[j].w);
        const float mean = wave_sum(s, lane) * (1.f / D); float s2 = 0.f;
#pragma unroll
        for (int j = 0; j < 8; ++j) { v[j] = v[j] - mean; s2 += (v[j].x * v[j].x + v[j].y * v[j].y) + (v[j].z * v[j].z + v[j].w * v[j].w); }
        const float rstd = 1.f / sqrtf(wave_sum(s2, lane) * (1.f / D) + LN_EPS);
        if (stat && lane == 0) { stat[0] = mean; stat[1] = rstd; }
#pragma unroll
        for (int j = 0; j < 8; ++j) { const f32x4 g4 = *(const f32x4*)(lg + 256 * j + 4 * lane), b4 = *(const f32x4*)(lb + 256 * j + 4 * lane); v[j] = v[j] * rstd * g4 + b4; }
    }
    if (xf) {
#pragma unroll
        for (int j = 0; j < 8; ++j) *(f32x4*)(xf + 256 * j + 4 * lane) = v[j];
    }
    if (xb) {
#pragma unroll
        for (int j = 0; j < 8; ++j) { u32x2 w; w.x = cvt_pk_bf16(v[j].x, v[j].y); w.y = cvt_pk_bf16(v[j].z, v[j].w); *(u32x2*)(xb + 256 * j + 4 * lane) = w; }
    }
    if (gates) {
        asm volatile("" : "+s"(wg));
        float myg = 0.f;
#pragma unroll
        for (int q = 0; q < 8; ++q) { float s = 0.f;
#pragma unroll
            for (int j = 0; j < 8; ++j) { const f32x4 w4 = *(const LAS f32x4*)(wg + q * D + 256 * j + 4 * lane); s += (v[j].x * w4.x + v[j].y * w4.y) + (v[j].z * w4.z + v[j].w * w4.w); }
            s = wave_sum(s, lane); if (lane == q) myg = s + gb[q]; }
        if (lane < 8) gates[lane] = myg;
    }
}
__device__ __forceinline__ void row_pass(const float* src, bool do_ln, const float* lg, const float* lb, float* xf, bf16_t* xb, const LAS float* wg, const float* gb, float* gates, int lane, float* stat = nullptr) {
    f32x4 v[8]; row_load(src, v, lane); row_finish(v, do_ln, lg, lb, xf, xb, wg, gb, gates, lane, stat);
}
__device__ __forceinline__ void load_gate_w(const Frame& F, const float* WGl) {
    LAS float* wg = (LAS float*)F.lds;
    for (int i = F.tid; i < 8 * D / 4; i += 512) *(LAS f32x4*)(wg + 4 * i) = *(const f32x4*)(WGl + 4 * i);
    __syncthreads();
}

__global__ void __launch_bounds__(512, 2) fwd_kernel(Args args) {
    extern __shared__ __attribute__((aligned(16))) unsigned char lds_raw[];
    LAS unsigned char* const lds_base = (LAS unsigned char*)lds_raw;
    unsigned char* const ws = args.ws;
    volatile LAS unsigned* MISC = (volatile LAS unsigned*)(lds_base + MISC_OFF);
    if (threadIdx.x < 64) MISC[threadIdx.x] = 0u;
    const int wv0 = __builtin_amdgcn_readfirstlane((int)threadIdx.x >> 6);
    __syncthreads();
#if MK_PER_PHASE
    XcdBarrier bar; bar.bar = (unsigned*)(ws + WS_CTL) + CW_BAR; bar.x = 0; bar.st = nullptr;
#define GRID_BAR() do { } while (0)
#else
    XcdBarrier bar = xcd_barrier_post((unsigned*)(ws + WS_CTL) + CW_BAR, MISC + 8);
#define GRID_BAR() do { XcdBarrier b_ = bar; asm volatile("" : "+s"(b_.bar), "+s"(b_.x)); xcd_barrier(b_, fresh_tid(wv0)); } while (0)
#endif
#define IN(k) true
#define SEAM(k) GRID_BAR()
#define PHASE_CTX \
    unsigned char* wsb; { GAS unsigned char* g_ = (GAS unsigned char*)ws; asm volatile("" : "+s"(g_)); wsb = (unsigned char*)g_; }     \
    Frame F; { int t_ = fresh_tid(wv0); F.lds = lds_base; F.tid = t_; F.lane = t_ & 63; F.wave = __builtin_amdgcn_readfirstlane(t_ >> 6); \
      int g_ = gridDim.x, b_ = blockIdx.x; asm volatile("" : "+s"(g_), "+s"(b_)); F.G = g_; F.bid = b_; F.gw = b_ * 8 + F.wave; F.ngw = g_ * 8; }
#define WG ((float*)(wsb + WS_WG))
#define BIN ((float*)(wsb + WS_BIN))
#define GATES ((float*)(wsb + WS_GATES))
#define STAT ((float*)(wsb + WS_STAT))
#define MEMN ((bf16_t*)(wsb + WS_MEMN))
#define KMEM ((bf16_t*)(wsb + WS_KMEM))
#define VMEM ((bf16_t*)(wsb + WS_VMEM))
#define WQK ((bf16_t*)(wsb + WS_WQK))
#define WQN ((bf16_t*)(wsb + WS_WQN))
#define BQK ((float*)(wsb + WS_BQK))
#define WKT ((bf16_t*)(wsb + WS_WKT))
#define WVT ((bf16_t*)(wsb + WS_WVT))
#define PAR ((float*)(wsb + WS_PAR))
#define XF ((float*)(wsb + WS_XF))
#define PF ((float*)(wsb + WS_PF))
#define XB ((bf16_t*)(wsb + WS_XB))
#define Z ((bf16_t*)(wsb + WS_Z))
#define HFF ((bf16_t*)(wsb + WS_Z))
#define MRG ((bf16_t*)(wsb + WS_MRG))
#define HRAW ((bf16_t*)(wsb + WS_HRAW))
#define QF ((bf16_t*)(wsb + WS_QF))
#define KF ((bf16_t*)(wsb + WS_KF))
#define PFR ((bf16_t*)(wsb + WS_PFR))
#define VF ((bf16_t*)(wsb + WS_VF))
#define GS ((float*)(wsb + WS_GS))
#define DEN ((float*)(wsb + WS_DEN))
#define VSTAT ((float*)(wsb + WS_VSTAT))
#define WIG ((float*)(wsb + WS_WIG))
#define WF32 ((float*)(wsb + WS_WF32))
#define C2A ((float*)(wsb + WS_C2))

    if (IN(0)) {
        PHASE_CTX
        const float* x_in = args.in[0]; const float* w_in = args.in[4]; const float* b_in = args.in[5];
        LAS float* scr = (LAS float*)(F.lds + F.wave * 16384);
        {
            constexpr int I_IN1 = 32 * 256, I_IN2 = 32 * 192, I_GU = 32 * 352, I_DN = 88 * 64, I_PA = 16 * 64, I_PB = 32 * 64, I_PC = 16 * 64, I_OUT = 32 * 64, I_KV = 32 * 64;
            constexpr int NIT = I_IN1 + I_IN2 + I_GU + I_DN + I_PA + I_PB + I_PC + I_OUT + I_KV, NALL = DEPTH * NIT;
            auto decode = [&](int itx) -> TItem {
                const int l = itx / NIT; int r = itx - l * NIT;
                unsigned char* wl = wsb + WS_WL + (size_t)l * WL_STRIDE; const float* win_l = w_in + (size_t)l * D * INW;
                if (r < I_IN1) return titem(win_l, INW, 256, 0, (bf16_t*)(wl + WL_IN), D, r, 0); r -= I_IN1;
                if (r < I_IN2) return titem(win_l + 8200, INW, 192, 32, (bf16_t*)(wl + WL_IN) + (size_t)8192 * D, D, r, 0); r -= I_IN2;
                if (r < I_GU) return titem(args.in[20] + (size_t)l * D * 2 * FF, 2 * FF, 352, 0, (bf16_t*)(wl + WL_GU), D, r, 1); r -= I_GU;
                if (r < I_DN) return titem(args.in[21] + (size_t)l * FF * D, D, 64, 0, (bf16_t*)(wl + WL_DN), FF, r, 0); r -= I_DN;
                if (r < I_PA) return titem(args.in[14] + (size_t)l * 1024 * D, D, 64, 0, (bf16_t*)(wl + WL_PA), 1024, r, 0); r -= I_PA;
                if (r < I_PB) return titem(args.in[15] + (size_t)l * 2048 * D, D, 64, 0, (bf16_t*)(wl + WL_PB), 2048, r, 0); r -= I_PB;
                if (r < I_PC) return titem(args.in[16] + (size_t)l * 1024 * D, D, 64, 0, (bf16_t*)(wl + WL_PC), 1024, r, 0); r -= I_PC;
                if (r < I_OUT) return titem(args.in[17] + (size_t)l * D * D, D, 64, 0, (bf16_t*)(wl + WL_OUT), D, r, 0); r -= I_OUT;
                const int kb = r / 64, nb = r % 64, k0 = 64 * kb, n0 = 32 * nb;
                TItem t; t.src = args.in[13] + (size_t)l * D * 2048 + (size_t)k0 * 2048 + n0; t.ldw = 2048;
                t.dst = ((n0 < 1024) ? WKT + (size_t)(l * 1024 + n0) * D : WVT + (size_t)(l * 1024 + n0 - 1024) * D) + k0; t.ldwt = D; return t;
            };
            f32x4 ta[8], tb[8];
            int it = F.gw;
            TItem ca = decode(it < NALL ? it : NALL - 1), cb = ca;
            tt_load(ta, ca, F.lane);
#pragma nounroll
            while (it < NALL) {
                const int n1 = it + F.ngw; cb = decode(n1 < NALL ? n1 : NALL - 1); tt_load(tb, cb, F.lane);
                tt_store(ta, ca, scr, F.lane);
                if (n1 >= NALL) break;
                const int n2 = n1 + F.ngw; ca = decode(n2 < NALL ? n2 : NALL - 1); tt_load(ta, ca, F.lane);
                tt_store(tb, cb, scr, F.lane);
                it = n2;
            }
        }
        const int gt = F.bid * 512 + F.tid, ngt = F.G * 512;
        for (int i = gt; i < DEPTH * 8 * D; i += ngt) { const int l = i / (8 * D), q = (i / D) % 8, k = i % D; WG[i] = w_in[((size_t)l * D + k) * INW + SRC_GATE + q]; }
        for (int i = gt; i < DEPTH * ZW; i += ngt) { const int l = i / ZW, c = i % ZW; BIN[i] = b_in[(size_t)l * INW + (c < 8192 ? c : c + 8)]; }
        if (gt < 32) PAR[PAR_GBIAS + gt] = b_in[(size_t)(gt >> 3) * INW + SRC_GATE + (gt & 7)];
        if (gt < D) { PAR[PAR_ONE + gt] = 1.f; PAR[PAR_ZERO + gt] = 0.f; }
#define CPY(dst, src, n) do { const float* _s = (src); for (int i = gt; i < (n); i += ngt) PAR[(dst) + i] = _s[i]; } while (0)
        CPY(PAR_GWS, args.in[8], DEPTH * 8 * 128 * 128); CPY(PAR_GLNG, args.in[6], DEPTH * 1024); CPY(PAR_GLNB, args.in[7], DEPTH * 1024); CPY(PAR_GBS, args.in[9], DEPTH * 8 * 128);
        CPY(PAR_CONVW, args.in[10], DEPTH * 4 * 2048); CPY(PAR_CONVB, args.in[11], DEPTH * 2048); CPY(PAR_MNG, args.in[12], DEPTH * 2048);
        CPY(PAR_LN1G, args.in[18], DEPTH * D); CPY(PAR_LN1B, args.in[19], DEPTH * D); CPY(PAR_LN2G, args.in[22], DEPTH * D); CPY(PAR_LN2B, args.in[23], DEPTH * D);
#undef CPY
        { const float* gws = args.in[8];
          for (int i = gt; i < DEPTH * 8 * 16384; i += ngt) { const int lg = i >> 14, f = (i >> 9) & 31, ln = (i >> 3) & 63, j = i & 7; const int t = 16 * (f >> 2) + (ln & 15), sx = 32 * (f & 3) + 8 * (ln >> 4) + j;
              WF32[i] = (sx <= t) ? gws[((size_t)lg * 128 + t) * 128 + sx] : 0.f; }
          for (int i = gt; i < DEPTH * 8 * 128; i += ngt) { const int t = i & 127; const float* wr_ = gws + (size_t)i * 128; float sm = 0.f; for (int sx = 0; sx <= t; ++sx) sm += wr_[sx]; C2A[i] = sm; } }
        for (int i = gt; i < DEPTH * D * 256; i += ngt) { const int l = i / (D * 256), k = (i / 256) % D, c4 = (i & 255) * 4; const f32x4 v = *(const f32x4*)(w_in + ((size_t)l * D + k) * INW + 8200 + c4);
            u32x2 o; o.x = pk2(v.x, v.y); o.y = pk2(v.z, v.w); *(u32x2*)(WQN + ((size_t)l * D + k) * 1024 + c4) = o; }
        for (int i = gt; i < DEPTH * 1024; i += ngt) PAR[PAR_BQ + i] = b_in[(size_t)(i >> 10) * INW + 8200 + (i & 1023)];
        for (int m = F.gw; m < NBATCH * MEMLEN; m += F.ngw) row_pass(args.in[1] + (size_t)m * D, true, args.in[2], args.in[3], nullptr, MEMN + (size_t)m * D, nullptr, nullptr, nullptr, F.lane);
        __syncthreads();
        { LAS float* wg = (LAS float*)F.lds;
          for (int i = F.tid; i < 8 * D; i += 512) { const int q = i / D, k = i % D; wg[i] = w_in[(size_t)k * INW + SRC_GATE + q]; }
          __syncthreads();
          { f32x4 va[8], vb[8]; int m = F.gw; row_load(x_in + (size_t)m * D, va, F.lane);
            for (; m < T; m += F.ngw) { const int mn = (m + F.ngw < T) ? m + F.ngw : m; row_load(x_in + (size_t)mn * D, vb, F.lane);
                row_finish(va, false, nullptr, nullptr, PF + (size_t)m * D, XB + (size_t)m * D, wg, b_in + SRC_GATE, GATES + (size_t)m * 8, F.lane); if (F.lane == 0) { STAT[2 * m] = 0.f; STAT[2 * m + 1] = 1.f; }
#pragma unroll
                for (int j = 0; j < 8; ++j) va[j] = vb[j]; } }
          __syncthreads(); }
    }
    SEAM(0);
    if (IN(1)) {
        PHASE_CTX
        if (F.bid < 64) { pg8::GemmStd<D, D, D> g{MEMN, WKT}; pg8::StaticOrder<1024, 4096> S; S.init(64, F.bid); pg8::EpiBf16 E{KMEM, 4096};
          pg8::gemm_phase(F.lds, g, S, E, F.tid); }
        else if (F.bid < 128) { pg8::GemmStd<D, D, D> g{MEMN, WVT}; pg8::StaticOrder<1024, 4096> S; S.init(64, F.bid - 64); pg8::EpiBf16 E{VMEM, 4096};
          pg8::gemm_phase(F.lds, g, S, E, F.tid); }
    }
    SEAM(1);
    {
        PHASE_CTX
        { pg8::GemmQK g{KMEM, WQN}; pg8::StaticOrder<64 * 256, 2048> S; S.init(F.G, F.bid); pg8::EpiQK E{WQK};
          pg8::gemm_phase(F.lds, g, S, E, F.tid); }
        { pg8::GemmVW g{wsb + WS_WL, VMEM}; pg8::StaticOrder<512 * 256, 256> S; S.init(F.G, F.bid); pg8::EpiVW E{wsb};
          pg8::gemm_phase(F.lds, g, S, E, F.tid); }
        for (int i = F.bid * 512 + F.tid; i < DEPTH * 4 * 1024; i += F.G * 512) {
            const int l = i >> 12, b = (i >> 10) & 3, hm = i & 1023, h = hm >> 8, m = hm & 255;
            const bf16_t* kp = KMEM + (size_t)(b * 256 + m) * 4096 + l * 1024 + h * 256; const float* bq = PAR + PAR_BQ + l * 1024 + h * 256; float sm = 0.f;
            for (int d8 = 0; d8 < 256; d8 += 8) { const u32x4 kv = *(const u32x4*)(kp + d8); const f32x4 q0 = *(const f32x4*)(bq + d8), q1 = *(const f32x4*)(bq + d8 + 4);
                sm += bflo(kv.x) * q0[0] + bfhi(kv.x) * q0[1] + bflo(kv.y) * q0[2] + bfhi(kv.y) * q0[3] + bflo(kv.z) * q1[0] + bfhi(kv.z) * q1[1] + bflo(kv.w) * q1[2] + bfhi(kv.w) * q1[3]; }
            BQK[i] = sm * pg8::SCORE_SCALE; }
    }
    GRID_BAR();

    for (int lyr = 0; lyr < DEPTH; ++lyr) {
        const int pb = 2 + 10 * lyr;
#define LAYER_CTX PHASE_CTX int l = lyr; asm volatile("" : "+s"(l)); unsigned char* wl = wsb + WS_WL + (size_t)l * WL_STRIDE; (void)wl;
        if (IN(pb + 0)) {
            LAYER_CTX
            for (int ch = F.gw; ch < 1024; ch += F.ngw) {
                const int bh = ch >> 6, c = ch & 63, b = bh >> 2, h = bh & 3;
                const size_t row = (size_t)b * SEQ + 64 * c + F.lane;
                const float gi = GATES[row * 8 + h], gf = GATES[row * 8 + 4 + h];
                float bc = fminf(gf, 0.f) - log1pf(expf(-fabsf(gf)));
#pragma unroll
                for (int o = 1; o < 64; o <<= 1) { const float y = shup(bc, o, F.lane); if (F.lane >= o) bc += y; }
                const float bv = gi - bc; float pm = bv;
#pragma unroll
                for (int o = 1; o < 64; o <<= 1) { const float y = shup(pm, o, F.lane); if (F.lane >= o) pm = fmaxf(pm, y); }
                const int pos = bh * 4096 + 64 * c + F.lane;
                GS[GS_BCUM + pos] = bc; GS[GS_BV + pos] = bv; GS[GS_PMAX + pos] = pm;
                if (F.lane == 63) { GS[GS_BLAST + ch] = bc; GS[GS_MAXB + ch] = pm; }
            }
            pg8::GemmIn g{XB, (const bf16_t*)(wl + WL_IN), WQK + (size_t)l * 4 * 1024 * D}; pg8::StaticOrder<T, ZW> S; S.init(F.G, F.bid);
            pg8::EpiIn E{Z, BIN + (size_t)l * ZW, BQK + (size_t)l * 4096, (LAS float*)(F.lds + RING_BYTES)};
            pg8::gemm_phase(F.lds, g, S, E, F.tid);
        }
        SEAM(pb + 0);
        if (IN(pb + 1)) {
            LAYER_CTX
            {
                LAS bf16_t* QL = (LAS bf16_t*)F.lds; LAS bf16_t* KL = QL + 64 * 264; LAS bf16_t* PL = KL + 64 * 264;
                LAS float* WSL = (LAS float*)(PL + 64 * 72);
                LAS bf16_t* VTL = (LAS bf16_t*)(WSL + 64);
                const int w = F.wave, fr = F.lane & 15, fq = F.lane >> 4;
                u32x4 zr[11], va[8]; f32x4 cw[4][2], cb2[2]; float bl, mb;
                auto pp_load = [&](int chx) {
                    const int bhx = chx >> 6, cx = chx & 63, bx = bhx >> 2, hx = bhx & 3; const size_t row0x = (size_t)bx * SEQ + 64 * cx;
                    bl = GS[GS_BLAST + bhx * 64 + F.lane]; mb = GS[GS_MAXB + bhx * 64 + F.lane];
                    const int cg = F.tid & 63, rg = F.tid >> 6; const int chz = (cg < 32) ? hx * 256 + 8 * cg : 1024 + hx * 256 + 8 * (cg - 32);
                    const float* cwp = PAR + PAR_CONVW + l * 4 * 2048 + chz; const float* cbp = PAR + PAR_CONVB + l * 2048 + chz;
#pragma unroll
                    for (int j = 0; j < 4; ++j) { cw[j][0] = *(const f32x4*)(cwp + j * 2048); cw[j][1] = *(const f32x4*)(cwp + j * 2048 + 4); }
                    cb2[0] = *(const f32x4*)cbp; cb2[1] = *(const f32x4*)(cbp + 4);
                    const bf16_t* zp = Z + (row0x + 8 * rg) * ZW + ZQK + chz;
#pragma unroll
                    for (int k = 0; k < 11; ++k) { if (k >= 3 || rg > 0 || cx > 0) zr[k] = *(const u32x4*)(zp + (ptrdiff_t)(k - 3) * ZW); else zr[k] = (u32x4){0u, 0u, 0u, 0u}; }
                    const int sx = F.tid & 63, cq = F.tid >> 6; const bf16_t* vp = Z + (row0x + sx) * ZW + ZVM + hx * 512 + 64 * cq;
#pragma unroll
                    for (int q = 0; q < 8; ++q) va[q] = *(const u32x4*)(vp + 8 * q);
                };
                pp_load(F.bid);
                for (int ch = F.bid; ch < 1024; ch += F.G) {
                    const int bh = ch >> 6, c = ch & 63, b = bh >> 2, h = bh & 3; const size_t row0 = (size_t)b * SEQ + 64 * c; const int pos0 = bh * 4096 + 64 * c;
                    float mp = 0.f;
                    for (int cc = 0; cc < c; ++cc) mp = rdlane(bl, cc) + fmaxf(mp, rdlane(mb, cc));
                    const float mm = fmaxf(mp, GS[GS_MAXB + ch]);
                    if (F.tid == 0) GS[GS_MPREV + ch] = mp;
                    if (F.tid < 64) { WSL[F.tid] = expf(GS[GS_BV + pos0 + F.tid] - mm); WIG[(size_t)ch * 256 + F.tid] = expf(mp - fmaxf(GS[GS_PMAX + pos0 + F.tid], mp)); }
                    if (F.tid == 64) WIG[(size_t)ch * 256 + 64] = expf(mp - mm);
                    {
                      const int cg = F.tid & 63, rg = F.tid >> 6;
                      const float osc = (cg < 32) ? 1.0f : 0.0625f;
                      f32x4 zf[11][2];
#pragma unroll
                      for (int k = 0; k < 11; ++k) { zf[k][0] = (f32x4){bflo(zr[k].x), bfhi(zr[k].x), bflo(zr[k].y), bfhi(zr[k].y)}; zf[k][1] = (f32x4){bflo(zr[k].z), bfhi(zr[k].z), bflo(zr[k].w), bfhi(zr[k].w)}; }
                      LAS bf16_t* dst = ((cg < 32) ? QL : KL) + (8 * rg) * 264 + 8 * (cg & 31);
#pragma unroll
                      for (int rr = 0; rr < 8; ++rr) { f32x4 y0 = cb2[0], y1 = cb2[1];
#pragma unroll
                          for (int j = 0; j < 4; ++j) { y0 += cw[j][0] * zf[rr + j][0]; y1 += cw[j][1] * zf[rr + j][1]; }
#pragma unroll
                          for (int e = 0; e < 4; ++e) { y0[e] = y0[e] * fast_sigmoid(y0[e]) * osc; y1[e] = y1[e] * fast_sigmoid(y1[e]) * osc; }
                          u32x4 o; o.x = cvt_pk_bf16(y0[0], y0[1]); o.y = cvt_pk_bf16(y0[2], y0[3]); o.z = cvt_pk_bf16(y1[0], y1[1]); o.w = cvt_pk_bf16(y1[2], y1[3]);
                          *(LAS u32x4*)(dst + rr * 264) = o; } }
                    {
                      const int sx = F.tid & 63, cq = F.tid >> 6;
#pragma unroll
                      for (int q = 0; q < 8; ++q) { const u32x4 a = va[q]; LAS bf16_t* d0 = VTL + (64 * cq + 8 * q) * 72 + sx;
                          d0[0] = (bf16_t)(a.x & 0xffffu); d0[72] = (bf16_t)(a.x >> 16); d0[2 * 72] = (bf16_t)(a.y & 0xffffu); d0[3 * 72] = (bf16_t)(a.y >> 16);
                          d0[4 * 72] = (bf16_t)(a.z & 0xffffu); d0[5 * 72] = (bf16_t)(a.z >> 16); d0[6 * 72] = (bf16_t)(a.w & 0xffffu); d0[7 * 72] = (bf16_t)(a.w >> 16); } }
                    pp_load(ch + F.G < 1024 ? ch + F.G : ch);
                    __syncthreads();
                    const int tb = w >> 1, half = w & 1;
                    bf16x8 qa[8];
#pragma unroll
                    for (int i = 0; i < 8; ++i) qa[i] = *(const LAS bf16x8*)(QL + (16 * tb + fr) * 264 + 32 * i + 8 * fq);
                    { bf16_t* qf = QF + ((size_t)ch * 32 + tb * 8 + 4 * half) * 512 + F.lane * 8;
                      const float wir = expf(mp - fmaxf(GS[GS_PMAX + pos0 + 16 * tb + fr], mp));
#pragma unroll
                      for (int ii = 0; ii < 4; ++ii) { const int i = 4 * half + ii; const LAS bf16_t* qp = QL + (16 * tb + fr) * 264 + 32 * i + 4 * fq;
                          u32x4 o; const u32x2 lo = *(const LAS u32x2*)qp, hi = *(const LAS u32x2*)(qp + 16);
                          o.x = cvt_pk_bf16(bflo(lo.x) * wir, bfhi(lo.x) * wir); o.y = cvt_pk_bf16(bflo(lo.y) * wir, bfhi(lo.y) * wir); o.z = cvt_pk_bf16(bflo(hi.x) * wir, bfhi(hi.x) * wir); o.w = cvt_pk_bf16(bflo(hi.y) * wir, bfhi(hi.y) * wir);
                          *(u32x4*)(qf + ii * 512) = o; } }
                    const f32x4 pm4 = *(const f32x4*)(GS + GS_PMAX + pos0 + 16 * tb + 4 * fq);
#pragma unroll
                    for (int sbi = 0; sbi < 2; ++sbi) { const int sb = 2 * half + sbi; f32x4 acc = (f32x4){0.f, 0.f, 0.f, 0.f};
                        if (sb <= tb) {
#pragma unroll
                            for (int i = 0; i < 8; ++i) { const bf16x8 kb = *(const LAS bf16x8*)(KL + (16 * sb + fr) * 264 + 32 * i + 8 * fq); acc = mfma16(qa[i], kb, acc); }
                            const float Bs = GS[GS_BV + pos0 + 16 * sb + fr]; const int sx = 16 * sb + fr;
#pragma unroll
                            for (int r = 0; r < 4; ++r) { const int t = 16 * tb + 4 * fq + r; const float At = -fmaxf(pm4[r], mp); acc[r] = (sx <= t) ? expf(At + Bs) * acc[r] : 0.f; } }
#pragma unroll
                        for (int r = 0; r < 4; ++r) PL[(16 * tb + 4 * fq + r) * 72 + 16 * sb + fr] = (bf16_t)f2bf(acc[r]); }
                    __syncthreads();
                    { const int i = w & 1; const bf16x8 pf = *(const LAS bf16x8*)(PL + (16 * tb + fr) * 72 + 32 * i + 8 * fq);
                      *(bf16x8*)(PFR + ((size_t)ch * 8 + tb * 2 + i) * 512 + F.lane * 8) = pf; }
#pragma unroll
                    for (int dbi = 0; dbi < 2; ++dbi)
#pragma unroll
                        for (int i = 0; i < 2; ++i) { const int db = 2 * w + dbi; float kv[8];
#pragma unroll
                            for (int j = 0; j < 8; ++j) { const int sx = 32 * i + 8 * fq + j; kv[j] = WSL[sx] * bf2f(KL[sx * 264 + 16 * db + fr]); }
                            u32x4 o; o.x = pk2(kv[0], kv[1]); o.y = pk2(kv[2], kv[3]); o.z = pk2(kv[4], kv[5]); o.w = pk2(kv[6], kv[7]);
                            *(u32x4*)(KF + ((size_t)ch * 32 + db * 2 + i) * 512 + F.lane * 8) = o; }
#pragma unroll
                    for (int vi = 0; vi < 4; ++vi)
#pragma unroll
                        for (int i = 0; i < 2; ++i) { const int vblk = 4 * w + vi; const u32x4 o = *(const LAS u32x4*)(VTL + (16 * vblk + fr) * 72 + 32 * i + 8 * fq);
                            *(u32x4*)(VF + ((size_t)ch * 64 + vblk * 2 + i) * 512 + F.lane * 8) = o; }
                    __syncthreads();
                }
            }
            for (int m0 = F.gw * 8; m0 < T; m0 += F.ngw * 8) {
                u32x4 ra[8], rbv[8];
#pragma unroll
                for (int rr = 0; rr < 8; ++rr) { const bf16_t* vp = Z + (size_t)(m0 + rr) * ZW + ZV; ra[rr] = *(const u32x4*)(vp + 8 * F.lane); rbv[rr] = *(const u32x4*)(vp + 512 + 8 * F.lane); }
                float s1[8], s2[8];
#pragma unroll
                for (int rr = 0; rr < 8; ++rr) { const u32x4 a = ra[rr], b = rbv[rr];
                    const float e[16] = {bflo(a.x), bfhi(a.x), bflo(a.y), bfhi(a.y), bflo(a.z), bfhi(a.z), bflo(a.w), bfhi(a.w), bflo(b.x), bfhi(b.x), bflo(b.y), bfhi(b.y), bflo(b.z), bfhi(b.z), bflo(b.w), bfhi(b.w)};
                    float t1 = 0.f, t2 = 0.f;
#pragma unroll
                    for (int j = 0; j < 16; ++j) { t1 += e[j]; t2 += e[j] * e[j]; }
                    s1[rr] = t1; s2[rr] = t2; }
#pragma unroll
                for (int rr = 0; rr < 8; ++rr) { s1[rr] = wave_sum(s1[rr], F.lane); s2[rr] = wave_sum(s2[rr], F.lane); }
#pragma unroll
                for (int rr = 0; rr < 8; ++rr) { const float mean = s1[rr] * (1.f / 1024.f); const float var = fmaxf(s2[rr] * (1.f / 1024.f) - mean * mean, 0.f);
                    if (F.lane == 0) { VSTAT[2 * (m0 + rr)] = mean; VSTAT[2 * (m0 + rr) + 1] = 1.f / sqrtf(var + LN_EPS); } }
            }
        }
        SEAM(pb + 1);
        {
            LAYER_CTX
            if (F.bid < 80) {
            LAS unsigned char* RG = F.lds;
            const int w = F.wave, fr = F.lane & 15, fq = F.lane >> 4;
            const bool is_den = F.bid >= 64;
            const int it = is_den ? F.bid - 64 : F.bid;
            const int bh = is_den ? (it & 7) * 2 + (it >> 3) : (it & 7) * 2 + (it >> 5), jq = is_den ? 0 : (it >> 3) & 3, b = bh >> 2, h = bh & 3;
            const bool active = w < 4 && (!is_den || w == 0);
            bf16x8 ones; { const short o1 = (fr == 0) ? (short)0x3f80 : (short)0; ones = (bf16x8){o1, o1, o1, o1, o1, o1, o1, o1}; }
            const int lo8 = F.lane * 8;
            f32x4 CA[16], CB[16];
#pragma unroll
            for (int i = 0; i < 16; ++i) { CA[i] = (f32x4){0.f, 0.f, 0.f, 0.f}; CB[i] = (f32x4){0.f, 0.f, 0.f, 0.f}; }
            bf16x8 vA[2], vB[2];
            vA[0] = ones; vA[1] = ones; vB[0] = ones; vB[1] = ones;
            float* const dmy = (float*)(wsb + WS_DUMMY) + ((size_t)F.bid * 512 + F.tid) * 4;
#define SC_DMA(c_, sl_) do { const size_t chh = (size_t)bh * 64 + (c_); int wd_ = w - 4; asm volatile("" : "+s"(wd_));        \
                _Pragma("unroll") for (int i = 0; i < 18; ++i) { const int p_ = 18 * wd_ + i; \
                    const bf16_t* src_ = (p_ < 32) ? QF + (chh * 32 + p_) * 512 : (p_ < 40) ? PFR + (chh * 8 + (p_ - 32)) * 512 : KF + (chh * 32 + (p_ - 40)) * 512; \
                    __builtin_amdgcn_global_load_lds((const unsigned*)(src_ + lo8), (LAS unsigned*)(RG + (sl_) * 74752 + p_ * 1024), 16, 0, 0); } \
                if (wd_ == 0) { int l4_ = lo8; asm volatile("" : "+v"(l4_)); l4_ >>= 1; __builtin_amdgcn_global_load_lds((const unsigned*)(WIG + chh * 256 + l4_), (LAS unsigned*)(RG + (sl_) * 74752 + 72 * 1024), 16, 0, 0); } } while (0)
#define SC_LOADV(c_) do { if (active && !is_den) { const bf16_t* v_ = VF + (((size_t)bh * 64 + (c_)) * 64 + (8 * jq + 2 * w) * 2) * 512 + lo8; \
                vA[0] = *(const bf16x8*)v_; vA[1] = *(const bf16x8*)(v_ + 512); vB[0] = *(const bf16x8*)(v_ + 1024); vB[1] = *(const bf16x8*)(v_ + 1536); } } while (0)
#define SC_SB __builtin_amdgcn_sched_barrier(0)
#define SC_RD4(dst, p0, p1, p2, p3) do { dst[0] = *(const LAS bf16x8*)(sb_ + (p0) * 1024); dst[1] = *(const LAS bf16x8*)(sb_ + (p1) * 1024); dst[2] = *(const LAS bf16x8*)(sb_ + (p2) * 1024); dst[3] = *(const LAS bf16x8*)(sb_ + (p3) * 1024); SC_SB; } while (0)
#define SC_W4 do { asm volatile("s_waitcnt lgkmcnt(4)" ::: "memory"); SC_SB; } while (0)
#define SC_INTER2(j, cur) do { \
                { const bf16x8 ca_ = pack8(CA[4 * (j)], CA[4 * (j) + 1]), cb_ = pack8(CB[4 * (j)], CB[4 * (j) + 1]); a0A = mfma16(cur[0], ca_, a0A); a0B = mfma16(cur[0], cb_, a0B); a1A = mfma16(cur[2], ca_, a1A); a1B = mfma16(cur[2], cb_, a1B); } \
                { const bf16x8 ca_ = pack8(CA[4 * (j) + 2], CA[4 * (j) + 3]), cb_ = pack8(CB[4 * (j) + 2], CB[4 * (j) + 3]); a0A = mfma16(cur[1], ca_, a0A); a0B = mfma16(cur[1], cb_, a0B); a1A = mfma16(cur[3], ca_, a1A); a1B = mfma16(cur[3], cb_, a1B); } SC_SB; } while (0)
#define SC_INTRA2(cur) do { a0A = mfma16(cur[0], vA[0], a0A); a0B = mfma16(cur[0], vB[0], a0B); a1A = mfma16(cur[2], vA[0], a1A); a1B = mfma16(cur[2], vB[0], a1B); \
                a0A = mfma16(cur[1], vA[1], a0A); a0B = mfma16(cur[1], vB[1], a0B); a1A = mfma16(cur[3], vA[1], a1A); a1B = mfma16(cur[3], vB[1], a1B); SC_SB; } while (0)
#define SC_OUT(p) do { if (!is_den) { bf16_t* hp = HRAW + (row0 + 32 * (p)) * 2048 + h * 512 + 128 * jq + 32 * w + ((4 * fq) * 2048 + fr); \
                    _Pragma("unroll") for (int r = 0; r < 4; ++r) { hp[r * 2048] = (bf16_t)f2bf(a0A[r]); hp[r * 2048 + 16] = (bf16_t)f2bf(a0B[r]); hp[(16 + r) * 2048] = (bf16_t)f2bf(a1A[r]); hp[(16 + r) * 2048 + 16] = (bf16_t)f2bf(a1B[r]); } } \
                else { float* dp = (fr == 0) ? DEN + (row0 + 32 * (p)) * 4 + h + (4 * fq) * 4 : dmy; const int ds_ = (fr == 0) ? 4 : 0; \
                    _Pragma("unroll") for (int r = 0; r < 4; ++r) { dp[r * ds_] = a0A[r]; dp[(16 + r) * ds_] = a1A[r]; } } \
                SC_SB; } while (0)
#define SC_ZERO do { a0A = (f32x4){0.f, 0.f, 0.f, 0.f}; a0B = a0A; a1A = a0A; a1B = a0A; } while (0)
#define SC_UPD(u, cur) do { f32x4 t0_ = scale4(CA[2 * (u)], dec), t1_ = scale4(CB[2 * (u)], dec), t2_ = scale4(CA[2 * (u) + 1], dec), t3_ = scale4(CB[2 * (u) + 1], dec); \
                t0_ = mfma16(cur[0], vA[0], t0_); t1_ = mfma16(cur[0], vB[0], t1_); t2_ = mfma16(cur[2], vA[0], t2_); t3_ = mfma16(cur[2], vB[0], t3_); \
                CA[2 * (u)] = mfma16(cur[1], vA[1], t0_); CB[2 * (u)] = mfma16(cur[1], vB[1], t1_); CA[2 * (u) + 1] = mfma16(cur[3], vA[1], t2_); CB[2 * (u) + 1] = mfma16(cur[3], vB[1], t3_); SC_SB; } while (0)
#define SC_STEP(c_, sl_, cn_, sn_) do { const size_t row0 = (size_t)b * SEQ + 64 * (c_); \
                const LAS unsigned char* sb_ = RG + (sl_) * 74752 + F.lane * 16; const LAS float* wip_ = (const LAS float*)(RG + (sl_) * 74752 + 72 * 1024); \
                if (active) { \
                const float dec = wip_[64]; \
                f32x4 a0A, a0B, a1A, a1B; bf16x8 fa[4], fb[4]; \
                SC_ZERO; \
                SC_RD4(fa, 0, 1, 8, 9); \
                SC_RD4(fb, 2, 3, 10, 11); SC_W4; SC_INTER2(0, fa); \
                SC_RD4(fa, 4, 5, 12, 13); SC_W4; SC_INTER2(1, fb); \
                SC_RD4(fb, 6, 7, 14, 15); SC_W4; SC_INTER2(2, fa); \
                SC_RD4(fa, 32, 33, 34, 35); SC_W4; SC_INTER2(3, fb); \
                SC_RD4(fb, 16, 17, 24, 25); SC_W4; SC_INTRA2(fa); SC_OUT(0); SC_ZERO; \
                _Pragma("unroll") for (int i = 0; i < 16; ++i) asm volatile("" : "+v"(CA[i]), "+v"(CB[i]));        \
                SC_RD4(fa, 18, 19, 26, 27); SC_W4; SC_INTER2(0, fb); \
                SC_RD4(fb, 20, 21, 28, 29); SC_W4; SC_INTER2(1, fa); \
                SC_RD4(fa, 22, 23, 30, 31); SC_W4; SC_INTER2(2, fb); \
                SC_RD4(fb, 36, 37, 38, 39); SC_W4; SC_INTER2(3, fa); \
                SC_RD4(fa, 40, 41, 42, 43); SC_W4; SC_INTRA2(fb); SC_OUT(1); \
                SC_RD4(fb, 44, 45, 46, 47); SC_W4; SC_UPD(0, fa); \
                SC_RD4(fa, 48, 49, 50, 51); SC_W4; SC_UPD(1, fb); \
                SC_RD4(fb, 52, 53, 54, 55); SC_W4; SC_UPD(2, fa); \
                SC_RD4(fa, 56, 57, 58, 59); SC_W4; SC_UPD(3, fb); \
                SC_RD4(fb, 60, 61, 62, 63); SC_W4; SC_UPD(4, fa); \
                SC_RD4(fa, 64, 65, 66, 67); SC_W4; SC_UPD(5, fb); \
                SC_RD4(fb, 68, 69, 70, 71); SC_W4; SC_UPD(6, fa); \
                asm volatile("s_waitcnt lgkmcnt(0)" ::: "memory"); SC_SB; SC_UPD(7, fb); \
                } else if (w >= 4) { SC_DMA(cn_, sn_); asm volatile("" ::: "memory"); __builtin_amdgcn_s_waitcnt(0x0070); }       \
                __builtin_amdgcn_s_barrier(); asm volatile("" ::: "memory"); } while (0)
            if (w >= 4) { SC_DMA(0, 0); }
            asm volatile("" ::: "memory"); __builtin_amdgcn_s_waitcnt(0x0070); __builtin_amdgcn_s_barrier(); asm volatile("" ::: "memory");
#define SC_TRIP(c) do { { SC_LOADV((c)); SC_STEP((c), 0, (c) + 1, 1); } \
                { const int cnx_ = (c) + 2 < 64 ? (c) + 2 : 63; SC_LOADV((c) + 1); SC_STEP((c) + 1, 1, cnx_, 0); } } while (0)
#pragma nounroll
            for (int c = 0; c < 64; c += 2) SC_TRIP(c);
#undef SC_TRIP
#undef SC_STEP
#undef SC_UPD
#undef SC_ZERO
#undef SC_OUT
#undef SC_INTRA2
#undef SC_INTER2
#undef SC_W4
#undef SC_RD4
#undef SC_SB
#undef SC_LOADV
#undef SC_DMA
            asm volatile("s_waitcnt vmcnt(0)" ::: "memory");
            __syncthreads();
            } else {
            {
                LAS bf16_t* VT = (LAS bf16_t*)F.lds;
                LAS float* ST = (LAS float*)(F.lds + 128 * 136 * 2);
                LAS float* C1 = ST + 256;
                const int w = F.wave, fr = F.lane & 15, fq = F.lane >> 4, nst = (w >> 1) + 1;
                for (int un = F.bid - 80; un < 256; un += 176) {
                    const int cc = un >> 1, hf = un & 1; const size_t r0 = (size_t)cc * 128;
                    if (F.tid < 128) { const f32x2 sv = *(const f32x2*)(VSTAT + 2 * (r0 + F.tid)); ST[F.tid] = sv.x; ST[128 + F.tid] = sv.y; }
                    __syncthreads();
                    u32x4 ta[4]; f32x4 wa[4][2]; unsigned short uvA[8][4];
#pragma unroll
                    for (int i = 0; i < 4; ++i) { ta[i] = (u32x4){0u, 0u, 0u, 0u}; wa[i][0] = (f32x4){0.f, 0.f, 0.f, 0.f}; wa[i][1] = (f32x4){0.f, 0.f, 0.f, 0.f}; }
#pragma unroll
                    for (int db = 0; db < 8; ++db)
#pragma unroll
                        for (int r = 0; r < 4; ++r) uvA[db][r] = 0;
#define BRA_LOAD_TW(gi_) do { const int gq_ = 4 * hf + (gi_), lg_ = l * 8 + gq_; const bf16_t* vp = Z + (r0 + (F.tid & 127)) * ZW + ZV + gq_ * 128 + (F.tid >> 7) * 32; \
                        _Pragma("unroll") for (int q = 0; q < 4; ++q) ta[q] = *(const u32x4*)(vp + 8 * q); \
                        _Pragma("unroll") for (int i = 0; i < 4; ++i) if (i < nst) { const float* wp = WF32 + ((size_t)lg_ * 32 + w * 4 + i) * 512 + F.lane * 8; wa[i][0] = *(const f32x4*)wp; wa[i][1] = *(const f32x4*)(wp + 4); } } while (0)
#define BRA_LOAD_UV(gi_, UV) do { const bf16_t* up0 = Z + (r0 + 16 * w + 4 * fq) * ZW + ZU + (4 * hf + (gi_)) * 128 + fr; \
                        _Pragma("unroll") for (int db = 0; db < 8; ++db) _Pragma("unroll") for (int r = 0; r < 4; ++r) UV[db][r] = up0[(size_t)r * ZW + 16 * db]; } while (0)
                    BRA_LOAD_TW(0); BRA_LOAD_UV(0, uvA);
#pragma nounroll
                    for (int gi = 0; gi < 4; ++gi) { const int gq = 4 * hf + gi, lg = l * 8 + gq;
                        { const int sx = F.tid & 127, c0 = (F.tid >> 7) * 32;
#pragma unroll
                          for (int q = 0; q < 4; ++q) { const u32x4 a = ta[q]; LAS bf16_t* d0 = VT + (c0 + 8 * q) * 136 + sx;
                              d0[0] = (bf16_t)(a.x & 0xffffu); d0[136] = (bf16_t)(a.x >> 16); d0[2 * 136] = (bf16_t)(a.y & 0xffffu); d0[3 * 136] = (bf16_t)(a.y >> 16);
                              d0[4 * 136] = (bf16_t)(a.z & 0xffffu); d0[5 * 136] = (bf16_t)(a.z >> 16); d0[6 * 136] = (bf16_t)(a.w & 0xffffu); d0[7 * 136] = (bf16_t)(a.w >> 16); } }
                        bf16x8 af[4]; float c1p = 0.f;
#pragma unroll
                        for (int i = 0; i < 4; ++i) { u32x4 o = (u32x4){0u, 0u, 0u, 0u};
                            if (i < nst) { const f32x4 w0 = wa[i][0], w1 = wa[i][1];
                                const LAS float* sp = ST + 32 * i + 8 * fq; const f32x4 m0 = *(const LAS f32x4*)sp, m1 = *(const LAS f32x4*)(sp + 4), q0 = *(const LAS f32x4*)(sp + 128), q1 = *(const LAS f32x4*)(sp + 132);
                                const f32x4 p0 = w0 * q0, p1 = w1 * q1;
                                o.x = pk2(p0[0], p0[1]); o.y = pk2(p0[2], p0[3]); o.z = pk2(p1[0], p1[1]); o.w = pk2(p1[2], p1[3]);
                                c1p += bflo(o.x) * m0[0] + bfhi(o.x) * m0[1] + bflo(o.y) * m0[2] + bfhi(o.y) * m0[3] + bflo(o.z) * m1[0] + bfhi(o.z) * m1[1] + bflo(o.w) * m1[2] + bfhi(o.w) * m1[3]; }
                            af[i] = __builtin_bit_cast(bf16x8, o); }
                        c1p += shx(c1p, 16, F.lane); c1p += shx(c1p, 32, F.lane);
                        if (fq == 0) C1[w * 16 + fr] = c1p;
                        __syncthreads();
                        if (gi < 3) BRA_LOAD_TW(gi + 1);
                        const f32x4 c14 = *(const LAS f32x4*)(C1 + w * 16 + 4 * fq);
                        const f32x4 c24 = *(const f32x4*)(C2A + lg * 128 + 16 * w + 4 * fq), bs4 = *(const f32x4*)(PAR + PAR_GBS + lg * 128 + 16 * w + 4 * fq);
#pragma unroll
                        for (int db = 0; db < 8; ++db) { f32x4 acc = (f32x4){0.f, 0.f, 0.f, 0.f};
#pragma unroll
                            for (int i = 0; i < 4; ++i) if (i < nst) { const bf16x8 bb = *(const LAS bf16x8*)(VT + (16 * db + fr) * 136 + 32 * i + 8 * fq); acc = mfma16(af[i], bb, acc); }
                            const int dcol = gq * 128 + 16 * db + fr; const float gg = PAR[PAR_GLNG + l * 1024 + dcol], bbv = PAR[PAR_GLNB + l * 1024 + dcol];
                            bf16_t* up = Z + (r0 + 16 * w + 4 * fq) * ZW + ZU + dcol;
#pragma unroll
                            for (int r = 0; r < 4; ++r) { const float mixed = gg * (acc[r] - c14[r]) + bbv * c24[r] + bs4[r]; up[(size_t)r * ZW] = (bf16_t)f2bf(bf2f(uvA[db][r]) * mixed); } }
                        asm volatile("" ::: "memory");
                        if (gi < 3) BRA_LOAD_UV(gi + 1, uvA);
                        __syncthreads();
                    }
#undef BRA_LOAD_TW
#undef BRA_LOAD_UV
                }
            }
                __syncthreads();
                { pg8::GemmT<ZW, 1024, 1024, 256L * ZW, 0L, 2048L * 1024, 256L * 1024> g{Z + ZQX, (const bf16_t*)(wsb + (l < 2 ? WS_VW01 + (size_t)l * 16 * MiB : WS_VW23 + (size_t)(l - 2) * 16 * MiB))};
                  pg8::StaticOrder<T, D> S; S.init(176, F.bid - 80); pg8::EpiGate<0> E{Z + ZG + 4096, MRG};
                  pg8::gemm_phase(F.lds, g, S, E, F.tid); }
            }
        }
        GRID_BAR();
        if (IN(pb + 2)) {
            LAYER_CTX
            for (int it0 = F.gw; it0 < T * 4; it0 += 4 * F.ngw) {
                u32x4 hw[4], ow[4]; float g0_[4], g1_[4], g2_[4], dnr[4]; f32x4 ga[4], gb[4];
#pragma unroll
                for (int q = 0; q < 4; ++q) { const int it = it0 + q * F.ngw; const size_t r = (size_t)(it >> 2); const int hq = it & 3; const int c0 = hq * 512 + 8 * F.lane;
                    hw[q] = *(const u32x4*)(HRAW + r * 2048 + c0); ow[q] = *(const u32x4*)(Z + r * ZW + ZO + c0);
                    const int bh = (int)(r >> 12) * 4 + hq, tp = (int)(r & 4095), pos = bh * 4096 + tp;
                    g0_[q] = GS[GS_BCUM + pos]; g1_[q] = GS[GS_PMAX + pos]; g2_[q] = GS[GS_MPREV + bh * 64 + (tp >> 6)]; dnr[q] = DEN[r * 4 + hq];
                    ga[q] = *(const f32x4*)(PAR + PAR_MNG + l * 2048 + c0); gb[q] = *(const f32x4*)(PAR + PAR_MNG + l * 2048 + c0 + 4); }
#pragma unroll
                for (int q = 0; q < 4; ++q) { const int it = it0 + q * F.ngw; const size_t r = (size_t)(it >> 2); const int hq = it & 3; const int c0 = hq * 512 + 8 * F.lane;
                    f32x4 a = (f32x4){bflo(hw[q].x), bfhi(hw[q].x), bflo(hw[q].y), bfhi(hw[q].y)}, b4 = (f32x4){bflo(hw[q].z), bfhi(hw[q].z), bflo(hw[q].w), bfhi(hw[q].w)};
                    { const float mrow = g0_[q] + fmaxf(g1_[q], g2_[q]); const float dn = 1.f / fmaxf(fabsf(dnr[q]), expf(-mrow)); a = a * dn; b4 = b4 * dn; }
                    const float mean = wave_sum((a.x + a.y) + (a.z + a.w) + (b4.x + b4.y) + (b4.z + b4.w), F.lane) * (1.f / 512.f);
                    const f32x4 da = a - mean, db = b4 - mean;
                    const float var = wave_sum((da.x * da.x + da.y * da.y) + (da.z * da.z + da.w * da.w) + (db.x * db.x + db.y * db.y) + (db.z * db.z + db.w * db.w), F.lane) * (1.f / 512.f);
                    const float rstd = 1.f / sqrtf(var + LN_EPS);
                    const f32x4 ya = da * rstd * ga[q], yb = db * rstd * gb[q]; const u32x4 o4 = ow[q];
                    u32x4 w; w.x = pk2(ya.x * bflo(o4.x), ya.y * bfhi(o4.x)); w.y = pk2(ya.z * bflo(o4.y), ya.w * bfhi(o4.y)); w.z = pk2(yb.x * bflo(o4.z), yb.y * bfhi(o4.z)); w.w = pk2(yb.z * bflo(o4.w), yb.w * bfhi(o4.w));
                    *(u32x4*)(Z + r * ZW + ZO + c0) = w; }
            }
        }
        SEAM(pb + 2);
        if (IN(pb + 4)) {
            LAYER_CTX
            { pg8::GemmStd<ZW, 1024, 1024> g{Z + ZU, (const bf16_t*)(wl + WL_PA)}; pg8::StaticOrder<T, D> S; S.init(F.G, F.bid); pg8::EpiGate<1> E{Z + ZG, MRG};
              pg8::gemm_phase(F.lds, g, S, E, F.tid); }
            { pg8::GemmStd<ZW, 2048, 2048> g{Z + ZO, (const bf16_t*)(wl + WL_PB)}; pg8::StaticOrder<T, D> S; S.init(F.G, F.bid); pg8::EpiGate<1> E{Z + ZG + 2048, MRG};
              pg8::gemm_phase(F.lds, g, S, E, F.tid); }
        }
        SEAM(pb + 4);
        if (IN(pb + 5)) {
            LAYER_CTX
            pg8::GemmStd<D, D, D> g{MRG, (const bf16_t*)(wl + WL_OUT)}; pg8::StaticOrder<T, D> S; S.init(F.G, F.bid);
            pg8::EpiResid E{PF, STAT, l ? PAR + PAR_LN2G + (l - 1) * D : PAR + PAR_ONE, l ? PAR + PAR_LN2B + (l - 1) * D : PAR + PAR_ZERO};
            pg8::gemm_phase(F.lds, g, S, E, F.tid);
        }
        SEAM(pb + 5);
        if (IN(pb + 6)) {
            LAYER_CTX
            { f32x4 va[8], vb[8]; int m = F.gw; row_load(PF + (size_t)m * D, va, F.lane);
              for (; m < T; m += F.ngw) { const int mn = (m + F.ngw < T) ? m + F.ngw : m; row_load(PF + (size_t)mn * D, vb, F.lane);
                  row_finish(va, true, PAR + PAR_LN1G + l * D, PAR + PAR_LN1B + l * D, nullptr, XB + (size_t)m * D, nullptr, nullptr, nullptr, F.lane, STAT + 2 * (size_t)m);
#pragma unroll
                  for (int j = 0; j < 8; ++j) va[j] = vb[j]; } }
        }
        SEAM(pb + 6);
        if (IN(pb + 7)) {
            LAYER_CTX
            pg8::GemmStd<D, D, D> g{XB, (const bf16_t*)(wl + WL_GU)}; pg8::StaticOrder<T, 2 * FF> S; S.init(F.G, F.bid); pg8::EpiSwiglu E{HFF};
            pg8::gemm_phase(F.lds, g, S, E, F.tid);
        }
        SEAM(pb + 7);
        if (IN(pb + 8)) {
            LAYER_CTX
            pg8::GemmStd<FF, FF, FF> g{HFF, (const bf16_t*)(wl + WL_DN)}; pg8::StaticOrder<T, D> S; S.init(F.G, F.bid); pg8::EpiResid E{PF, STAT, PAR + PAR_LN1G + l * D, PAR + PAR_LN1B + l * D};
            pg8::gemm_phase(F.lds, g, S, E, F.tid);
        }
        SEAM(pb + 8);
        if (IN(pb + 9)) {
            LAYER_CTX
            const bool lastl = (l == DEPTH - 1);
            if (!lastl) load_gate_w(F, WG + (size_t)(l + 1) * 8 * D);
            { f32x4 va[8], vb[8]; int m = F.gw; row_load(PF + (size_t)m * D, va, F.lane);
              for (; m < T; m += F.ngw) { const int mn = (m + F.ngw < T) ? m + F.ngw : m; row_load(PF + (size_t)mn * D, vb, F.lane);
                  row_finish(va, true, PAR + PAR_LN2G + l * D, PAR + PAR_LN2B + l * D, lastl ? args.out + (size_t)m * D : nullptr, lastl ? nullptr : XB + (size_t)m * D,
                             (const LAS float*)F.lds, lastl ? nullptr : PAR + PAR_GBIAS + (l + 1) * 8, lastl ? nullptr : GATES + (size_t)m * 8, F.lane, STAT + 2 * (size_t)m);
#pragma unroll
                  for (int j = 0; j < 8; ++j) va[j] = vb[j]; } }
            __syncthreads();
        }
        if (lyr != DEPTH - 1) GRID_BAR();
    }
#undef IN
#undef SEAM
#undef GRID_BAR
#undef PHASE_CTX
#undef LAYER_CTX
#undef WG
#undef BIN
#undef GATES
#undef STAT
#undef MEMN
#undef KMEM
#undef VMEM
#undef WQK
#undef WQN
#undef BQK
#undef WKT
#undef WVT
#undef PAR
#undef XF
#undef PF
#undef XB
#undef Z
#undef HFF
#undef MRG
#undef HRAW
#undef QF
#undef KF
#undef PFR
#undef VF
#undef GS
#undef DEN
#undef VSTAT
#undef WIG
#undef WF32
#undef C2A
}

extern "C" void kernel_launch(void* const* d_in, const int* in_sizes, int n_in, void* d_out, int out_size, void* d_ws, size_t ws_size, hipStream_t stream) {
    static int grid = 0;
    if (grid == 0) {
        if (n_in != 24 || out_size != T * D || ws_size < WS_END) { fprintf(stderr, "kernel_launch: unexpected shapes (n_in %d, out %d, ws %zu < %zu)\n", n_in, out_size, ws_size, (size_t)WS_END); grid = -1; return; }
        int dev = 0, cus = 0, per_cu = 0;
        if (hipGetDevice(&dev) != hipSuccess || hipDeviceGetAttribute(&cus, hipDeviceAttributeMultiprocessorCount, dev) != hipSuccess) { grid = -1; return; }
        if (hipFuncSetAttribute((const void*)fwd_kernel, hipFuncAttributeMaxDynamicSharedMemorySize, LDS_BYTES) != hipSuccess) { fprintf(stderr, "kernel_launch: hipFuncSetAttribute failed\n"); grid = -1; return; }
        if (hipOccupancyMaxActiveBlocksPerMultiprocessor(&per_cu, (const void*)fwd_kernel, 512, LDS_BYTES) != hipSuccess || per_cu < 1) fprintf(stderr, "kernel_launch: occupancy query says %d\n", per_cu);
        (void)hipGetLastError();
        grid = cus;
    }
    if (grid < 0) return;
    (void)hipMemsetAsync((char*)d_ws + WS_CTL, 0, CTL_ZERO_BYTES, stream);
    Args a{};
    for (int i = 0; i < 24; ++i) a.in[i] = (const float*)d_in[i];
    a.out = (float*)d_out; a.ws = (unsigned char*)d_ws;
    constexpr int NPH = 2 + 10 * DEPTH;
#if MK_PER_PHASE
    for (int p = 0; p < NPH; ++p) { a.ph_lo = p; a.ph_hi = p + 1; hipLaunchKernelGGL(fwd_kernel, dim3(grid), dim3(512), LDS_BYTES, stream, a); }
#else
    a.ph_lo = 0; a.ph_hi = NPH;
    hipLaunchKernelGGL(fwd_kernel, dim3(grid), dim3(512), LDS_BYTES, stream, a);
#endif
    const hipError_t le = hipPeekAtLastError();
    if (le != hipSuccess) fprintf(stderr, "kernel_launch: launch failed: %s\n", hipGetErrorName(le));
}
```

```cpp
#include <hip/hip_runtime.h>
#include <cstdio>
#include <cstdint>

#ifndef MK_PER_PHASE
#define MK_PER_PHASE 0
#endif

#define LAS __attribute__((address_space(3)))
#define GAS __attribute__((address_space(1)))
typedef unsigned short bf16_t;
typedef short bf16x8 __attribute__((ext_vector_type(8)));
typedef float f32x4 __attribute__((ext_vector_type(4)));
typedef float f32x2 __attribute__((ext_vector_type(2)));
typedef unsigned u32x4 __attribute__((ext_vector_type(4)));
typedef unsigned u32x2 __attribute__((ext_vector_type(2)));

constexpr int T = 16384, D = 2048, SEQ = 4096, NBATCH = 4, DEPTH = 4, MEMLEN = 256;
constexpr int INW = 15368, ZW = 15360, FF = 5632;
constexpr int ZU = 0, ZV = 1024, ZQK = 2048, ZVM = 4096, ZO = 6144, ZQX = 8192, ZG = 9216;
constexpr int SRC_GATE = 8192;
constexpr float LN_EPS = 1e-5f;
constexpr float ALPHA = 1.681792830507429f;

constexpr size_t MiB = 1u << 20;
constexpr size_t WS_CTL = 0, CTL_ZERO_BYTES = 1 * MiB;
constexpr size_t WS_WG = 1 * MiB;
constexpr size_t WS_BIN = 2 * MiB;
constexpr size_t WS_GATES = 3 * MiB;
constexpr size_t WS_STAT = 3 * MiB + 512 * 1024;
constexpr size_t WS_MEMN = 4 * MiB;
constexpr size_t WS_KMEM = 8 * MiB;
constexpr size_t WS_VMEM = 16 * MiB;
constexpr size_t WS_PAR = 24 * MiB;
constexpr int PAR_GWS = 0, PAR_GLNG = 524288, PAR_GLNB = 528384, PAR_GBS = 532480, PAR_CONVW = 536576, PAR_CONVB = 569344, PAR_MNG = 577536,
              PAR_LN1G = 585728, PAR_LN1B = 593920, PAR_LN2G = 602112, PAR_LN2B = 610304, PAR_GBIAS = 618496, PAR_ONE = 618528, PAR_ZERO = 620576, PAR_BQ = 622624, PAR_END = 626720;
constexpr size_t WS_WF32 = 28 * MiB;
constexpr size_t WS_C2 = 30 * MiB;
constexpr size_t WS_WKT = 32 * MiB;
constexpr size_t WS_WVT = 48 * MiB;
constexpr size_t WS_WL = 64 * MiB;
constexpr size_t WL_STRIDE = 150 * MiB;
constexpr size_t WL_IN = 0, WL_GU = 60 * MiB, WL_DN = 104 * MiB, WL_PA = 126 * MiB, WL_PB = 130 * MiB, WL_PC = 138 * MiB, WL_OUT = 142 * MiB;
constexpr size_t WS_XF = 664 * MiB;
constexpr size_t WS_PF = 792 * MiB;
constexpr size_t WS_XB = 920 * MiB;
constexpr size_t WS_Z = 984 * MiB;
constexpr size_t WS_MRG = 1464 * MiB;
constexpr size_t WS_WQK = 1528 * MiB;
constexpr size_t WS_VW01 = 1592 * MiB;
constexpr size_t WS_VW23 = 32 * MiB;
constexpr size_t WS_WQN = 984 * MiB;
constexpr size_t WS_BQK = 3 * MiB + 768 * 1024;
constexpr size_t WS_HRAW = 1624 * MiB;
constexpr size_t WS_QF = 1752 * MiB;
constexpr size_t WS_KF = 1784 * MiB;
constexpr size_t WS_PFR = 1816 * MiB;
constexpr size_t WS_VF = 1824 * MiB;
constexpr size_t WS_GS = 1888 * MiB;
constexpr int GS_BCUM = 0, GS_BV = 65536, GS_PMAX = 131072, GS_BLAST = 196608, GS_MAXB = 197632, GS_MPREV = 198656;
constexpr size_t WS_VSTAT = 1889 * MiB;
constexpr size_t WS_DEN = 1890 * MiB;
constexpr size_t WS_WIG = 1893 * MiB;
constexpr size_t WS_DUMMY = 1891 * MiB;
constexpr size_t WS_END = 1894 * MiB;
static_assert(WL_OUT + 8 * MiB == WL_STRIDE && WS_WL + 4 * WL_STRIDE == WS_XF, "weights map");

constexpr int CW_BAR = 4096;

constexpr int LDS_BYTES = 163840;
constexpr int RING_BYTES = 131072;
constexpr int MISC_OFF = LDS_BYTES - 256;

__device__ __forceinline__ unsigned f2bf(float f) { unsigned u = __builtin_bit_cast(unsigned, f); return (u + 0x7fffu + ((u >> 16) & 1u)) >> 16; }
__device__ __forceinline__ unsigned pk2(float lo, float hi) { return f2bf(lo) | (f2bf(hi) << 16); }
__device__ __forceinline__ float bf2f(unsigned b) { return __builtin_bit_cast(float, b << 16); }
__device__ __forceinline__ float bflo(unsigned w) { return __builtin_bit_cast(float, w << 16); }
__device__ __forceinline__ float bfhi(unsigned w) { return __builtin_bit_cast(float, w & 0xffff0000u); }
typedef __bf16 bf16x2_t __attribute__((ext_vector_type(2)));
__device__ __forceinline__ unsigned cvt_pk_bf16(float lo, float hi) { const f32x2 v = {lo, hi}; const bf16x2_t b = __builtin_convertvector(v, bf16x2_t); return __builtin_bit_cast(unsigned, b); }
__device__ __forceinline__ float fast_sigmoid(float x) { return __builtin_amdgcn_rcpf(1.0f + __builtin_amdgcn_exp2f(-1.4426950408889634f * x)); }
__device__ __forceinline__ float gelu_tanh(float v) { const float y = 1.5957691216057308f * (v + 0.044715f * v * v * v); return v * fast_sigmoid(y); }
__device__ __forceinline__ float shx(float v, int o, int lane) { return __builtin_bit_cast(float, __builtin_amdgcn_ds_bpermute((lane ^ o) << 2, __builtin_bit_cast(int, v))); }
__device__ __forceinline__ float shup(float v, int o, int lane) { return __builtin_bit_cast(float, __builtin_amdgcn_ds_bpermute((lane - o) << 2, __builtin_bit_cast(int, v))); }
__device__ __forceinline__ float rdlane(float v, int l) { return __builtin_bit_cast(float, __builtin_amdgcn_readlane(__builtin_bit_cast(int, v), l)); }
__device__ __forceinline__ f32x4 scale4(f32x4 v, float s) { asm volatile("v_mul_f32 %0, %0, %4\n\tv_mul_f32 %1, %1, %4\n\tv_mul_f32 %2, %2, %4\n\tv_mul_f32 %3, %3, %4" : "+v"(v[0]), "+v"(v[1]), "+v"(v[2]), "+v"(v[3]) : "v"(s)); return v; }
__device__ __forceinline__ bf16x8 pack8(f32x4 a, f32x4 b) { u32x4 o; o.x = cvt_pk_bf16(a[0], a[1]); o.y = cvt_pk_bf16(a[2], a[3]); o.z = cvt_pk_bf16(b[0], b[1]); o.w = cvt_pk_bf16(b[2], b[3]); return __builtin_bit_cast(bf16x8, o); }
__device__ __forceinline__ f32x4 mfma16(bf16x8 a, bf16x8 b, f32x4 c) { return __builtin_amdgcn_mfma_f32_16x16x32_bf16(a, b, c, 0, 0, 0); }
template <int CTRL> __device__ __forceinline__ float dpp_f(float v) { return __builtin_bit_cast(float, __builtin_amdgcn_update_dpp(0, __builtin_bit_cast(int, v), CTRL, 0xf, 0xf, true)); }
__device__ __forceinline__ float wave_sum(float v, int lane) {
    v += dpp_f<0xB1>(v); v += dpp_f<0x4E>(v); v += dpp_f<0x141>(v); v += dpp_f<0x140>(v);
    v += shx(v, 16, lane); v += shx(v, 32, lane);
    return v;
}
__device__ __forceinline__ float wave_max(float v, int lane) {
    v = fmaxf(v, dpp_f<0xB1>(v)); v = fmaxf(v, dpp_f<0x4E>(v)); v = fmaxf(v, dpp_f<0x141>(v)); v = fmaxf(v, dpp_f<0x140>(v));
    v = fmaxf(v, shx(v, 16, lane)); v = fmaxf(v, shx(v, 32, lane));
    return v;
}
#define LDS_WAIT() asm volatile("s_waitcnt lgkmcnt(0)" ::: "memory")
#define VM_WAIT() asm volatile("s_waitcnt vmcnt(0)" ::: "memory")

#define XB_TMO      128
#define XB_XCNT(j)  (256  + 64 * (j))
#define XB_XSUB(j)  (1280 + 64 * (j))
#define XB_XGEN(j)  (2304 + 64 * (j))
#define XB_TOP      3328
#define XB_TOPGEN   3392
#define XCD_BAR_WORDS 3456
#define XB_SPIN_CAP (1u << 22)
__device__ __forceinline__ unsigned xb_ld(unsigned* p)              { return __hip_atomic_load(p, __ATOMIC_RELAXED, __HIP_MEMORY_SCOPE_AGENT); }
__device__ __forceinline__ unsigned xb_add(unsigned* p, unsigned v) { return __hip_atomic_fetch_add(p, v, __ATOMIC_RELAXED, __HIP_MEMORY_SCOPE_AGENT); }
__device__ __forceinline__ unsigned xb_xcc_id() { return (unsigned)__builtin_amdgcn_s_getreg((3 << 11) | 20) & 0xFu; }
#define XB_SPIN(cond, bar) do { unsigned _sp = 0; while (cond) { __builtin_amdgcn_s_sleep(1); \
    if ((++_sp & 255u) == 0u) { if (xb_ld(&(bar)[XB_TMO])) break; if (_sp > XB_SPIN_CAP) { atomicAdd(&(bar)[XB_TMO], 1u); break; } } } } while (0)
__device__ __forceinline__ int fresh_tid(const int wv) { int l_; asm volatile("v_mbcnt_lo_u32_b32 %0, -1, 0\n\tv_mbcnt_hi_u32_b32 %0, -1, %0" : "=v"(l_)); return wv * 64 + l_; }
struct XcdBarrier { unsigned* bar; unsigned x; volatile LAS unsigned* st; };
__device__ __forceinline__ XcdBarrier xcd_barrier_post(unsigned* bar, volatile LAS unsigned* st) {
    XcdBarrier b; b.bar = bar; b.x = xb_xcc_id(); b.st = st;
    if (threadIdx.x == 0) (void)xb_add(&bar[XB_XCNT(b.x)], 1u);
    return b;
}
__device__ __forceinline__ void xcd_barrier_complete(unsigned* bar, unsigned x, unsigned& nloc, unsigned& nx) {
    const unsigned G = gridDim.x * gridDim.y * gridDim.z;
    unsigned sum, cnt, mine, sp = 0u;
    for (;;) {
        sum = 0u; cnt = 0u; mine = 0u;
#pragma unroll
        for (unsigned j = 0; j < 16; ++j) { const unsigned c = xb_ld(&bar[XB_XCNT(j)]); sum += c; cnt += (c > 0u) ? 1u : 0u; mine = (j == x) ? c : mine; }
        if (sum == G) break;
        __builtin_amdgcn_s_sleep(1);
        if ((++sp & 255u) == 0u) { if (xb_ld(&bar[XB_TMO])) break; if (sp > XB_SPIN_CAP) { atomicAdd(&bar[XB_TMO], 1u); break; } }
    }
    nloc = mine > 0u ? mine : 1u; nx = cnt > 0u ? cnt : 1u;
}
__device__ __forceinline__ void xcd_barrier(const XcdBarrier& b, const int tid_) {
    asm volatile("s_waitcnt vmcnt(0)" ::: "memory");
    __syncthreads();
    if (tid_ == 0) {
        unsigned* bar = b.bar;
        __builtin_amdgcn_s_waitcnt(0);
        unsigned nloc = b.st[0], nx = b.st[1];
        if (nloc == 0u) { xcd_barrier_complete(bar, b.x, nloc, nx); b.st[0] = nloc; b.st[1] = nx; }
        const unsigned old = xb_add(&bar[XB_XSUB(b.x)], 1u);
        const unsigned gen = old / nloc;
        if (old + 1u == (gen + 1u) * nloc) {
            __builtin_amdgcn_fence(__ATOMIC_RELEASE, "agent");
            asm volatile("s_waitcnt vmcnt(0)" ::: "memory");
            const unsigned og = xb_add(&bar[XB_TOP], 1u);
            const unsigned tg = og / nx;
            if (og + 1u == (tg + 1u) * nx) xb_add(&bar[XB_TOPGEN], 1u);
            else XB_SPIN(xb_ld(&bar[XB_TOPGEN]) == tg, bar);
            __builtin_amdgcn_fence(__ATOMIC_ACQUIRE, "agent");
            xb_add(&bar[XB_XGEN(b.x)], 1u);
            asm volatile("s_waitcnt vmcnt(0)" ::: "memory");
        } else {
            XB_SPIN(xb_ld(&bar[XB_XGEN(b.x)]) == gen, bar);
            __builtin_amdgcn_fence(__ATOMIC_ACQUIRE, "agent");
            asm volatile("s_waitcnt vmcnt(0)" ::: "memory");
        }
    }
    __syncthreads();
}

namespace pg8 {
constexpr int BM = 256, BK = 64, HALF = 128, HTB = HALF * BK * 2, STAGE_BYTES = 8 * HTB, NXCD = 8, WGM = 4;
__host__ __device__ __forceinline__ int lds_byte(int r, int c) { const int st = (r >> 4) * 2 + (c >> 5), rr = r & 15, cc = c & 31, ob = rr * 64 + cc * 2; return st * 1024 + (ob ^ (((ob >> 9) & 1) << 5)); }
__host__ __device__ __forceinline__ void stage_rc(int b, int& R, int& C) { const int st = b / 1024, sb = b % 1024, swz = sb ^ (((sb >> 9) & 1) << 5); R = (st >> 1) * 16 + swz / 64; C = (st & 1) * 32 + (swz % 64) / 2; }
__host__ __device__ __forceinline__ int perm32(int rho) { const int n = rho >> 4, i = rho & 15; return 8 * (i >> 2) + 4 * n + (i & 3); }
struct Unit { int pm, pn; };
template <int LDA_, int LDB_, int K_, long A_PM, long A_PN, long B_PB, long B_PN> struct GemmT { const bf16_t* A; const bf16_t* Bt;
    static constexpr int lda = LDA_, ldb = LDB_, K = K_;
    __device__ __forceinline__ const char* a_ptr(const Unit& u) const { return (const char*)(A + (size_t)((long)u.pm * A_PM + (long)u.pn * A_PN)); }
    __device__ __forceinline__ const char* b_ptr(const Unit& u) const { return (const char*)(Bt + (size_t)((long)(u.pm >> 4) * B_PB + (long)u.pn * B_PN)); } };
template <int LDA_, int LDB_, int K_> using GemmStd = GemmT<LDA_, LDB_, K_, 256L * LDA_, 0L, 0L, 256L * LDB_>;
template <int M_, int N_> struct StaticOrder {
    static constexpr int nM = M_ / BM, nN = N_ / BM, nwg = nM * nN;
    int G, c;
    __device__ __forceinline__ void init(int G_, int c_) { G = G_; c = c_; }
    __device__ __forceinline__ bool next(int i, Unit& u) const {
        const int L = i * G + c; if (L >= nwg) return false;
        int wgid = L; { constexpr int q = nwg / NXCD, r = nwg % NXCD; const int xcd = wgid % NXCD, off = wgid / NXCD; wgid = (xcd < r ? xcd * (q + 1) : r * (q + 1) + (xcd - r) * q) + off; }
        constexpr int nig = WGM * nN; const int gid = wgid / nig, fm = gid * WGM, gsz = (nM - fm) < WGM ? (nM - fm) : WGM;
        u.pm = fm + ((wgid % nig) % gsz); u.pn = (wgid % nig) / gsz; return true;
    }
};
template <class Epi, class GemmD, class Sched>
__device__ __forceinline__ void gemm_phase(LAS unsigned char* lds, const GemmD g, const Sched& S, const Epi& E, int tid) {
    asm volatile("" : "+v"(tid));
    const int wid = __builtin_amdgcn_readfirstlane(tid >> 6), lane = tid & 63, wr = wid >> 2, wc = wid & 3, fr = lane & 15, fq = lane >> 4;
    constexpr int K = GemmD::K, nt = K / BK;
    unsigned voffA[2], voffB[2];
#pragma unroll
    for (int i = 0; i < 2; ++i) { int R, C; stage_rc(tid * 16 + i * 8192, R, C); const int Rb = (R & ~31) + perm32(R & 31);
        voffA[i] = (unsigned)(R * GemmD::lda + C) * 2u; voffB[i] = (unsigned)(Rb * GemmD::ldb + C) * 2u; }
    constexpr size_t kstep = (size_t)(BK * 2);
    constexpr size_t hA = (size_t)HALF * GemmD::lda * 2, hB = (size_t)HALF * GemmD::ldb * 2;
    const unsigned ldsw = (unsigned)wid * 1024u;
    const int aoff = lds_byte(wr * 64 + fr, fq * 8), boff = lds_byte(wc * 32 + fr, fq * 8);
#define PG8_SA(b, h) (((b) * 2 + (h)) * HTB)
#define PG8_SB(b, h) ((4 + (b) * 2 + (h)) * HTB)
#define PG8_STAGE(bufoff, gbase, voff) do { _Pragma("unroll") for (int _i = 0; _i < 2; ++_i) \
        __builtin_amdgcn_global_load_lds((const unsigned*)((const char*)(gbase) + (voff)[_i]), (LAS unsigned*)(lds + (bufoff) + ldsw + _i * 8192), 16, 0, 0); } while (0)
#define PG8_LDA(dst, b, h) do { _Pragma("unroll") for (int m = 0; m < 4; ++m) _Pragma("unroll") for (int k = 0; k < 2; ++k) dst[m][k] = *(const LAS bf16x8*)(lds + PG8_SA(b, h) + aoff + m * 2048 + k * 1024); } while (0)
#define PG8_LDB(dst, b, h) do { _Pragma("unroll") for (int n = 0; n < 2; ++n) _Pragma("unroll") for (int k = 0; k < 2; ++k) dst[n][k] = *(const LAS bf16x8*)(lds + PG8_SB(b, h) + boff + n * 2048 + k * 1024); } while (0)
#define PG8_MMA(ai, bj, At, Bt) do { __builtin_amdgcn_s_setprio(1); _Pragma("unroll") for (int m = 0; m < 4; ++m) _Pragma("unroll") for (int n = 0; n < 2; ++n) _Pragma("unroll") for (int k = 0; k < 2; ++k) \
        acc[ai][bj][m][n] = __builtin_amdgcn_mfma_f32_16x16x32_bf16(Bt[n][k], At[m][k], acc[ai][bj][m][n], 0, 0, 0); __builtin_amdgcn_s_setprio(0); } while (0)
#define PG8_WAIT_V(n) asm volatile("s_waitcnt vmcnt(" #n ")" ::: "memory")
#define PG8_WAIT_L(n) asm volatile("s_waitcnt lgkmcnt(" #n ")" ::: "memory")
#define PG8_BAR __builtin_amdgcn_s_barrier()
#define PG8_SCHED __builtin_amdgcn_sched_barrier(0)
    Unit cur, nxt; int ui = 0;
    if (!S.next(0, cur)) return;
    f32x4 acc[2][2][4][2];
#pragma unroll
    for (int a = 0; a < 2; ++a)
#pragma unroll
        for (int b = 0; b < 2; ++b)
#pragma unroll
            for (int m = 0; m < 4; ++m)
#pragma unroll
                for (int n = 0; n < 2; ++n) acc[a][b][m][n] = (f32x4){0.f, 0.f, 0.f, 0.f};
    bf16x8 At[4][2], B0[2][2], B1[2][2];
    const char* cA = g.a_ptr(cur); const char* cB = g.b_ptr(cur);
    PG8_STAGE(PG8_SB(0, 0), cB, voffB); PG8_STAGE(PG8_SB(0, 1), cB + hB, voffB); PG8_STAGE(PG8_SA(0, 0), cA, voffA); PG8_STAGE(PG8_SA(0, 1), cA + hA, voffA);
    if (wr == 1) PG8_BAR;
    PG8_WAIT_V(2); PG8_BAR;
    PG8_STAGE(PG8_SB(1, 0), cB + kstep, voffB); PG8_STAGE(PG8_SA(1, 0), cA + kstep, voffA); PG8_STAGE(PG8_SB(1, 1), cB + hB + kstep, voffB);
    PG8_WAIT_V(6); PG8_BAR;
    for (;;) {
        const bool has_next = S.next(ui + 1, nxt);
        const char* nA = has_next ? g.a_ptr(nxt) : cA; const char* nB = has_next ? g.b_ptr(nxt) : cB;
#pragma nounroll
        for (int t = 0; t < nt; t += 2) {
            const bool last = (t == nt - 2);
            const char* a1 = cA + (size_t)(t + 1) * kstep;
            const char* a2 = last ? nA : cA + (size_t)(t + 2) * kstep; const char* b2 = last ? nB : cB + (size_t)(t + 2) * kstep;
            const char* a3 = a2 + kstep; const char* b3 = b2 + kstep;
            PG8_LDB(B0, 0, 0); PG8_LDB(B1, 0, 1); PG8_SCHED; PG8_LDA(At, 0, 0); PG8_STAGE(PG8_SA(1, 1), a1 + hA, voffA);
            PG8_WAIT_V(8); PG8_WAIT_L(0); PG8_BAR; PG8_MMA(0, 0, At, B0); PG8_MMA(0, 1, At, B1); PG8_BAR; PG8_SCHED;
            PG8_LDA(At, 0, 1); PG8_STAGE(PG8_SB(0, 0), b2, voffB); PG8_STAGE(PG8_SB(0, 1), b2 + hB, voffB); PG8_STAGE(PG8_SA(0, 0), a2, voffA);
            PG8_WAIT_V(8); PG8_WAIT_L(0); PG8_BAR; PG8_MMA(1, 0, At, B0); PG8_MMA(1, 1, At, B1); PG8_BAR; PG8_SCHED;
            PG8_LDB(B0, 1, 0); PG8_LDB(B1, 1, 1); PG8_SCHED; PG8_LDA(At, 1, 0); PG8_STAGE(PG8_SA(0, 1), a2 + hA, voffA);
            PG8_WAIT_V(8); PG8_WAIT_L(0); PG8_BAR; PG8_MMA(0, 0, At, B0); PG8_MMA(0, 1, At, B1); PG8_BAR; PG8_SCHED;
            PG8_LDA(At, 1, 1); PG8_STAGE(PG8_SB(1, 0), b3, voffB); PG8_STAGE(PG8_SB(1, 1), b3 + hB, voffB); PG8_STAGE(PG8_SA(1, 0), a3, voffA);
            PG8_WAIT_V(8); PG8_WAIT_L(0); PG8_BAR; PG8_MMA(1, 0, At, B0); PG8_MMA(1, 1, At, B1); PG8_BAR; PG8_SCHED;
        }
        if (wr == 0) PG8_BAR;
        E(acc, cur, wr, wc, fr, fq);
        if (!has_next) break;
#pragma unroll
        for (int a = 0; a < 2; ++a)
#pragma unroll
            for (int b = 0; b < 2; ++b)
#pragma unroll
                for (int m = 0; m < 4; ++m)
#pragma unroll
                    for (int n = 0; n < 2; ++n) acc[a][b][m][n] = (f32x4){0.f, 0.f, 0.f, 0.f};
        cur = nxt; cA = nA; cB = nB; ++ui;
        if (wr == 1) PG8_BAR;
    }
    PG8_WAIT_V(0);
    PG8_BAR;
#undef PG8_SA
#undef PG8_SB
#undef PG8_STAGE
#undef PG8_LDA
#undef PG8_LDB
#undef PG8_MMA
#undef PG8_WAIT_V
#undef PG8_WAIT_L
#undef PG8_BAR
#undef PG8_SCHED
}

typedef f32x4 Acc[2][2][4][2];
struct EpiIn { bf16_t* Z; const float* bias; const float* bqk; LAS float* red;
    __device__ __forceinline__ void operator()(Acc& acc, const Unit& u, int wr, int wc, int fr, int fq) const {
        const int pn = u.pn; const int act = (pn < 8) ? 1 : (pn < 24) ? 0 : (pn < 32) ? 2 : (pn < 36) ? 3 : 2;
        const int row0 = u.pm * BM + wr * 64 + fr, col0 = pn * BM + wc * 32 + 8 * fq;
        if (act == 3) {
            const int lane = fq * 16 + fr; const float* bp = bqk + (u.pm >> 4) * 1024 + (pn - 32) * BM + wc * 32 + 8 * fq;
            LAS float* RM = red; LAS float* RS = red + 1024;
#pragma unroll
            for (int bj = 0; bj < 2; ++bj) { const f32x4 b0 = *(const f32x4*)(bp + bj * HALF), b1 = *(const f32x4*)(bp + bj * HALF + 4);
#pragma unroll
                for (int ai = 0; ai < 2; ++ai)
#pragma unroll
                    for (int m = 0; m < 4; ++m) { acc[ai][bj][m][0] += b0; acc[ai][bj][m][1] += b1; } }
#pragma unroll
            for (int ai = 0; ai < 2; ++ai)
#pragma unroll
                for (int m = 0; m < 4; ++m) { float mx = -3.0e38f;
#pragma unroll
                    for (int bj = 0; bj < 2; ++bj)
#pragma unroll
                        for (int n = 0; n < 2; ++n) { const f32x4 v = acc[ai][bj][m][n]; mx = fmaxf(mx, fmaxf(fmaxf(v[0], v[1]), fmaxf(v[2], v[3]))); }
                    mx = fmaxf(mx, shx(mx, 16, lane)); mx = fmaxf(mx, shx(mx, 32, lane));
                    if (fq == 0) RM[(ai * HALF + wr * 64 + m * 16 + fr) * 4 + wc] = mx; }
            asm volatile("s_waitcnt lgkmcnt(0)" ::: "memory"); __builtin_amdgcn_s_barrier(); asm volatile("" ::: "memory");
#pragma unroll
            for (int ai = 0; ai < 2; ++ai)
#pragma unroll
                for (int m = 0; m < 4; ++m) { const f32x4 m4 = *(const LAS f32x4*)(RM + (ai * HALF + wr * 64 + m * 16 + fr) * 4); const float mx = fmaxf(fmaxf(m4[0], m4[1]), fmaxf(m4[2], m4[3])); float sm = 0.f;
#pragma unroll
                    for (int bj = 0; bj < 2; ++bj)
#pragma unroll
                        for (int n = 0; n < 2; ++n) { f32x4 v = acc[ai][bj][m][n];
#pragma unroll
                            for (int j = 0; j < 4; ++j) { v[j] = __builtin_amdgcn_exp2f(v[j] - mx); sm += v[j]; }
                            acc[ai][bj][m][n] = v; }
                    sm += shx(sm, 16, lane); sm += shx(sm, 32, lane);
                    if (fq == 0) RS[(ai * HALF + wr * 64 + m * 16 + fr) * 4 + wc] = sm; }
            asm volatile("s_waitcnt lgkmcnt(0)" ::: "memory"); __builtin_amdgcn_s_barrier(); asm volatile("" ::: "memory");
#pragma unroll
            for (int ai = 0; ai < 2; ++ai)
#pragma unroll
                for (int m = 0; m < 4; ++m) { const f32x4 s4 = *(const LAS f32x4*)(RS + (ai * HALF + wr * 64 + m * 16 + fr) * 4); const float inv = 1.f / ((s4[0] + s4[1]) + (s4[2] + s4[3]));
                    bf16_t* rowp = Z + (size_t)(row0 + ai * HALF + m * 16) * ZW + col0;
#pragma unroll
                    for (int bj = 0; bj < 2; ++bj) { const f32x4 v0 = acc[ai][bj][m][0] * inv, v1 = acc[ai][bj][m][1] * inv;
                        u32x4 w; w.x = cvt_pk_bf16(v0[0], v0[1]); w.y = cvt_pk_bf16(v0[2], v0[3]); w.z = cvt_pk_bf16(v1[0], v1[1]); w.w = cvt_pk_bf16(v1[2], v1[3]);
                        *(u32x4*)(rowp + bj * HALF) = w; } }
            return;
        }
#pragma unroll
        for (int bj = 0; bj < 2; ++bj) {
            const f32x4 b0 = *(const f32x4*)(bias + col0 + bj * HALF), b1 = *(const f32x4*)(bias + col0 + bj * HALF + 4);
#pragma unroll
            for (int ai = 0; ai < 2; ++ai)
#pragma unroll
                for (int m = 0; m < 4; ++m) { bf16_t* rowp = Z + (size_t)(row0 + ai * HALF + m * 16) * ZW + col0 + bj * HALF;
                    f32x4 v0 = acc[ai][bj][m][0] + b0, v1 = acc[ai][bj][m][1] + b1;
                    if (act == 1) {
#pragma unroll
                        for (int j = 0; j < 4; ++j) { v0[j] = gelu_tanh(v0[j]); v1[j] = gelu_tanh(v1[j]); } }
                    else if (act == 2) {
#pragma unroll
                        for (int j = 0; j < 4; ++j) { v0[j] = fast_sigmoid(v0[j]); v1[j] = fast_sigmoid(v1[j]); } }
                    u32x4 w; w.x = cvt_pk_bf16(v0[0], v0[1]); w.y = cvt_pk_bf16(v0[2], v0[3]); w.z = cvt_pk_bf16(v1[0], v1[1]); w.w = cvt_pk_bf16(v1[2], v1[3]);
                    *(u32x4*)rowp = w; }
        }
    }
};
__device__ __forceinline__ void store_tile_bf16(const Acc& acc, bf16_t* base, int ldc, float sc, int wr, int wc, int fr, int fq) {
#pragma unroll
    for (int ai = 0; ai < 2; ++ai)
#pragma unroll
        for (int m = 0; m < 4; ++m) { bf16_t* rowp = base + (size_t)(wr * 64 + fr + ai * HALF + m * 16) * ldc + wc * 32 + 8 * fq;
#pragma unroll
            for (int bj = 0; bj < 2; ++bj) { const f32x4 v0 = acc[ai][bj][m][0] * sc, v1 = acc[ai][bj][m][1] * sc;
                u32x4 w; w.x = cvt_pk_bf16(v0[0], v0[1]); w.y = cvt_pk_bf16(v0[2], v0[3]); w.z = cvt_pk_bf16(v1[0], v1[1]); w.w = cvt_pk_bf16(v1[2], v1[3]);
                *(u32x4*)(rowp + bj * HALF) = w; } }
}
constexpr float SCORE_SCALE = 0.0625f * 1.4426950408889634f;
struct GemmQK { const bf16_t* Km; const bf16_t* Wqn; static constexpr int lda = 4096, ldb = 1024, K = 256;
    __device__ __forceinline__ const char* a_ptr(const Unit& u) const { return (const char*)(Km + (size_t)(u.pm & 3) * 256 * 4096 + (size_t)(u.pm >> 2) * 256); }
    __device__ __forceinline__ const char* b_ptr(const Unit& u) const { return (const char*)(Wqn + (size_t)(u.pm >> 4) * 2048 * 1024 + (size_t)((u.pm >> 2) & 3) * 256 + (size_t)u.pn * 256 * 1024); } };
struct EpiQK { bf16_t* O;
    __device__ __forceinline__ void operator()(const Acc& acc, const Unit& u, int wr, int wc, int fr, int fq) const {
        store_tile_bf16(acc, O + ((size_t)((u.pm >> 4) * 4 + (u.pm & 3)) * 1024 + (size_t)((u.pm >> 2) & 3) * 256) * 2048 + (size_t)u.pn * 256, 2048, SCORE_SCALE, wr, wc, fr, fq); } };
struct GemmVW { const unsigned char* wl0; const bf16_t* Vm; static constexpr int lda = 1024, ldb = 4096, K = 256;
    __device__ __forceinline__ const char* a_ptr(const Unit& u) const { const int lbh = u.pm >> 3; return (const char*)((const bf16_t*)(wl0 + (size_t)(lbh >> 4) * WL_STRIDE + WL_PC) + (size_t)(u.pm & 7) * 256 * 1024 + (size_t)(lbh & 3) * 256); }
    __device__ __forceinline__ const char* b_ptr(const Unit& u) const { const int lbh = u.pm >> 3; return (const char*)(Vm + (size_t)((lbh >> 2) & 3) * 256 * 4096 + (size_t)(lbh >> 4) * 1024 + (size_t)(lbh & 3) * 256); } };
struct EpiVW { unsigned char* wsb;
    __device__ __forceinline__ void operator()(const Acc& acc, const Unit& u, int wr, int wc, int fr, int fq) const {
        const int lbh = u.pm >> 3, l = lbh >> 4, b = (lbh >> 2) & 3, h = lbh & 3;
        bf16_t* vw = (bf16_t*)(wsb + (l < 2 ? WS_VW01 + (size_t)l * 16 * MiB : WS_VW23 + (size_t)(l - 2) * 16 * MiB));
        store_tile_bf16(acc, vw + ((size_t)b * 2048 + (size_t)(u.pm & 7) * 256) * 1024 + h * 256, 1024, 1.0f, wr, wc, fr, fq); } };
struct GemmIn { const bf16_t* A; const bf16_t* W; const bf16_t* Wqk; static constexpr int lda = D, ldb = D, K = D;
    __device__ __forceinline__ const char* a_ptr(const Unit& u) const { return (const char*)(A + (size_t)u.pm * 256 * D); }
    __device__ __forceinline__ const char* b_ptr(const Unit& u) const { return (u.pn >= 32 && u.pn < 36) ? (const char*)(Wqk + ((size_t)(u.pm >> 4) * 1024 + (size_t)(u.pn - 32) * 256) * D) : (const char*)(W + (size_t)u.pn * 256 * D); } };
struct EpiF32 { float* C; int ldc;
    __device__ __forceinline__ void operator()(const Acc& acc, const Unit& u, int wr, int wc, int fr, int fq) const {
        const int row0 = u.pm * BM + wr * 64 + fr, col0 = u.pn * BM + wc * 32 + 8 * fq;
#pragma unroll
        for (int ai = 0; ai < 2; ++ai)
#pragma unroll
            for (int m = 0; m < 4; ++m) { float* rowp = C + (size_t)(row0 + ai * HALF + m * 16) * ldc + col0;
#pragma unroll
                for (int bj = 0; bj < 2; ++bj)
#pragma unroll
                    for (int n = 0; n < 2; ++n) *(f32x4*)(rowp + bj * HALF + 4 * n) = acc[ai][bj][m][n]; }
    }
};
struct EpiBf16 { bf16_t* O; int ldc;
    __device__ __forceinline__ void operator()(const Acc& acc, const Unit& u, int wr, int wc, int fr, int fq) const {
        const int row0 = u.pm * BM + wr * 64 + fr, col0 = u.pn * BM + wc * 32 + 8 * fq;
#pragma unroll
        for (int ai = 0; ai < 2; ++ai)
#pragma unroll
            for (int m = 0; m < 4; ++m) { bf16_t* rowp = O + (size_t)(row0 + ai * HALF + m * 16) * ldc + col0;
#pragma unroll
                for (int bj = 0; bj < 2; ++bj) { const f32x4 v0 = acc[ai][bj][m][0], v1 = acc[ai][bj][m][1];
                    u32x4 w; w.x = cvt_pk_bf16(v0[0], v0[1]); w.y = cvt_pk_bf16(v0[2], v0[3]); w.z = cvt_pk_bf16(v1[0], v1[1]); w.w = cvt_pk_bf16(v1[2], v1[3]);
                    *(u32x4*)(rowp + bj * HALF) = w; } }
    }
};
template <int MODE> struct EpiGate { const bf16_t* Gz; bf16_t* mrg;
    __device__ __forceinline__ void operator()(const Acc& acc, const Unit& u, int wr, int wc, int fr, int fq) const {
        const int row0 = u.pm * BM + wr * 64 + fr, col0 = u.pn * BM + wc * 32 + 8 * fq;
#pragma unroll
        for (int ai = 0; ai < 2; ++ai) {
            u32x4 gw[4][2], pw[4][2];
#pragma unroll
            for (int m = 0; m < 4; ++m) { const size_t r = (size_t)(row0 + ai * HALF + m * 16);
#pragma unroll
                for (int bj = 0; bj < 2; ++bj) { const int c = col0 + bj * HALF; gw[m][bj] = *(const u32x4*)(Gz + r * ZW + c); if (MODE != 0) pw[m][bj] = *(const u32x4*)(mrg + r * D + c); else pw[m][bj] = (u32x4){0u, 0u, 0u, 0u}; } }
            __builtin_amdgcn_sched_barrier(0);
#pragma unroll
            for (int m = 0; m < 4; ++m) { const size_t r = (size_t)(row0 + ai * HALF + m * 16);
#pragma unroll
                for (int bj = 0; bj < 2; ++bj) { const int c = col0 + bj * HALF; const u32x4 g4 = gw[m][bj];
                    f32x4 v0 = acc[ai][bj][m][0], v1 = acc[ai][bj][m][1];
                    v0[0] *= bflo(g4.x); v0[1] *= bfhi(g4.x); v0[2] *= bflo(g4.y); v0[3] *= bfhi(g4.y);
                    v1[0] *= bflo(g4.z); v1[1] *= bfhi(g4.z); v1[2] *= bflo(g4.w); v1[3] *= bfhi(g4.w);
                    if (MODE != 0) { const u32x4 p4 = pw[m][bj];
                        v0[0] += bflo(p4.x); v0[1] += bfhi(p4.x); v0[2] += bflo(p4.y); v0[3] += bfhi(p4.y); v1[0] += bflo(p4.z); v1[1] += bfhi(p4.z); v1[2] += bflo(p4.w); v1[3] += bfhi(p4.w); }
                    u32x4 w; w.x = cvt_pk_bf16(v0[0], v0[1]); w.y = cvt_pk_bf16(v0[2], v0[3]); w.z = cvt_pk_bf16(v1[0], v1[1]); w.w = cvt_pk_bf16(v1[2], v1[3]);
                    *(u32x4*)(mrg + r * D + c) = w; } }
            __builtin_amdgcn_sched_barrier(0);
        }
    }
};
struct EpiResid { float* P; const float* stat; const float* g; const float* b;
    __device__ __forceinline__ void operator()(const Acc& acc, const Unit& u, int wr, int wc, int fr, int fq) const {
        const int row0 = u.pm * BM + wr * 64 + fr, col0 = u.pn * BM + wc * 32 + 8 * fq;
        f32x4 g4[2][2], b4[2][2];
#pragma unroll
        for (int bj = 0; bj < 2; ++bj)
#pragma unroll
            for (int n = 0; n < 2; ++n) { const int c = col0 + bj * HALF + 4 * n; g4[bj][n] = *(const f32x4*)(g + c); b4[bj][n] = *(const f32x4*)(b + c); }
#pragma unroll
        for (int q = 0; q < 4; ++q) {
            const int ai = q >> 1, mb = (q & 1) * 2;
            f32x2 st[2]; f32x4 px[2][2][2];
#pragma unroll
            for (int mm = 0; mm < 2; ++mm) { const int row = row0 + ai * HALF + (mb + mm) * 16; const float* pp = P + (size_t)row * D + col0; st[mm] = *(const f32x2*)(stat + 2 * row);
#pragma unroll
                for (int bj = 0; bj < 2; ++bj)
#pragma unroll
                    for (int n = 0; n < 2; ++n) px[mm][bj][n] = *(const f32x4*)(pp + bj * HALF + 4 * n); }
            __builtin_amdgcn_sched_barrier(0);
#pragma unroll
            for (int mm = 0; mm < 2; ++mm) { const int row = row0 + ai * HALF + (mb + mm) * 16; float* pp = P + (size_t)row * D + col0;
#pragma unroll
                for (int bj = 0; bj < 2; ++bj)
#pragma unroll
                    for (int n = 0; n < 2; ++n) { const f32x4 x = (px[mm][bj][n] - st[mm].x) * st[mm].y * g4[bj][n] + b4[bj][n]; *(f32x4*)(pp + bj * HALF + 4 * n) = x * ALPHA + acc[ai][bj][mb + mm][n]; } }
            __builtin_amdgcn_sched_barrier(0);
        }
    }
};
struct EpiSwiglu { bf16_t* H;
    __device__ __forceinline__ void operator()(const Acc& acc, const Unit& u, int wr, int wc, int fr, int fq) const {
        const int row0 = u.pm * BM + wr * 64 + fr, col0 = u.pn * HALF + wc * 32 + 8 * fq;
#pragma unroll
        for (int ai = 0; ai < 2; ++ai)
#pragma unroll
            for (int m = 0; m < 4; ++m) { bf16_t* rowp = H + (size_t)(row0 + ai * HALF + m * 16) * FF + col0;
                f32x4 h0, h1;
#pragma unroll
                for (int j = 0; j < 4; ++j) { const float g0 = acc[ai][0][m][0][j], g1 = acc[ai][0][m][1][j];
                    h0[j] = g0 * fast_sigmoid(g0) * acc[ai][1][m][0][j]; h1[j] = g1 * fast_sigmoid(g1) * acc[ai][1][m][1][j]; }
                u32x4 w; w.x = cvt_pk_bf16(h0[0], h0[1]); w.y = cvt_pk_bf16(h0[2], h0[3]); w.z = cvt_pk_bf16(h1[0], h1[1]); w.w = cvt_pk_bf16(h1[2], h1[3]);
                *(u32x4*)rowp = w; }
    }
};
}

struct Args { const float* in[24]; float* out; unsigned char* ws; int ph_lo, ph_hi; };

struct Frame { LAS unsigned char* lds; int tid, lane, wave, gw, ngw, G, bid; };

__device__ __forceinline__ void transpose_tile(const float* src, size_t ldw, bf16_t* dst, size_t ldwt, LAS float* scr, int lane) {
    float tv[32];
#pragma unroll
    for (int i = 0; i < 32; ++i) tv[i] = src[(size_t)(2 * i + (lane >> 5)) * ldw + (lane & 31)];
#pragma unroll
    for (int i = 0; i < 32; ++i) scr[(2 * i + (lane >> 5)) * 33 + (lane & 31)] = tv[i];
    LDS_WAIT(); asm volatile("" ::: "memory");
    const int c = lane & 7;
#pragma unroll
    for (int j = 0; j < 4; ++j) { const int n = (lane >> 3) + 8 * j; const LAS float* s = scr + (8 * c) * 33 + n;
        u32x4 o; o.x = pk2(s[0 * 33], s[1 * 33]); o.y = pk2(s[2 * 33], s[3 * 33]); o.z = pk2(s[4 * 33], s[5 * 33]); o.w = pk2(s[6 * 33], s[7 * 33]);
        *(u32x4*)(dst + (size_t)n * ldwt + 8 * c) = o; }
    LDS_WAIT(); asm volatile("" ::: "memory");
}
__device__ __forceinline__ void transpose_item(const float* W, int ldw, int N, bf16_t* WT, int K, int item, LAS float* scr, int lane, int mode) {
    const int nblk = N / 32, kb = item / nblk, nb = item % nblk, k0 = 64 * kb, n0 = 32 * nb;
    int r0 = n0;
    if (mode == 1) { r0 = (n0 < FF) ? 256 * (n0 / 128) + (n0 % 128) : 256 * ((n0 - FF) / 128) + 128 + ((n0 - FF) % 128); }
    transpose_tile(W + (size_t)k0 * ldw + n0, (size_t)ldw, WT + (size_t)r0 * K + k0, (size_t)K, scr, lane);
}

struct TItem { const float* src; size_t ldw; bf16_t* dst; size_t ldwt; };
__device__ __forceinline__ void tt_load(f32x4 (&tv)[8], const TItem& t, int lane) {
#pragma unroll
    for (int i = 0; i < 8; ++i) tv[i] = *(const f32x4*)(t.src + (size_t)((lane >> 3) + 8 * i) * t.ldw + 4 * (lane & 7));
}
__device__ __forceinline__ void tt_store(const f32x4 (&tv)[8], const TItem& t, LAS float* scr, int lane) {
#pragma unroll
    for (int i = 0; i < 8; ++i) { LAS float* p = scr + ((lane >> 3) + 8 * i) * 33 + 4 * (lane & 7); p[0] = tv[i][0]; p[1] = tv[i][1]; p[2] = tv[i][2]; p[3] = tv[i][3]; }
    LDS_WAIT(); asm volatile("" ::: "memory");
    const int c = lane & 7;
#pragma unroll
    for (int j = 0; j < 4; ++j) { const int n = (lane >> 3) + 8 * j; const LAS float* s = scr + (8 * c) * 33 + n;
        u32x4 o; o.x = pk2(s[0 * 33], s[1 * 33]); o.y = pk2(s[2 * 33], s[3 * 33]); o.z = pk2(s[4 * 33], s[5 * 33]); o.w = pk2(s[6 * 33], s[7 * 33]);
        *(u32x4*)(t.dst + (size_t)n * t.ldwt + 8 * c) = o; }
    LDS_WAIT(); asm volatile("" ::: "memory");
}
__device__ __forceinline__ TItem titem(const float* W, int ldw, int nblk, int nb0, bf16_t* WT, int K, int item, int mode) {
    const int kb = item / nblk, nb = nb0 + item % nblk, k0 = 64 * kb, n0 = 32 * nb;
    int r0 = n0;
    if (mode == 1) { r0 = (n0 < FF) ? 256 * (n0 / 128) + (n0 % 128) : 256 * ((n0 - FF) / 128) + 128 + ((n0 - FF) % 128); }
    TItem t; t.src = W + (size_t)k0 * ldw + n0; t.ldw = (size_t)ldw; t.dst = WT + (size_t)r0 * K + k0; t.ldwt = (size_t)K; return t;
}
__device__ __forceinline__ void row_load(const float* src, f32x4 (&v)[8], int lane) {
#pragma unroll
    for (int j = 0; j < 8; ++j) v[j] = *(const f32x4*)(src + 256 * j + 4 * lane);
}
__device__ __forceinline__ void row_finish(f32x4 (&v)[8], bool do_ln, const float* lg, const float* lb, float* xf, bf16_t* xb, const LAS float* wg, const float* gb, float* gates, int lane, float* stat = nullptr) {
    if (do_ln) {
        float s = 0.f;
#pragma unroll
        for (int j = 0; j < 8; ++j) s += (v[j].x + v[j].y) + (v[j].z + v[j].w);
        const float mean = wave_sum(s, lane) * (1.f / D); float s2 = 0.f;
#pragma unroll
        for (int j = 0; j < 8; ++j) { v[j] = v[j] - mean; s2 += (v[j].x * v[j].x + v[j].y * v[j].y) + (v[j].z * v[j].z + v[j].w * v[j].w); }
        const float rstd = 1.f / sqrtf(wave_sum(s2, lane) * (1.f / D) + LN_EPS);
        if (stat && lane == 0) { stat[0] = mean; stat[1] = rstd; }
#pragma unroll
        for (int j = 0; j < 8; ++j) { const f32x4 g4 = *(const f32x4*)(lg + 256 * j + 4 * lane), b4 = *(const f32x4*)(lb + 256 * j + 4 * lane); v[j] = v[j] * rstd * g4 + b4; }
    }
    if (xf) {
#pragma unroll
        for (int j = 0; j < 8; ++j) *(f32x4*)(xf + 256 * j + 4 * lane) = v[j];
    }
    if (xb) {
#pragma unroll
        for (int j = 0; j < 8; ++j) { u32x2 w; w.x = cvt_pk_bf16(v[j].x, v[j].y); w.y = cvt_pk_bf16(v[j].z, v[j].w); *(u32x2*)(xb + 256 * j + 4 * lane) = w; }
    }
    if (gates) {
        asm volatile("" : "+s"(wg));
        float myg = 0.f;
#pragma unroll
        for (int q = 0; q < 8; ++q) { float s = 0.f;
#pragma unroll
            for (int j = 0; j < 8; ++j) { const f32x4 w4 = *(const LAS f32x4*)(wg + q * D + 256 * j + 4 * lane); s += (v[j].x * w4.x + v[j].y * w4.y) + (v[j].z * w4.z + v[j].w * w4.w); }
            s = wave_sum(s, lane); if (lane == q) myg = s + gb[q]; }
        if (lane < 8) gates[lane] = myg;
    }
}
__device__ __forceinline__ void row_pass(const float* src, bool do_ln, const float* lg, const float* lb, float* xf, bf16_t* xb, const LAS float* wg, const float* gb, float* gates, int lane, float* stat = nullptr) {
    f32x4 v[8]; row_load(src, v, lane); row_finish(v, do_ln, lg, lb, xf, xb, wg, gb, gates, lane, stat);
}
__device__ __forceinline__ void load_gate_w(const Frame& F, const float* WGl) {
    LAS float* wg = (LAS float*)F.lds;
    for (int i = F.tid; i < 8 * D / 4; i += 512) *(LAS f32x4*)(wg + 4 * i) = *(const f32x4*)(WGl + 4 * i);
    __syncthreads();
}

__global__ void __launch_bounds__(512, 2) fwd_kernel(Args args) {
    extern __shared__ __attribute__((aligned(16))) unsigned char lds_raw[];
    LAS unsigned char* const lds_base = (LAS unsigned char*)lds_raw;
    unsigned char* const ws = args.ws;
    volatile LAS unsigned* MISC = (volatile LAS unsigned*)(lds_base + MISC_OFF);
    if (threadIdx.x < 64) MISC[threadIdx.x] = 0u;
    const int wv0 = __builtin_amdgcn_readfirstlane((int)threadIdx.x >> 6);
    __syncthreads();
#if MK_PER_PHASE
    XcdBarrier bar; bar.bar = (unsigned*)(ws + WS_CTL) + CW_BAR; bar.x = 0; bar.st = nullptr;
#define GRID_BAR() do { } while (0)
#else
    XcdBarrier bar = xcd_barrier_post((unsigned*)(ws + WS_CTL) + CW_BAR, MISC + 8);
#define GRID_BAR() do { XcdBarrier b_ = bar; asm volatile("" : "+s"(b_.bar), "+s"(b_.x)); xcd_barrier(b_, fresh_tid(wv0)); } while (0)
#endif
#define IN(k) true
#define SEAM(k) GRID_BAR()
#define PHASE_CTX \
    unsigned char* wsb; { GAS unsigned char* g_ = (GAS unsigned char*)ws; asm volatile("" : "+s"(g_)); wsb = (unsigned char*)g_; }     \
    Frame F; { int t_ = fresh_tid(wv0); F.lds = lds_base; F.tid = t_; F.lane = t_ & 63; F.wave = __builtin_amdgcn_readfirstlane(t_ >> 6); \
      int g_ = gridDim.x, b_ = blockIdx.x; asm volatile("" : "+s"(g_), "+s"(b_)); F.G = g_; F.bid = b_; F.gw = b_ * 8 + F.wave; F.ngw = g_ * 8; }
#define WG ((float*)(wsb + WS_WG))
#define BIN ((float*)(wsb + WS_BIN))
#define GATES ((float*)(wsb + WS_GATES))
#define STAT ((float*)(wsb + WS_STAT))
#define MEMN ((bf16_t*)(wsb + WS_MEMN))
#define KMEM ((bf16_t*)(wsb + WS_KMEM))
#define VMEM ((bf16_t*)(wsb + WS_VMEM))
#define WQK ((bf16_t*)(wsb + WS_WQK))
#define WQN ((bf16_t*)(wsb + WS_WQN))
#define BQK ((float*)(wsb + WS_BQK))
#define WKT ((bf16_t*)(wsb + WS_WKT))
#define WVT ((bf16_t*)(wsb + WS_WVT))
#define PAR ((float*)(wsb + WS_PAR))
#define XF ((float*)(wsb + WS_XF))
#define PF ((float*)(wsb + WS_PF))
#define XB ((bf16_t*)(wsb + WS_XB))
#define Z ((bf16_t*)(wsb + WS_Z))
#define HFF ((bf16_t*)(wsb + WS_Z))
#define MRG ((bf16_t*)(wsb + WS_MRG))
#define HRAW ((bf16_t*)(wsb + WS_HRAW))
#define QF ((bf16_t*)(wsb + WS_QF))
#define KF ((bf16_t*)(wsb + WS_KF))
#define PFR ((bf16_t*)(wsb + WS_PFR))
#define VF ((bf16_t*)(wsb + WS_VF))
#define GS ((float*)(wsb + WS_GS))
#define DEN ((float*)(wsb + WS_DEN))
#define VSTAT ((float*)(wsb + WS_VSTAT))
#define WIG ((float*)(wsb + WS_WIG))
#define WF32 ((float*)(wsb + WS_WF32))
#define C2A ((float*)(wsb + WS_C2))

    if (IN(0)) {
        PHASE_CTX
        const float* x_in = args.in[0]; const float* w_in = args.in[4]; const float* b_in = args.in[5];
        LAS float* scr = (LAS float*)(F.lds + F.wave * 16384);
        {
            constexpr int I_IN1 = 32 * 256, I_IN2 = 32 * 192, I_GU = 32 * 352, I_DN = 88 * 64, I_PA = 16 * 64, I_PB = 32 * 64, I_PC = 16 * 64, I_OUT = 32 * 64, I_KV = 32 * 64;
            constexpr int NIT = I_IN1 + I_IN2 + I_GU + I_DN + I_PA + I_PB + I_PC + I_OUT + I_KV, NALL = DEPTH * NIT;
            auto decode = [&](int itx) -> TItem {
                const int l = itx / NIT; int r = itx - l * NIT;
                unsigned char* wl = wsb + WS_WL + (size_t)l * WL_STRIDE; const float* win_l = w_in + (size_t)l * D * INW;
                if (r < I_IN1) return titem(win_l, INW, 256, 0, (bf16_t*)(wl + WL_IN), D, r, 0); r -= I_IN1;
                if (r < I_IN2) return titem(win_l + 8200, INW, 192, 32, (bf16_t*)(wl + WL_IN) + (size_t)8192 * D, D, r, 0); r -= I_IN2;
                if (r < I_GU) return titem(args.in[20] + (size_t)l * D * 2 * FF, 2 * FF, 352, 0, (bf16_t*)(wl + WL_GU), D, r, 1); r -= I_GU;
                if (r < I_DN) return titem(args.in[21] + (size_t)l * FF * D, D, 64, 0, (bf16_t*)(wl + WL_DN), FF, r, 0); r -= I_DN;
                if (r < I_PA) return titem(args.in[14] + (size_t)l * 1024 * D, D, 64, 0, (bf16_t*)(wl + WL_PA), 1024, r, 0); r -= I_PA;
                if (r < I_PB) return titem(args.in[15] + (size_t)l * 2048 * D, D, 64, 0, (bf16_t*)(wl + WL_PB), 2048, r, 0); r -= I_PB;
                if (r < I_PC) return titem(args.in[16] + (size_t)l * 1024 * D, D, 64, 0, (bf16_t*)(wl + WL_PC), 1024, r, 0); r -= I_PC;
                if (r < I_OUT) return titem(args.in[17] + (size_t)l * D * D, D, 64, 0, (bf16_t*)(wl + WL_OUT), D, r, 0); r -= I_OUT;
                const int kb = r / 64, nb = r % 64, k0 = 64 * kb, n0 = 32 * nb;
                TItem t; t.src = args.in[13] + (size_t)l * D * 2048 + (size_t)k0 * 2048 + n0; t.ldw = 2048;
                t.dst = ((n0 < 1024) ? WKT + (size_t)(l * 1024 + n0) * D : WVT + (size_t)(l * 1024 + n0 - 1024) * D) + k0; t.ldwt = D; return t;
            };
            f32x4 ta[8], tb[8];
            int it = F.gw;
            TItem ca = decode(it < NALL ? it : NALL - 1), cb = ca;
            tt_load(ta, ca, F.lane);
#pragma nounroll
            while (it < NALL) {
                const int n1 = it + F.ngw; cb = decode(n1 < NALL ? n1 : NALL - 1); tt_load(tb, cb, F.lane);
                tt_store(ta, ca, scr, F.lane);
                if (n1 >= NALL) break;
                const int n2 = n1 + F.ngw; ca = decode(n2 < NALL ? n2 : NALL - 1); tt_load(ta, ca, F.lane);
                tt_store(tb, cb, scr, F.lane);
                it = n2;
            }
        }
        const int gt = F.bid * 512 + F.tid, ngt = F.G * 512;
        for (int i = gt; i < DEPTH * 8 * D; i += ngt) { const int l = i / (8 * D), q = (i / D) % 8, k = i % D; WG[i] = w_in[((size_t)l * D + k) * INW + SRC_GATE + q]; }
        for (int i = gt; i < DEPTH * ZW; i += ngt) { const int l = i / ZW, c = i % ZW; BIN[i] = b_in[(size_t)l * INW + (c < 8192 ? c : c + 8)]; }
        if (gt < 32) PAR[PAR_GBIAS + gt] = b_in[(size_t)(gt >> 3) * INW + SRC_GATE + (gt & 7)];
        if (gt < D) { PAR[PAR_ONE + gt] = 1.f; PAR[PAR_ZERO + gt] = 0.f; }
#define CPY(dst, src, n) do { const float* _s = (src); for (int i = gt; i < (n); i += ngt) PAR[(dst) + i] = _s[i]; } while (0)
        CPY(PAR_GWS, args.in[8], DEPTH * 8 * 128 * 128); CPY(PAR_GLNG, args.in[6], DEPTH * 1024); CPY(PAR_GLNB, args.in[7], DEPTH * 1024); CPY(PAR_GBS, args.in[9], DEPTH * 8 * 128);
        CPY(PAR_CONVW, args.in[10], DEPTH * 4 * 2048); CPY(PAR_CONVB, args.in[11], DEPTH * 2048); CPY(PAR_MNG, args.in[12], DEPTH * 2048);
        CPY(PAR_LN1G, args.in[18], DEPTH * D); CPY(PAR_LN1B, args.in[19], DEPTH * D); CPY(PAR_LN2G, args.in[22], DEPTH * D); CPY(PAR_LN2B, args.in[23], DEPTH * D);
#undef CPY
        { const float* gws = args.in[8];
          for (int i = gt; i < DEPTH * 8 * 16384; i += ngt) { const int lg = i >> 14, f = (i >> 9) & 31, ln = (i >> 3) & 63, j = i & 7; const int t = 16 * (f >> 2) + (ln & 15), sx = 32 * (f & 3) + 8 * (ln >> 4) + j;
              WF32[i] = (sx <= t) ? gws[((size_t)lg * 128 + t) * 128 + sx] : 0.f; }
          for (int i = gt; i < DEPTH * 8 * 128; i += ngt) { const int t = i & 127; const float* wr_ = gws + (size_t)i * 128; float sm = 0.f; for (int sx = 0; sx <= t; ++sx) sm += wr_[sx]; C2A[i] = sm; } }
        for (int i = gt; i < DEPTH * D * 256; i += ngt) { const int l = i / (D * 256), k = (i / 256) % D, c4 = (i & 255) * 4; const f32x4 v = *(const f32x4*)(w_in + ((size_t)l * D + k) * INW + 8200 + c4);
            u32x2 o; o.x = pk2(v.x, v.y); o.y = pk2(v.z, v.w); *(u32x2*)(WQN + ((size_t)l * D + k) * 1024 + c4) = o; }
        for (int i = gt; i < DEPTH * 1024; i += ngt) PAR[PAR_BQ + i] = b_in[(size_t)(i >> 10) * INW + 8200 + (i & 1023)];
        for (int m = F.gw; m < NBATCH * MEMLEN; m += F.ngw) row_pass(args.in[1] + (size_t)m * D, true, args.in[2], args.in[3], nullptr, MEMN + (size_t)m * D, nullptr, nullptr, nullptr, F.lane);
        __syncthreads();
        { LAS float* wg = (LAS float*)F.lds;
          for (int i = F.tid; i < 8 * D; i += 512) { const int q = i / D, k = i % D; wg[i] = w_in[(size_t)k * INW + SRC_GATE + q]; }
          __syncthreads();
          { f32x4 va[8], vb[8]; int m = F.gw; row_load(x_in + (size_t)m * D, va, F.lane);
            for (; m < T; m += F.ngw) { const int mn = (m + F.ngw < T) ? m + F.ngw : m; row_load(x_in + (size_t)mn * D, vb, F.lane);
                row_finish(va, false, nullptr, nullptr, PF + (size_t)m * D, XB + (size_t)m * D, wg, b_in + SRC_GATE, GATES + (size_t)m * 8, F.lane); if (F.lane == 0) { STAT[2 * m] = 0.f; STAT[2 * m + 1] = 1.f; }
#pragma unroll
                for (int j = 0; j < 8; ++j) va[j] = vb[j]; } }
          __syncthreads(); }
    }
    SEAM(0);
    if (IN(1)) {
        PHASE_CTX
        if (F.bid < 64) { pg8::GemmStd<D, D, D> g{MEMN, WKT}; pg8::StaticOrder<1024, 4096> S; S.init(64, F.bid); pg8::EpiBf16 E{KMEM, 4096};
          pg8::gemm_phase(F.lds, g, S, E, F.tid); }
        else if (F.bid < 128) { pg8::GemmStd<D, D, D> g{MEMN, WVT}; pg8::StaticOrder<1024, 4096> S; S.init(64, F.bid - 64); pg8::EpiBf16 E{VMEM, 4096};
          pg8::gemm_phase(F.lds, g, S, E, F.tid); }
    }
    SEAM(1);
    {
        PHASE_CTX
        { pg8::GemmQK g{KMEM, WQN}; pg8::StaticOrder<64 * 256, 2048> S; S.init(F.G, F.bid); pg8::EpiQK E{WQK};
          pg8::gemm_phase(F.lds, g, S, E, F.tid); }
        { pg8::GemmVW g{wsb + WS_WL, VMEM}; pg8::StaticOrder<512 * 256, 256> S; S.init(F.G, F.bid); pg8::EpiVW E{wsb};
          pg8::gemm_phase(F.lds, g, S, E, F.tid); }
        for (int i = F.bid * 512 + F.tid; i < DEPTH * 4 * 1024; i += F.G * 512) {
            const int l = i >> 12, b = (i >> 10) & 3, hm = i & 1023, h = hm >> 8, m = hm & 255;
            const bf16_t* kp = KMEM + (size_t)(b * 256 + m) * 4096 + l * 1024 + h * 256; const float* bq = PAR + PAR_BQ + l * 1024 + h * 256; float sm = 0.f;
            for (int d8 = 0; d8 < 256; d8 += 8) { const u32x4 kv = *(const u32x4*)(kp + d8); const f32x4 q0 = *(const f32x4*)(bq + d8), q1 = *(const f32x4*)(bq + d8 + 4);
                sm += bflo(kv.x) * q0[0] + bfhi(kv.x) * q0[1] + bflo(kv.y) * q0[2] + bfhi(kv.y) * q0[3] + bflo(kv.z) * q1[0] + bfhi(kv.z) * q1[1] + bflo(kv.w) * q1[2] + bfhi(kv.w) * q1[3]; }
            BQK[i] = sm * pg8::SCORE_SCALE; }
    }
    GRID_BAR();

    for (int lyr = 0; lyr < DEPTH; ++lyr) {
        const int pb = 2 + 10 * lyr;
#define LAYER_CTX PHASE_CTX int l = lyr; asm volatile("" : "+s"(l)); unsigned char* wl = wsb + WS_WL + (size_t)l * WL_STRIDE; (void)wl;
        if (IN(pb + 0)) {
            LAYER_CTX
            for (int ch = F.gw; ch < 1024; ch += F.ngw) {
                const int bh = ch >> 6, c = ch & 63, b = bh >> 2, h = bh & 3;
                const size_t row = (size_t)b * SEQ + 64 * c + F.lane;
                const float gi = GATES[row * 8 + h], gf = GATES[row * 8 + 4 + h];
                float bc = fminf(gf, 0.f) - log1pf(expf(-fabsf(gf)));
#pragma unroll
                for (int o = 1; o < 64; o <<= 1) { const float y = shup(bc, o, F.lane); if (F.lane >= o) bc += y; }
                const float bv = gi - bc; float pm = bv;
#pragma unroll
                for (int o = 1; o < 64; o <<= 1) { const float y = shup(pm, o, F.lane); if (F.lane >= o) pm = fmaxf(pm, y); }
                const int pos = bh * 4096 + 64 * c + F.lane;
                GS[GS_BCUM + pos] = bc; GS[GS_BV + pos] = bv; GS[GS_PMAX + pos] = pm;
                if (F.lane == 63) { GS[GS_BLAST + ch] = bc; GS[GS_MAXB + ch] = pm; }
            }
            pg8::GemmIn g{XB, (const bf16_t*)(wl + WL_IN), WQK + (size_t)l * 4 * 1024 * D}; pg8::StaticOrder<T, ZW> S; S.init(F.G, F.bid);
            pg8::EpiIn E{Z, BIN + (size_t)l * ZW, BQK + (size_t)l * 4096, (LAS float*)(F.lds + RING_BYTES)};
            pg8::gemm_phase(F.lds, g, S, E, F.tid);
        }
        SEAM(pb + 0);
        if (IN(pb + 1)) {
            LAYER_CTX
            {
                LAS bf16_t* QL = (LAS bf16_t*)F.lds; LAS bf16_t* KL = QL + 64 * 264; LAS bf16_t* PL = KL + 64 * 264;
                LAS float* WSL = (LAS float*)(PL + 64 * 72);
                LAS bf16_t* VTL = (LAS bf16_t*)(WSL + 64);
                const int w = F.wave, fr = F.lane & 15, fq = F.lane >> 4;
                u32x4 zr[11], va[8]; f32x4 cw[4][2], cb2[2]; float bl, mb;
                auto pp_load = [&](int chx) {
                    const int bhx = chx >> 6, cx = chx & 63, bx = bhx >> 2, hx = bhx & 3; const size_t row0x = (size_t)bx * SEQ + 64 * cx;
                    bl = GS[GS_BLAST + bhx * 64 + F.lane]; mb = GS[GS_MAXB + bhx * 64 + F.lane];
                    const int cg = F.tid & 63, rg = F.tid >> 6; const int chz = (cg < 32) ? hx * 256 + 8 * cg : 1024 + hx * 256 + 8 * (cg - 32);
                    const float* cwp = PAR + PAR_CONVW + l * 4 * 2048 + chz; const float* cbp = PAR + PAR_CONVB + l * 2048 + chz;
#pragma unroll
                    for (int j = 0; j < 4; ++j) { cw[j][0] = *(const f32x4*)(cwp + j * 2048); cw[j][1] = *(const f32x4*)(cwp + j * 2048 + 4); }
                    cb2[0] = *(const f32x4*)cbp; cb2[1] = *(const f32x4*)(cbp + 4);
                    const bf16_t* zp = Z + (row0x + 8 * rg) * ZW + ZQK + chz;
#pragma unroll
                    for (int k = 0; k < 11; ++k) { if (k >= 3 || rg > 0 || cx > 0) zr[k] = *(const u32x4*)(zp + (ptrdiff_t)(k - 3) * ZW); else zr[k] = (u32x4){0u, 0u, 0u, 0u}; }
                    const int sx = F.tid & 63, cq = F.tid >> 6; const bf16_t* vp = Z + (row0x + sx) * ZW + ZVM + hx * 512 + 64 * cq;
#pragma unroll
                    for (int q = 0; q < 8; ++q) va[q] = *(const u32x4*)(vp + 8 * q);
                };
                pp_load(F.bid);
                for (int ch = F.bid; ch < 1024; ch += F.G) {
                    const int bh = ch >> 6, c = ch & 63, b = bh >> 2, h = bh & 3; const size_t row0 = (size_t)b * SEQ + 64 * c; const int pos0 = bh * 4096 + 64 * c;
                    float mp = 0.f;
                    for (int cc = 0; cc < c; ++cc) mp = rdlane(bl, cc) + fmaxf(mp, rdlane(mb, cc));
                    const float mm = fmaxf(mp, GS[GS_MAXB + ch]);
                    if (F.tid == 0) GS[GS_MPREV + ch] = mp;
                    if (F.tid < 64) { WSL[F.tid] = expf(GS[GS_BV + pos0 + F.tid] - mm); WIG[(size_t)ch * 256 + F.tid] = expf(mp - fmaxf(GS[GS_PMAX + pos0 + F.tid], mp)); }
                    if (F.tid == 64) WIG[(size_t)ch * 256 + 64] = expf(mp - mm);
                    {
                      const int cg = F.tid & 63, rg = F.tid >> 6;
                      const float osc = (cg < 32) ? 1.0f : 0.0625f;
                      f32x4 zf[11][2];
#pragma unroll
                      for (int k = 0; k < 11; ++k) { zf[k][0] = (f32x4){bflo(zr[k].x), bfhi(zr[k].x), bflo(zr[k].y), bfhi(zr[k].y)}; zf[k][1] = (f32x4){bflo(zr[k].z), bfhi(zr[k].z), bflo(zr[k].w), bfhi(zr[k].w)}; }
                      LAS bf16_t* dst = ((cg < 32) ? QL : KL) + (8 * rg) * 264 + 8 * (cg & 31);
#pragma unroll
                      for (int rr = 0; rr < 8; ++rr) { f32x4 y0 = cb2[0], y1 = cb2[1];
#pragma unroll
                          for (int j = 0; j < 4; ++j) { y0 += cw[j][0] * zf[rr + j][0]; y1 += cw[j][1] * zf[rr + j][1]; }
#pragma unroll
                          for (int e = 0; e < 4; ++e) { y0[e] = y0[e] * fast_sigmoid(y0[e]) * osc; y1[e] = y1[e] * fast_sigmoid(y1[e]) * osc; }
                          u32x4 o; o.x = cvt_pk_bf16(y0[0], y0[1]); o.y = cvt_pk_bf16(y0[2], y0[3]); o.z = cvt_pk_bf16(y1[0], y1[1]); o.w = cvt_pk_bf16(y1[2], y1[3]);
                          *(LAS u32x4*)(dst + rr * 264) = o; } }
                    {
                      const int sx = F.tid & 63, cq = F.tid >> 6;
#pragma unroll
                      for (int q = 0; q < 8; ++q) { const u32x4 a = va[q]; LAS bf16_t* d0 = VTL + (64 * cq + 8 * q) * 72 + sx;
                          d0[0] = (bf16_t)(a.x & 0xffffu); d0[72] = (bf16_t)(a.x >> 16); d0[2 * 72] = (bf16_t)(a.y & 0xffffu); d0[3 * 72] = (bf16_t)(a.y >> 16);
                          d0[4 * 72] = (bf16_t)(a.z & 0xffffu); d0[5 * 72] = (bf16_t)(a.z >> 16); d0[6 * 72] = (bf16_t)(a.w & 0xffffu); d0[7 * 72] = (bf16_t)(a.w >> 16); } }
                    pp_load(ch + F.G < 1024 ? ch + F.G : ch);
                    __syncthreads();
                    const int tb = w >> 1, half = w & 1;
                    bf16x8 qa[8];
#pragma unroll
                    for (int i = 0; i < 8; ++i) qa[i] = *(const LAS bf16x8*)(QL + (16 * tb + fr) * 264 + 32 * i + 8 * fq);
                    { bf16_t* qf = QF + ((size_t)ch * 32 + tb * 8 + 4 * half) * 512 + F.lane * 8;
                      const float wir = expf(mp - fmaxf(GS[GS_PMAX + pos0 + 16 * tb + fr], mp));
#pragma unroll
                      for (int ii = 0; ii < 4; ++ii) { const int i = 4 * half + ii; const LAS bf16_t* qp = QL + (16 * tb + fr) * 264 + 32 * i + 4 * fq;
                          u32x4 o; const u32x2 lo = *(const LAS u32x2*)qp, hi = *(const LAS u32x2*)(qp + 16);
                          o.x = cvt_pk_bf16(bflo(lo.x) * wir, bfhi(lo.x) * wir); o.y = cvt_pk_bf16(bflo(lo.y) * wir, bfhi(lo.y) * wir); o.z = cvt_pk_bf16(bflo(hi.x) * wir, bfhi(hi.x) * wir); o.w = cvt_pk_bf16(bflo(hi.y) * wir, bfhi(hi.y) * wir);
                          *(u32x4*)(qf + ii * 512) = o; } }
                    const f32x4 pm4 = *(const f32x4*)(GS + GS_PMAX + pos0 + 16 * tb + 4 * fq);
#pragma unroll
                    for (int sbi = 0; sbi < 2; ++sbi) { const int sb = 2 * half + sbi; f32x4 acc = (f32x4){0.f, 0.f, 0.f, 0.f};
                        if (sb <= tb) {
#pragma unroll
                            for (int i = 0; i < 8; ++i) { const bf16x8 kb = *(const LAS bf16x8*)(KL + (16 * sb + fr) * 264 + 32 * i + 8 * fq); acc = mfma16(qa[i], kb, acc); }
                            const float Bs = GS[GS_BV + pos0 + 16 * sb + fr]; const int sx = 16 * sb + fr;
#pragma unroll
                            for (int r = 0; r < 4; ++r) { const int t = 16 * tb + 4 * fq + r; const float At = -fmaxf(pm4[r], mp); acc[r] = (sx <= t) ? expf(At + Bs) * acc[r] : 0.f; } }
#pragma unroll
                        for (int r = 0; r < 4; ++r) PL[(16 * tb + 4 * fq + r) * 72 + 16 * sb + fr] = (bf16_t)f2bf(acc[r]); }
                    __syncthreads();
                    { const int i = w & 1; const bf16x8 pf = *(const LAS bf16x8*)(PL + (16 * tb + fr) * 72 + 32 * i + 8 * fq);
                      *(bf16x8*)(PFR + ((size_t)ch * 8 + tb * 2 + i) * 512 + F.lane * 8) = pf; }
#pragma unroll
                    for (int dbi = 0; dbi < 2; ++dbi)
#pragma unroll
                        for (int i = 0; i < 2; ++i) { const int db = 2 * w + dbi; float kv[8];
#pragma unroll
                            for (int j = 0; j < 8; ++j) { const int sx = 32 * i + 8 * fq + j; kv[j] = WSL[sx] * bf2f(KL[sx * 264 + 16 * db + fr]); }
                            u32x4 o; o.x = pk2(kv[0], kv[1]); o.y = pk2(kv[2], kv[3]); o.z = pk2(kv[4], kv[5]); o.w = pk2(kv[6], kv[7]);
                            *(u32x4*)(KF + ((size_t)ch * 32 + db * 2 + i) * 512 + F.lane * 8) = o; }
#pragma unroll
                    for (int vi = 0; vi < 4; ++vi)
#pragma unroll
                        for (int i = 0; i < 2; ++i) { const int vblk = 4 * w + vi; const u32x4 o = *(const LAS u32x4*)(VTL + (16 * vblk + fr) * 72 + 32 * i + 8 * fq);
                            *(u32x4*)(VF + ((size_t)ch * 64 + vblk * 2 + i) * 512 + F.lane * 8) = o; }
                    __syncthreads();
                }
            }
            for (int m0 = F.gw * 8; m0 < T; m0 += F.ngw * 8) {
                u32x4 ra[8], rbv[8];
#pragma unroll
                for (int rr = 0; rr < 8; ++rr) { const bf16_t* vp = Z + (size_t)(m0 + rr) * ZW + ZV; ra[rr] = *(const u32x4*)(vp + 8 * F.lane); rbv[rr] = *(const u32x4*)(vp + 512 + 8 * F.lane); }
                float s1[8], s2[8];
#pragma unroll
                for (int rr = 0; rr < 8; ++rr) { const u32x4 a = ra[rr], b = rbv[rr];
                    const float e[16] = {bflo(a.x), bfhi(a.x), bflo(a.y), bfhi(a.y), bflo(a.z), bfhi(a.z), bflo(a.w), bfhi(a.w), bflo(b.x), bfhi(b.x), bflo(b.y), bfhi(b.y), bflo(b.z), bfhi(b.z), bflo(b.w), bfhi(b.w)};
                    float t1 = 0.f, t2 = 0.f;
#pragma unroll
                    for (int j = 0; j < 16; ++j) { t1 += e[j]; t2 += e[j] * e[j]; }
                    s1[rr] = t1; s2[rr] = t2; }
#pragma unroll
                for (int rr = 0; rr < 8; ++rr) { s1[rr] = wave_sum(s1[rr], F.lane); s2[rr] = wave_sum(s2[rr], F.lane); }
#pragma unroll
                for (int rr = 0; rr < 8; ++rr) { const float mean = s1[rr] * (1.f / 1024.f); const float var = fmaxf(s2[rr] * (1.f / 1024.f) - mean * mean, 0.f);
                    if (F.lane == 0) { VSTAT[2 * (m0 + rr)] = mean; VSTAT[2 * (m0 + rr) + 1] = 1.f / sqrtf(var + LN_EPS); } }
            }
        }
        SEAM(pb + 1);
        {
            LAYER_CTX
            if (F.bid < 80) {
            LAS unsigned char* RG = F.lds;
            const int w = F.wave, fr = F.lane & 15, fq = F.lane >> 4;
            const bool is_den = F.bid >= 64;
            const int it = is_den ? F.bid - 64 : F.bid;
            const int bh = is_den ? (it & 7) * 2 + (it >> 3) : (it & 7) * 2 + (it >> 5), jq = is_den ? 0 : (it >> 3) & 3, b = bh >> 2, h = bh & 3;
            const bool active = w < 4 && (!is_den || w == 0);
            bf16x8 ones; { const short o1 = (fr == 0) ? (short)0x3f80 : (short)0; ones = (bf16x8){o1, o1, o1, o1, o1, o1, o1, o1}; }
            const int lo8 = F.lane * 8;
            f32x4 CA[16], CB[16];
#pragma unroll
            for (int i = 0; i < 16; ++i) { CA[i] = (f32x4){0.f, 0.f, 0.f, 0.f}; CB[i] = (f32x4){0.f, 0.f, 0.f, 0.f}; }
            bf16x8 vA[2], vB[2];
            vA[0] = ones; vA[1] = ones; vB[0] = ones; vB[1] = ones;
            float* const dmy = (float*)(wsb + WS_DUMMY) + ((size_t)F.bid * 512 + F.tid) * 4;
#define SC_DMA(c_, sl_) do { const size_t chh = (size_t)bh * 64 + (c_); int wd_ = w - 4; asm volatile("" : "+s"(wd_));        \
                _Pragma("unroll") for (int i = 0; i < 18; ++i) { const int p_ = 18 * wd_ + i; \
                    const bf16_t* src_ = (p_ < 32) ? QF + (chh * 32 + p_) * 512 : (p_ < 40) ? PFR + (chh * 8 + (p_ - 32)) * 512 : KF + (chh * 32 + (p_ - 40)) * 512; \
                    __builtin_amdgcn_global_load_lds((const unsigned*)(src_ + lo8), (LAS unsigned*)(RG + (sl_) * 74752 + p_ * 1024), 16, 0, 0); } \
                if (wd_ == 0) { int l4_ = lo8; asm volatile("" : "+v"(l4_)); l4_ >>= 1; __builtin_amdgcn_global_load_lds((const unsigned*)(WIG + chh * 256 + l4_), (LAS unsigned*)(RG + (sl_) * 74752 + 72 * 1024), 16, 0, 0); } } while (0)
#define SC_LOADV(c_) do { if (active && !is_den) { const bf16_t* v_ = VF + (((size_t)bh * 64 + (c_)) * 64 + (8 * jq + 2 * w) * 2) * 512 + lo8; \
                vA[0] = *(const bf16x8*)v_; vA[1] = *(const bf16x8*)(v_ + 512); vB[0] = *(const bf16x8*)(v_ + 1024); vB[1] = *(const bf16x8*)(v_ + 1536); } } while (0)
#define SC_SB __builtin_amdgcn_sched_barrier(0)
#define SC_RD4(dst, p0, p1, p2, p3) do { dst[0] = *(const LAS bf16x8*)(sb_ + (p0) * 1024); dst[1] = *(const LAS bf16x8*)(sb_ + (p1) * 1024); dst[2] = *(const LAS bf16x8*)(sb_ + (p2) * 1024); dst[3] = *(const LAS bf16x8*)(sb_ + (p3) * 1024); SC_SB; } while (0)
#define SC_W4 do { asm volatile("s_waitcnt lgkmcnt(4)" ::: "memory"); SC_SB; } while (0)
#define SC_INTER2(j, cur) do { \
                { const bf16x8 ca_ = pack8(CA[4 * (j)], CA[4 * (j) + 1]), cb_ = pack8(CB[4 * (j)], CB[4 * (j) + 1]); a0A = mfma16(cur[0], ca_, a0A); a0B = mfma16(cur[0], cb_, a0B); a1A = mfma16(cur[2], ca_, a1A); a1B = mfma16(cur[2], cb_, a1B); } \
                { const bf16x8 ca_ = pack8(CA[4 * (j) + 2], CA[4 * (j) + 3]), cb_ = pack8(CB[4 * (j) + 2], CB[4 * (j) + 3]); a0A = mfma16(cur[1], ca_, a0A); a0B = mfma16(cur[1], cb_, a0B); a1A = mfma16(cur[3], ca_, a1A); a1B = mfma16(cur[3], cb_, a1B); } SC_SB; } while (0)
#define SC_INTRA2(cur) do { a0A = mfma16(cur[0], vA[0], a0A); a0B = mfma16(cur[0], vB[0], a0B); a1A = mfma16(cur[2], vA[0], a1A); a1B = mfma16(cur[2], vB[0], a1B); \
                a0A = mfma16(cur[1], vA[1], a0A); a0B = mfma16(cur[1], vB[1], a0B); a1A = mfma16(cur[3], vA[1], a1A); a1B = mfma16(cur[3], vB[1], a1B); SC_SB; } while (0)
#define SC_OUT(p) do { if (!is_den) { bf16_t* hp = HRAW + (row0 + 32 * (p)) * 2048 + h * 512 + 128 * jq + 32 * w + ((4 * fq) * 2048 + fr); \
                    _Pragma("unroll") for (int r = 0; r < 4; ++r) { hp[r * 2048] = (bf16_t)f2bf(a0A[r]); hp[r * 2048 + 16] = (bf16_t)f2bf(a0B[r]); hp[(16 + r) * 2048] = (bf16_t)f2bf(a1A[r]); hp[(16 + r) * 2048 + 16] = (bf16_t)f2bf(a1B[r]); } } \
                else { float* dp = (fr == 0) ? DEN + (row0 + 32 * (p)) * 4 + h + (4 * fq) * 4 : dmy; const int ds_ = (fr == 0) ? 4 : 0; \
                    _Pragma("unroll") for (int r = 0; r < 4; ++r) { dp[r * ds_] = a0A[r]; dp[(16 + r) * ds_] = a1A[r]; } } \
                SC_SB; } while (0)
#define SC_ZERO do { a0A = (f32x4){0.f, 0.f, 0.f, 0.f}; a0B = a0A; a1A = a0A; a1B = a0A; } while (0)
#define SC_UPD(u, cur) do { f32x4 t0_ = scale4(CA[2 * (u)], dec), t1_ = scale4(CB[2 * (u)], dec), t2_ = scale4(CA[2 * (u) + 1], dec), t3_ = scale4(CB[2 * (u) + 1], dec); \
                t0_ = mfma16(cur[0], vA[0], t0_); t1_ = mfma16(cur[0], vB[0], t1_); t2_ = mfma16(cur[2], vA[0], t2_); t3_ = mfma16(cur[2], vB[0], t3_); \
                CA[2 * (u)] = mfma16(cur[1], vA[1], t0_); CB[2 * (u)] = mfma16(cur[1], vB[1], t1_); CA[2 * (u) + 1] = mfma16(cur[3], vA[1], t2_); CB[2 * (u) + 1] = mfma16(cur[3], vB[1], t3_); SC_SB; } while (0)
#define SC_STEP(c_, sl_, cn_, sn_) do { const size_t row0 = (size_t)b * SEQ + 64 * (c_); \
                const LAS unsigned char* sb_ = RG + (sl_) * 74752 + F.lane * 16; const LAS float* wip_ = (const LAS float*)(RG + (sl_) * 74752 + 72 * 1024); \
                if (active) { \
                const float dec = wip_[64]; \
                f32x4 a0A, a0B, a1A, a1B; bf16x8 fa[4], fb[4]; \
                SC_ZERO; \
                SC_RD4(fa, 0, 1, 8, 9); \
                SC_RD4(fb, 2, 3, 10, 11); SC_W4; SC_INTER2(0, fa); \
                SC_RD4(fa, 4, 5, 12, 13); SC_W4; SC_INTER2(1, fb); \
                SC_RD4(fb, 6, 7, 14, 15); SC_W4; SC_INTER2(2, fa); \
                SC_RD4(fa, 32, 33, 34, 35); SC_W4; SC_INTER2(3, fb); \
                SC_RD4(fb, 16, 17, 24, 25); SC_W4; SC_INTRA2(fa); SC_OUT(0); SC_ZERO; \
                _Pragma("unroll") for (int i = 0; i < 16; ++i) asm volatile("" : "+v"(CA[i]), "+v"(CB[i]));        \
                SC_RD4(fa, 18, 19, 26, 27); SC_W4; SC_INTER2(0, fb); \
                SC_RD4(fb, 20, 21, 28, 29); SC_W4; SC_INTER2(1, fa); \
                SC_RD4(fa, 22, 23, 30, 31); SC_W4; SC_INTER2(2, fb); \
                SC_RD4(fb, 36, 37, 38, 39); SC_W4; SC_INTER2(3, fa); \
                SC_RD4(fa, 40, 41, 42, 43); SC_W4; SC_INTRA2(fb); SC_OUT(1); \
                SC_RD4(fb, 44, 45, 46, 47); SC_W4; SC_UPD(0, fa); \
                SC_RD4(fa, 48, 49, 50, 51); SC_W4; SC_UPD(1, fb); \
                SC_RD4(fb, 52, 53, 54, 55); SC_W4; SC_UPD(2, fa); \
                SC_RD4(fa, 56, 57, 58, 59); SC_W4; SC_UPD(3, fb); \
                SC_RD4(fb, 60, 61, 62, 63); SC_W4; SC_UPD(4, fa); \
                SC_RD4(fa, 64, 65, 66, 67); SC_W4; SC_UPD(5, fb); \
                SC_RD4(fb, 68, 69, 70, 71); SC_W4; SC_UPD(6, fa); \
                asm volatile("s_waitcnt lgkmcnt(0)" ::: "memory"); SC_SB; SC_UPD(7, fb); \
                } else if (w >= 4) { SC_DMA(cn_, sn_); asm volatile("" ::: "memory"); __builtin_amdgcn_s_waitcnt(0x0070); }       \
                __builtin_amdgcn_s_barrier(); asm volatile("" ::: "memory"); } while (0)
            if (w >= 4) { SC_DMA(0, 0); }
            asm volatile("" ::: "memory"); __builtin_amdgcn_s_waitcnt(0x0070); __builtin_amdgcn_s_barrier(); asm volatile("" ::: "memory");
#define SC_TRIP(c) do { { SC_LOADV((c)); SC_STEP((c), 0, (c) + 1, 1); } \
                { const int cnx_ = (c) + 2 < 64 ? (c) + 2 : 63; SC_LOADV((c) + 1); SC_STEP((c) + 1, 1, cnx_, 0); } } while (0)
#pragma nounroll
            for (int c = 0; c < 64; c += 2) SC_TRIP(c);
#undef SC_TRIP
#undef SC_STEP
#undef SC_UPD
#undef SC_ZERO
#undef SC_OUT
#undef SC_INTRA2
#undef SC_INTER2
#undef SC_W4
#undef SC_RD4
#undef SC_SB
#undef SC_LOADV
#undef SC_DMA
            asm volatile("s_waitcnt vmcnt(0)" ::: "memory");
            __syncthreads();
            } else {
            {
                LAS bf16_t* VT = (LAS bf16_t*)F.lds;
                LAS float* ST = (LAS float*)(F.lds + 128 * 136 * 2);
                LAS float* C1 = ST + 256;
                const int w = F.wave, fr = F.lane & 15, fq = F.lane >> 4, nst = (w >> 1) + 1;
                for (int un = F.bid - 80; un < 256; un += 176) {
                    const int cc = un >> 1, hf = un & 1; const size_t r0 = (size_t)cc * 128;
                    if (F.tid < 128) { const f32x2 sv = *(const f32x2*)(VSTAT + 2 * (r0 + F.tid)); ST[F.tid] = sv.x; ST[128 + F.tid] = sv.y; }
                    __syncthreads();
                    u32x4 ta[4]; f32x4 wa[4][2]; unsigned short uvA[8][4];
#pragma unroll
                    for (int i = 0; i < 4; ++i) { ta[i] = (u32x4){0u, 0u, 0u, 0u}; wa[i][0] = (f32x4){0.f, 0.f, 0.f, 0.f}; wa[i][1] = (f32x4){0.f, 0.f, 0.f, 0.f}; }
#pragma unroll
                    for (int db = 0; db < 8; ++db)
#pragma unroll
                        for (int r = 0; r < 4; ++r) uvA[db][r] = 0;
#define BRA_LOAD_TW(gi_) do { const int gq_ = 4 * hf + (gi_), lg_ = l * 8 + gq_; const bf16_t* vp = Z + (r0 + (F.tid & 127)) * ZW + ZV + gq_ * 128 + (F.tid >> 7) * 32; \
                        _Pragma("unroll") for (int q = 0; q < 4; ++q) ta[q] = *(const u32x4*)(vp + 8 * q); \
                        _Pragma("unroll") for (int i = 0; i < 4; ++i) if (i < nst) { const float* wp = WF32 + ((size_t)lg_ * 32 + w * 4 + i) * 512 + F.lane * 8; wa[i][0] = *(const f32x4*)wp; wa[i][1] = *(const f32x4*)(wp + 4); } } while (0)
#define BRA_LOAD_UV(gi_, UV) do { const bf16_t* up0 = Z + (r0 + 16 * w + 4 * fq) * ZW + ZU + (4 * hf + (gi_)) * 128 + fr; \
                        _Pragma("unroll") for (int db = 0; db < 8; ++db) _Pragma("unroll") for (int r = 0; r < 4; ++r) UV[db][r] = up0[(size_t)r * ZW + 16 * db]; } while (0)
                    BRA_LOAD_TW(0); BRA_LOAD_UV(0, uvA);
#pragma nounroll
                    for (int gi = 0; gi < 4; ++gi) { const int gq = 4 * hf + gi, lg = l * 8 + gq;
                        { const int sx = F.tid & 127, c0 = (F.tid >> 7) * 32;
#pragma unroll
                          for (int q = 0; q < 4; ++q) { const u32x4 a = ta[q]; LAS bf16_t* d0 = VT + (c0 + 8 * q) * 136 + sx;
                              d0[0] = (bf16_t)(a.x & 0xffffu); d0[136] = (bf16_t)(a.x >> 16); d0[2 * 136] = (bf16_t)(a.y & 0xffffu); d0[3 * 136] = (bf16_t)(a.y >> 16);
                              d0[4 * 136] = (bf16_t)(a.z & 0xffffu); d0[5 * 136] = (bf16_t)(a.z >> 16); d0[6 * 136] = (bf16_t)(a.w & 0xffffu); d0[7 * 136] = (bf16_t)(a.w >> 16); } }
                        bf16x8 af[4]; float c1p = 0.f;
#pragma unroll
                        for (int i = 0; i < 4; ++i) { u32x4 o = (u32x4){0u, 0u, 0u, 0u};
                            if (i < nst) { const f32x4 w0 = wa[i][0], w1 = wa[i][1];
                                const LAS float* sp = ST + 32 * i + 8 * fq; const f32x4 m0 = *(const LAS f32x4*)sp, m1 = *(const LAS f32x4*)(sp + 4), q0 = *(const LAS f32x4*)(sp + 128), q1 = *(const LAS f32x4*)(sp + 132);
                                const f32x4 p0 = w0 * q0, p1 = w1 * q1;
                                o.x = pk2(p0[0], p0[1]); o.y = pk2(p0[2], p0[3]); o.z = pk2(p1[0], p1[1]); o.w = pk2(p1[2], p1[3]);
                                c1p += bflo(o.x) * m0[0] + bfhi(o.x) * m0[1] + bflo(o.y) * m0[2] + bfhi(o.y) * m0[3] + bflo(o.z) * m1[0] + bfhi(o.z) * m1[1] + bflo(o.w) * m1[2] + bfhi(o.w) * m1[3]; }
                            af[i] = __builtin_bit_cast(bf16x8, o); }
                        c1p += shx(c1p, 16, F.lane); c1p += shx(c1p, 32, F.lane);
                        if (fq == 0) C1[w * 16 + fr] = c1p;
                        __syncthreads();
                        if (gi < 3) BRA_LOAD_TW(gi + 1);
                        const f32x4 c14 = *(const LAS f32x4*)(C1 + w * 16 + 4 * fq);
                        const f32x4 c24 = *(const f32x4*)(C2A + lg * 128 + 16 * w + 4 * fq), bs4 = *(const f32x4*)(PAR + PAR_GBS + lg * 128 + 16 * w + 4 * fq);
#pragma unroll
                        for (int db = 0; db < 8; ++db) { f32x4 acc = (f32x4){0.f, 0.f, 0.f, 0.f};
#pragma unroll
                            for (int i = 0; i < 4; ++i) if (i < nst) { const bf16x8 bb = *(const LAS bf16x8*)(VT + (16 * db + fr) * 136 + 32 * i + 8 * fq); acc = mfma16(af[i], bb, acc); }
                            const int dcol = gq * 128 + 16 * db + fr; const float gg = PAR[PAR_GLNG + l * 1024 + dcol], bbv = PAR[PAR_GLNB + l * 1024 + dcol];
                            bf16_t* up = Z + (r0 + 16 * w + 4 * fq) * ZW + ZU + dcol;
#pragma unroll
                            for (int r = 0; r < 4; ++r) { const float mixed = gg * (acc[r] - c14[r]) + bbv * c24[r] + bs4[r]; up[(size_t)r * ZW] = (bf16_t)f2bf(bf2f(uvA[db][r]) * mixed); } }
                        asm volatile("" ::: "memory");
                        if (gi < 3) BRA_LOAD_UV(gi + 1, uvA);
                        __syncthreads();
                    }
#undef BRA_LOAD_TW
#undef BRA_LOAD_UV
                }
            }
                __syncthreads();
                { pg8::GemmT<ZW, 1024, 1024, 256L * ZW, 0L, 2048L * 1024, 256L * 1024> g{Z + ZQX, (const bf16_t*)(wsb + (l < 2 ? WS_VW01 + (size_t)l * 16 * MiB : WS_VW23 + (size_t)(l - 2) * 16 * MiB))};
                  pg8::StaticOrder<T, D> S; S.init(176, F.bid - 80); pg8::EpiGate<0> E{Z + ZG + 4096, MRG};
                  pg8::gemm_phase(F.lds, g, S, E, F.tid); }
            }
        }
        GRID_BAR();
        if (IN(pb + 2)) {
            LAYER_CTX
            for (int it0 = F.gw; it0 < T * 4; it0 += 4 * F.ngw) {
                u32x4 hw[4], ow[4]; float g0_[4], g1_[4], g2_[4], dnr[4]; f32x4 ga[4], gb[4];
#pragma unroll
                for (int q = 0; q < 4; ++q) { const int it = it0 + q * F.ngw; const size_t r = (size_t)(it >> 2); const int hq = it & 3; const int c0 = hq * 512 + 8 * F.lane;
                    hw[q] = *(const u32x4*)(HRAW + r * 2048 + c0); ow[q] = *(const u32x4*)(Z + r * ZW + ZO + c0);
                    const int bh = (int)(r >> 12) * 4 + hq, tp = (int)(r & 4095), pos = bh * 4096 + tp;
                    g0_[q] = GS[GS_BCUM + pos]; g1_[q] = GS[GS_PMAX + pos]; g2_[q] = GS[GS_MPREV + bh * 64 + (tp >> 6)]; dnr[q] = DEN[r * 4 + hq];
                    ga[q] = *(const f32x4*)(PAR + PAR_MNG + l * 2048 + c0); gb[q] = *(const f32x4*)(PAR + PAR_MNG + l * 2048 + c0 + 4); }
#pragma unroll
                for (int q = 0; q < 4; ++q) { const int it = it0 + q * F.ngw; const size_t r = (size_t)(it >> 2); const int hq = it & 3; const int c0 = hq * 512 + 8 * F.lane;
                    f32x4 a = (f32x4){bflo(hw[q].x), bfhi(hw[q].x), bflo(hw[q].y), bfhi(hw[q].y)}, b4 = (f32x4){bflo(hw[q].z), bfhi(hw[q].z), bflo(hw[q].w), bfhi(hw[q].w)};
                    { const float mrow = g0_[q] + fmaxf(g1_[q], g2_[q]); const float dn = 1.f / fmaxf(fabsf(dnr[q]), expf(-mrow)); a = a * dn; b4 = b4 * dn; }
                    const float mean = wave_sum((a.x + a.y) + (a.z + a.w) + (b4.x + b4.y) + (b4.z + b4.w), F.lane) * (1.f / 512.f);
                    const f32x4 da = a - mean, db = b4 - mean;
                    const float var = wave_sum((da.x * da.x + da.y * da.y) + (da.z * da.z + da.w * da.w) + (db.x * db.x + db.y * db.y) + (db.z * db.z + db.w * db.w), F.lane) * (1.f / 512.f);
                    const float rstd = 1.f / sqrtf(var + LN_EPS);
                    const f32x4 ya = da * rstd * ga[q], yb = db * rstd * gb[q]; const u32x4 o4 = ow[q];
                    u32x4 w; w.x = pk2(ya.x * bflo(o4.x), ya.y * bfhi(o4.x)); w.y = pk2(ya.z * bflo(o4.y), ya.w * bfhi(o4.y)); w.z = pk2(yb.x * bflo(o4.z), yb.y * bfhi(o4.z)); w.w = pk2(yb.z * bflo(o4.w), yb.w * bfhi(o4.w));
                    *(u32x4*)(Z + r * ZW + ZO + c0) = w; }
            }
        }
        SEAM(pb + 2);
        if (IN(pb + 4)) {
            LAYER_CTX
            int og = (F.bid >> 3) & 1; asm volatile("" : "+s"(og));
            if (og == 0) {
                { pg8::GemmStd<ZW, 1024, 1024> g{Z + ZU, (const bf16_t*)(wl + WL_PA)}; pg8::StaticOrder<T, D> S; S.init(F.G, F.bid); pg8::EpiGate<1> E{Z + ZG, MRG};
                  pg8::gemm_phase(F.lds, g, S, E, F.tid); }
                { pg8::GemmStd<ZW, 2048, 2048> g{Z + ZO, (const bf16_t*)(wl + WL_PB)}; pg8::StaticOrder<T, D> S; S.init(F.G, F.bid); pg8::EpiGate<1> E{Z + ZG + 2048, MRG};
                  pg8::gemm_phase(F.lds, g, S, E, F.tid); }
            } else {
                { pg8::GemmStd<ZW, 2048, 2048> g{Z + ZO, (const bf16_t*)(wl + WL_PB)}; pg8::StaticOrder<T, D> S; S.init(F.G, F.bid); pg8::EpiGate<1> E{Z + ZG + 2048, MRG};
                  pg8::gemm_phase(F.lds, g, S, E, F.tid); }
                { pg8::GemmStd<ZW, 1024, 1024> g{Z + ZU, (const bf16_t*)(wl + WL_PA)}; pg8::StaticOrder<T, D> S; S.init(F.G, F.bid); pg8::EpiGate<1> E{Z + ZG, MRG};
                  pg8::gemm_phase(F.lds, g, S, E, F.tid); }
            }
        }
        SEAM(pb + 4);
        if (IN(pb + 5)) {
            LAYER_CTX
            pg8::GemmStd<D, D, D> g{MRG, (const bf16_t*)(wl + WL_OUT)}; pg8::StaticOrder<T, D> S; S.init(F.G, F.bid);
            pg8::EpiResid E{PF, STAT, l ? PAR + PAR_LN2G + (l - 1) * D : PAR + PAR_ONE, l ? PAR + PAR_LN2B + (l - 1) * D : PAR + PAR_ZERO};
            pg8::gemm_phase(F.lds, g, S, E, F.tid);
        }
        SEAM(pb + 5);
        if (IN(pb + 6)) {
            LAYER_CTX
            { f32x4 va[8], vb[8]; int m = F.gw; row_load(PF + (size_t)m * D, va, F.lane);
              for (; m < T; m += F.ngw) { const int mn = (m + F.ngw < T) ? m + F.ngw : m; row_load(PF + (size_t)mn * D, vb, F.lane);
                  row_finish(va, true, PAR + PAR_LN1G + l * D, PAR + PAR_LN1B + l * D, nullptr, XB + (size_t)m * D, nullptr, nullptr, nullptr, F.lane, STAT + 2 * (size_t)m);
#pragma unroll
                  for (int j = 0; j < 8; ++j) va[j] = vb[j]; } }
        }
        SEAM(pb + 6);
        if (IN(pb + 7)) {
            LAYER_CTX
            pg8::GemmStd<D, D, D> g{XB, (const bf16_t*)(wl + WL_GU)}; pg8::StaticOrder<T, 2 * FF> S; S.init(F.G, F.bid); pg8::EpiSwiglu E{HFF};
            pg8::gemm_phase(F.lds, g, S, E, F.tid);
        }
        SEAM(pb + 7);
        if (IN(pb + 8)) {
            LAYER_CTX
            pg8::GemmStd<FF, FF, FF> g{HFF, (const bf16_t*)(wl + WL_DN)}; pg8::StaticOrder<T, D> S; S.init(F.G, F.bid); pg8::EpiResid E{PF, STAT, PAR + PAR_LN1G + l * D, PAR + PAR_LN1B + l * D};
            pg8::gemm_phase(F.lds, g, S, E, F.tid);
        }
        SEAM(pb + 8);
        if (IN(pb + 9)) {
            LAYER_CTX
            const bool lastl = (l == DEPTH - 1);
            if (!lastl) load_gate_w(F, WG + (size_t)(l + 1) * 8 * D);
            { f32x4 va[8], vb[8]; int m = F.gw; row_load(PF + (size_t)m * D, va, F.lane);
              for (; m < T; m += F.ngw) { const int mn = (m + F.ngw < T) ? m + F.ngw : m; row_load(PF + (size_t)mn * D, vb, F.lane);
                  row_finish(va, true, PAR + PAR_LN2G + l * D, PAR + PAR_LN2B + l * D, lastl ? args.out + (size_t)m * D : nullptr, lastl ? nullptr : XB + (size_t)m * D,
                             (const LAS float*)F.lds, lastl ? nullptr : PAR + PAR_GBIAS + (l + 1) * 8, lastl ? nullptr : GATES + (size_t)m * 8, F.lane, STAT + 2 * (size_t)m);
#pragma unroll
                  for (int j = 0; j < 8; ++j) va[j] = vb[j]; } }
            __syncthreads();
        }
        if (lyr != DEPTH - 1) GRID_BAR();
    }
#undef IN
#undef SEAM
#undef GRID_BAR
#undef PHASE_CTX
#undef LAYER_CTX
#undef WG
#undef BIN
#undef GATES
#undef STAT
#undef MEMN
#undef KMEM
#undef VMEM
#undef WQK
#undef WQN
#undef BQK
#undef WKT
#undef WVT
#undef PAR
#undef XF
#undef PF
#undef XB
#undef Z
#undef HFF
#undef MRG
#undef HRAW
#undef QF
#undef KF
#undef PFR
#undef VF
#undef GS
#undef DEN
#undef VSTAT
#undef WIG
#undef WF32
#undef C2A
}

extern "C" void kernel_launch(void* const* d_in, const int* in_sizes, int n_in, void* d_out, int out_size, void* d_ws, size_t ws_size, hipStream_t stream) {
    static int grid = 0;
    if (grid == 0) {
        if (n_in != 24 || out_size != T * D || ws_size < WS_END) { fprintf(stderr, "kernel_launch: unexpected shapes (n_in %d, out %d, ws %zu < %zu)\n", n_in, out_size, ws_size, (size_t)WS_END); grid = -1; return; }
        int dev = 0, cus = 0, per_cu = 0;
        if (hipGetDevice(&dev) != hipSuccess || hipDeviceGetAttribute(&cus, hipDeviceAttributeMultiprocessorCount, dev) != hipSuccess) { grid = -1; return; }
        if (hipFuncSetAttribute((const void*)fwd_kernel, hipFuncAttributeMaxDynamicSharedMemorySize, LDS_BYTES) != hipSuccess) { fprintf(stderr, "kernel_launch: hipFuncSetAttribute failed\n"); grid = -1; return; }
        if (hipOccupancyMaxActiveBlocksPerMultiprocessor(&per_cu, (const void*)fwd_kernel, 512, LDS_BYTES) != hipSuccess || per_cu < 1) fprintf(stderr, "kernel_launch: occupancy query says %d\n", per_cu);
        (void)hipGetLastError();
        grid = cus;
    }
    if (grid < 0) return;
    (void)hipMemsetAsync((char*)d_ws + WS_CTL, 0, CTL_ZERO_BYTES, stream);
    Args a{};
    for (int i = 0; i < 24; ++i) a.in[i] = (const float*)d_in[i];
    a.out = (float*)d_out; a.ws = (unsigned char*)d_ws;
    constexpr int NPH = 2 + 10 * DEPTH;
#if MK_PER_PHASE
    for (int p = 0; p < NPH; ++p) { a.ph_lo = p; a.ph_hi = p + 1; hipLaunchKernelGGL(fwd_kernel, dim3(grid), dim3(512), LDS_BYTES, stream, a); }
#else
    a.ph_lo = 0; a.ph_hi = NPH;
    hipLaunchKernelGGL(fwd_kernel, dim3(grid), dim3(512), LDS_BYTES, stream, a);
#endif
    const hipError_t le = hipPeekAtLastError();
    if (le != hipSuccess) fprintf(stderr, "kernel_launch: launch failed: %s\n", hipGetErrorName(le));
}
```

```cpp
#include <hip/hip_runtime.h>
#include <cstdio>
#include <cstdint>

#ifndef MK_PER_PHASE
#define MK_PER_PHASE 0
#endif

#define LAS __attribute__((address_space(3)))
#define GAS __attribute__((address_space(1)))
typedef unsigned short bf16_t;
typedef short bf16x8 __attribute__((ext_vector_type(8)));
typedef float f32x4 __attribute__((ext_vector_type(4)));
typedef float f32x2 __attribute__((ext_vector_type(2)));
typedef unsigned u32x4 __attribute__((ext_vector_type(4)));
typedef unsigned u32x2 __attribute__((ext_vector_type(2)));

constexpr int T = 16384, D = 2048, SEQ = 4096, NBATCH = 4, DEPTH = 4, MEMLEN = 256;
constexpr int INW = 15368, ZW = 15360, FF = 5632;
constexpr int ZU = 0, ZV = 1024, ZQK = 2048, ZVM = 4096, ZO = 6144, ZQX = 8192, ZG = 9216;
constexpr int SRC_GATE = 8192;
constexpr float LN_EPS = 1e-5f;
constexpr float ALPHA = 1.681792830507429f;

constexpr size_t MiB = 1u << 20;
constexpr size_t WS_CTL = 0, CTL_ZERO_BYTES = 1 * MiB;
constexpr size_t WS_WG = 1 * MiB;
constexpr size_t WS_BIN = 2 * MiB;
constexpr size_t WS_GATES = 3 * MiB;
constexpr size_t WS_STAT = 3 * MiB + 512 * 1024;
constexpr size_t WS_MEMN = 4 * MiB;
constexpr size_t WS_KMEM = 8 * MiB;
constexpr size_t WS_VMEM = 16 * MiB;
constexpr size_t WS_PAR = 24 * MiB;
constexpr int PAR_GWS = 0, PAR_GLNG = 524288, PAR_GLNB = 528384, PAR_GBS = 532480, PAR_CONVW = 536576, PAR_CONVB = 569344, PAR_MNG = 577536,
              PAR_LN1G = 585728, PAR_LN1B = 593920, PAR_LN2G = 602112, PAR_LN2B = 610304, PAR_GBIAS = 618496, PAR_ONE = 618528, PAR_ZERO = 620576, PAR_BQ = 622624, PAR_END = 626720;
constexpr size_t WS_WF32 = 28 * MiB;
constexpr size_t WS_C2 = 30 * MiB;
constexpr size_t WS_WKT = 32 * MiB;
constexpr size_t WS_WVT = 48 * MiB;
constexpr size_t WS_WL = 64 * MiB;
constexpr size_t WL_STRIDE = 150 * MiB;
constexpr size_t WL_IN = 0, WL_GU = 60 * MiB, WL_DN = 104 * MiB, WL_PA = 126 * MiB, WL_PB = 130 * MiB, WL_PC = 138 * MiB, WL_OUT = 142 * MiB;
constexpr size_t WS_XF = 664 * MiB;
constexpr size_t WS_PF = 792 * MiB;
constexpr size_t WS_XB = 920 * MiB;
constexpr size_t WS_Z = 984 * MiB;
constexpr size_t WS_MRG = 1464 * MiB;
constexpr size_t WS_WQK = 1528 * MiB;
constexpr size_t WS_VW01 = 1592 * MiB;
constexpr size_t WS_VW23 = 32 * MiB;
constexpr size_t WS_WQN = 984 * MiB;
constexpr size_t WS_BQK = 3 * MiB + 768 * 1024;
constexpr size_t WS_HRAW = 1624 * MiB;
constexpr size_t WS_QF = 1752 * MiB;
constexpr size_t WS_KF = 1784 * MiB;
constexpr size_t WS_PFR = 1816 * MiB;
constexpr size_t WS_VF = 1824 * MiB;
constexpr size_t WS_GS = 1888 * MiB;
constexpr int GS_BCUM = 0, GS_BV = 65536, GS_PMAX = 131072, GS_BLAST = 196608, GS_MAXB = 197632, GS_MPREV = 198656;
constexpr size_t WS_VSTAT = 1889 * MiB;
constexpr size_t WS_DEN = 1890 * MiB;
constexpr size_t WS_WIG = 1893 * MiB;
constexpr size_t WS_DUMMY = 1891 * MiB;
constexpr size_t WS_END = 1894 * MiB;
static_assert(WL_OUT + 8 * MiB == WL_STRIDE && WS_WL + 4 * WL_STRIDE == WS_XF, "weights map");

constexpr int CW_BAR = 4096;

constexpr int LDS_BYTES = 163840;
constexpr int RING_BYTES = 131072;
constexpr int MISC_OFF = LDS_BYTES - 256;

__device__ __forceinline__ unsigned f2bf(float f) { unsigned u = __builtin_bit_cast(unsigned, f); return (u + 0x7fffu + ((u >> 16) & 1u)) >> 16; }
__device__ __forceinline__ unsigned pk2(float lo, float hi) { return f2bf(lo) | (f2bf(hi) << 16); }
__device__ __forceinline__ float bf2f(unsigned b) { return __builtin_bit_cast(float, b << 16); }
__device__ __forceinline__ float bflo(unsigned w) { return __builtin_bit_cast(float, w << 16); }
__device__ __forceinline__ float bfhi(unsigned w) { return __builtin_bit_cast(float, w & 0xffff0000u); }
typedef __bf16 bf16x2_t __attribute__((ext_vector_type(2)));
__device__ __forceinline__ unsigned cvt_pk_bf16(float lo, float hi) { const f32x2 v = {lo, hi}; const bf16x2_t b = __builtin_convertvector(v, bf16x2_t); return __builtin_bit_cast(unsigned, b); }
__device__ __forceinline__ float fast_sigmoid(float x) { return __builtin_amdgcn_rcpf(1.0f + __builtin_amdgcn_exp2f(-1.4426950408889634f * x)); }
__device__ __forceinline__ float gelu_tanh(float v) { const float y = 1.5957691216057308f * (v + 0.044715f * v * v * v); return v * fast_sigmoid(y); }
__device__ __forceinline__ float shx(float v, int o, int lane) { return __builtin_bit_cast(float, __builtin_amdgcn_ds_bpermute((lane ^ o) << 2, __builtin_bit_cast(int, v))); }
__device__ __forceinline__ float shup(float v, int o, int lane) { return __builtin_bit_cast(float, __builtin_amdgcn_ds_bpermute((lane - o) << 2, __builtin_bit_cast(int, v))); }
__device__ __forceinline__ float rdlane(float v, int l) { return __builtin_bit_cast(float, __builtin_amdgcn_readlane(__builtin_bit_cast(int, v), l)); }
__device__ __forceinline__ f32x4 scale4(f32x4 v, float s) { asm volatile("v_mul_f32 %0, %0, %4\n\tv_mul_f32 %1, %1, %4\n\tv_mul_f32 %2, %2, %4\n\tv_mul_f32 %3, %3, %4" : "+v"(v[0]), "+v"(v[1]), "+v"(v[2]), "+v"(v[3]) : "v"(s)); return v; }
__device__ __forceinline__ bf16x8 pack8(f32x4 a, f32x4 b) { u32x4 o; o.x = cvt_pk_bf16(a[0], a[1]); o.y = cvt_pk_bf16(a[2], a[3]); o.z = cvt_pk_bf16(b[0], b[1]); o.w = cvt_pk_bf16(b[2], b[3]); return __builtin_bit_cast(bf16x8, o); }
__device__ __forceinline__ f32x4 mfma16(bf16x8 a, bf16x8 b, f32x4 c) { return __builtin_amdgcn_mfma_f32_16x16x32_bf16(a, b, c, 0, 0, 0); }
template <int CTRL> __device__ __forceinline__ float dpp_f(float v) { return __builtin_bit_cast(float, __builtin_amdgcn_update_dpp(0, __builtin_bit_cast(int, v), CTRL, 0xf, 0xf, true)); }
__device__ __forceinline__ float wave_sum(float v, int lane) {
    v += dpp_f<0xB1>(v); v += dpp_f<0x4E>(v); v += dpp_f<0x141>(v); v += dpp_f<0x140>(v);
    v += shx(v, 16, lane); v += shx(v, 32, lane);
    return v;
}
__device__ __forceinline__ float wave_max(float v, int lane) {
    v = fmaxf(v, dpp_f<0xB1>(v)); v = fmaxf(v, dpp_f<0x4E>(v)); v = fmaxf(v, dpp_f<0x141>(v)); v = fmaxf(v, dpp_f<0x140>(v));
    v = fmaxf(v, shx(v, 16, lane)); v = fmaxf(v, shx(v, 32, lane));
    return v;
}
#define LDS_WAIT() asm volatile("s_waitcnt lgkmcnt(0)" ::: "memory")
#define VM_WAIT() asm volatile("s_waitcnt vmcnt(0)" ::: "memory")

#define XB_TMO      128
#define XB_XCNT(j)  (256  + 64 * (j))
#define XB_XSUB(j)  (1280 + 64 * (j))
#define XB_XGEN(j)  (2304 + 64 * (j))
#define XB_TOP      3328
#define XB_TOPGEN   3392
#define XCD_BAR_WORDS 3456
#define XB_SPIN_CAP (1u << 22)
__device__ __forceinline__ unsigned xb_ld(unsigned* p)              { return __hip_atomic_load(p, __ATOMIC_RELAXED, __HIP_MEMORY_SCOPE_AGENT); }
__device__ __forceinline__ unsigned xb_add(unsigned* p, unsigned v) { return __hip_atomic_fetch_add(p, v, __ATOMIC_RELAXED, __HIP_MEMORY_SCOPE_AGENT); }
__device__ __forceinline__ unsigned xb_xcc_id() { return (unsigned)__builtin_amdgcn_s_getreg((3 << 11) | 20) & 0xFu; }
#define XB_SPIN(cond, bar) do { unsigned _sp = 0; while (cond) { __builtin_amdgcn_s_sleep(1); \
    if ((++_sp & 255u) == 0u) { if (xb_ld(&(bar)[XB_TMO])) break; if (_sp > XB_SPIN_CAP) { atomicAdd(&(bar)[XB_TMO], 1u); break; } } } } while (0)
__device__ __forceinline__ int fresh_tid(const int wv) { int l_; asm volatile("v_mbcnt_lo_u32_b32 %0, -1, 0\n\tv_mbcnt_hi_u32_b32 %0, -1, %0" : "=v"(l_)); return wv * 64 + l_; }
struct XcdBarrier { unsigned* bar; unsigned x; volatile LAS unsigned* st; };
__device__ __forceinline__ XcdBarrier xcd_barrier_post(unsigned* bar, volatile LAS unsigned* st) {
    XcdBarrier b; b.bar = bar; b.x = xb_xcc_id(); b.st = st;
    if (threadIdx.x == 0) (void)xb_add(&bar[XB_XCNT(b.x)], 1u);
    return b;
}
__device__ __forceinline__ void xcd_barrier_complete(unsigned* bar, unsigned x, unsigned& nloc, unsigned& nx) {
    const unsigned G = gridDim.x * gridDim.y * gridDim.z;
    unsigned sum, cnt, mine, sp = 0u;
    for (;;) {
        sum = 0u; cnt = 0u; mine = 0u;
#pragma unroll
        for (unsigned j = 0; j < 16; ++j) { const unsigned c = xb_ld(&bar[XB_XCNT(j)]); sum += c; cnt += (c > 0u) ? 1u : 0u; mine = (j == x) ? c : mine; }
        if (sum == G) break;
        __builtin_amdgcn_s_sleep(1);
        if ((++sp & 255u) == 0u) { if (xb_ld(&bar[XB_TMO])) break; if (sp > XB_SPIN_CAP) { atomicAdd(&bar[XB_TMO], 1u); break; } }
    }
    nloc = mine > 0u ? mine : 1u; nx = cnt > 0u ? cnt : 1u;
}
__device__ __forceinline__ void xcd_barrier(const XcdBarrier& b, const int tid_) {
    asm volatile("s_waitcnt vmcnt(0)" ::: "memory");
    __syncthreads();
    if (tid_ == 0) {
        unsigned* bar = b.bar;
        __builtin_amdgcn_s_waitcnt(0);
        unsigned nloc = b.st[0], nx = b.st[1];
        if (nloc == 0u) { xcd_barrier_complete(bar, b.x, nloc, nx); b.st[0] = nloc; b.st[1] = nx; }
        const unsigned old = xb_add(&bar[XB_XSUB(b.x)], 1u);
        const unsigned gen = old / nloc;
        if (old + 1u == (gen + 1u) * nloc) {
            __builtin_amdgcn_fence(__ATOMIC_RELEASE, "agent");
            asm volatile("s_waitcnt vmcnt(0)" ::: "memory");
            const unsigned og = xb_add(&bar[XB_TOP], 1u);
            const unsigned tg = og / nx;
            if (og + 1u == (tg + 1u) * nx) xb_add(&bar[XB_TOPGEN], 1u);
            else XB_SPIN(xb_ld(&bar[XB_TOPGEN]) == tg, bar);
            __builtin_amdgcn_fence(__ATOMIC_ACQUIRE, "agent");
            xb_add(&bar[XB_XGEN(b.x)], 1u);
            asm volatile("s_waitcnt vmcnt(0)" ::: "memory");
        } else {
            XB_SPIN(xb_ld(&bar[XB_XGEN(b.x)]) == gen, bar);
            __builtin_amdgcn_fence(__ATOMIC_ACQUIRE, "agent");
            asm volatile("s_waitcnt vmcnt(0)" ::: "memory");
        }
    }
    __syncthreads();
}

namespace pg8 {
constexpr int BM = 256, BK = 64, HALF = 128, HTB = HALF * BK * 2, STAGE_BYTES = 8 * HTB, NXCD = 8, WGM = 4;
__host__ __device__ __forceinline__ int lds_byte(int r, int c) { const int st = (r >> 4) * 2 + (c >> 5), rr = r & 15, cc = c & 31, ob = rr * 64 + cc * 2; return st * 1024 + (ob ^ (((ob >> 9) & 1) << 5)); }
__host__ __device__ __forceinline__ void stage_rc(int b, int& R, int& C) { const int st = b / 1024, sb = b % 1024, swz = sb ^ (((sb >> 9) & 1) << 5); R = (st >> 1) * 16 + swz / 64; C = (st & 1) * 32 + (swz % 64) / 2; }
__host__ __device__ __forceinline__ int perm32(int rho) { const int n = rho >> 4, i = rho & 15; return 8 * (i >> 2) + 4 * n + (i & 3); }
struct Unit { int pm, pn; };
template <int LDA_, int LDB_, int K_, long A_PM, long A_PN, long B_PB, long B_PN> struct GemmT { const bf16_t* A; const bf16_t* Bt;
    static constexpr int lda = LDA_, ldb = LDB_, K = K_;
    __device__ __forceinline__ const char* a_ptr(const Unit& u) const { return (const char*)(A + (size_t)((long)u.pm * A_PM + (long)u.pn * A_PN)); }
    __device__ __forceinline__ const char* b_ptr(const Unit& u) const { return (const char*)(Bt + (size_t)((long)(u.pm >> 4) * B_PB + (long)u.pn * B_PN)); } };
template <int LDA_, int LDB_, int K_> using GemmStd = GemmT<LDA_, LDB_, K_, 256L * LDA_, 0L, 0L, 256L * LDB_>;
template <int M_, int N_> struct StaticOrder {
    static constexpr int nM = M_ / BM, nN = N_ / BM, nwg = nM * nN;
    int G, c;
    __device__ __forceinline__ void init(int G_, int c_) { G = G_; c = c_; }
    __device__ __forceinline__ bool next(int i, Unit& u) const {
        const int L = i * G + c; if (L >= nwg) return false;
        int wgid = L; { constexpr int q = nwg / NXCD, r = nwg % NXCD; const int xcd = wgid % NXCD, off = wgid / NXCD; wgid = (xcd < r ? xcd * (q + 1) : r * (q + 1) + (xcd - r) * q) + off; }
        constexpr int nig = WGM * nN; const int gid = wgid / nig, fm = gid * WGM, gsz = (nM - fm) < WGM ? (nM - fm) : WGM;
        u.pm = fm + ((wgid % nig) % gsz); u.pn = (wgid % nig) / gsz; return true;
    }
};
template <class Epi, class GemmD, class Sched>
__device__ __forceinline__ void gemm_phase(LAS unsigned char* lds, const GemmD g, const Sched& S, const Epi& E, int tid) {
    asm volatile("" : "+v"(tid));
    const int wid = __builtin_amdgcn_readfirstlane(tid >> 6), lane = tid & 63, wr = wid >> 2, wc = wid & 3, fr = lane & 15, fq = lane >> 4;
    constexpr int K = GemmD::K, nt = K / BK;
    unsigned voffA[2], voffB[2];
#pragma unroll
    for (int i = 0; i < 2; ++i) { int R, C; stage_rc(tid * 16 + i * 8192, R, C); const int Rb = (R & ~31) + perm32(R & 31);
        voffA[i] = (unsigned)(R * GemmD::lda + C) * 2u; voffB[i] = (unsigned)(Rb * GemmD::ldb + C) * 2u; }
    constexpr size_t kstep = (size_t)(BK * 2);
    constexpr size_t hA = (size_t)HALF * GemmD::lda * 2, hB = (size_t)HALF * GemmD::ldb * 2;
    const unsigned ldsw = (unsigned)wid * 1024u;
    const int aoff = lds_byte(wr * 64 + fr, fq * 8), boff = lds_byte(wc * 32 + fr, fq * 8);
#define PG8_SA(b, h) (((b) * 2 + (h)) * HTB)
#define PG8_SB(b, h) ((4 + (b) * 2 + (h)) * HTB)
#define PG8_STAGE(bufoff, gbase, voff) do { _Pragma("unroll") for (int _i = 0; _i < 2; ++_i) \
        __builtin_amdgcn_global_load_lds((const unsigned*)((const char*)(gbase) + (voff)[_i]), (LAS unsigned*)(lds + (bufoff) + ldsw + _i * 8192), 16, 0, 0); } while (0)
#define PG8_LDA(dst, b, h) do { _Pragma("unroll") for (int m = 0; m < 4; ++m) _Pragma("unroll") for (int k = 0; k < 2; ++k) dst[m][k] = *(const LAS bf16x8*)(lds + PG8_SA(b, h) + aoff + m * 2048 + k * 1024); } while (0)
#define PG8_LDB(dst, b, h) do { _Pragma("unroll") for (int n = 0; n < 2; ++n) _Pragma("unroll") for (int k = 0; k < 2; ++k) dst[n][k] = *(const LAS bf16x8*)(lds + PG8_SB(b, h) + boff + n * 2048 + k * 1024); } while (0)
#define PG8_MMA(ai, bj, At, Bt) do { __builtin_amdgcn_s_setprio(1); _Pragma("unroll") for (int m = 0; m < 4; ++m) _Pragma("unroll") for (int n = 0; n < 2; ++n) _Pragma("unroll") for (int k = 0; k < 2; ++k) \
        acc[ai][bj][m][n] = __builtin_amdgcn_mfma_f32_16x16x32_bf16(Bt[n][k], At[m][k], acc[ai][bj][m][n], 0, 0, 0); __builtin_amdgcn_s_setprio(0); } while (0)
#define PG8_WAIT_V(n) asm volatile("s_waitcnt vmcnt(" #n ")" ::: "memory")
#define PG8_WAIT_L(n) asm volatile("s_waitcnt lgkmcnt(" #n ")" ::: "memory")
#define PG8_BAR __builtin_amdgcn_s_barrier()
#define PG8_SCHED __builtin_amdgcn_sched_barrier(0)
    Unit cur, nxt; int ui = 0;
    if (!S.next(0, cur)) return;
    f32x4 acc[2][2][4][2];
#pragma unroll
    for (int a = 0; a < 2; ++a)
#pragma unroll
        for (int b = 0; b < 2; ++b)
#pragma unroll
            for (int m = 0; m < 4; ++m)
#pragma unroll
                for (int n = 0; n < 2; ++n) acc[a][b][m][n] = (f32x4){0.f, 0.f, 0.f, 0.f};
    bf16x8 At[4][2], B0[2][2], B1[2][2];
    const char* cA = g.a_ptr(cur); const char* cB = g.b_ptr(cur);
    PG8_STAGE(PG8_SB(0, 0), cB, voffB); PG8_STAGE(PG8_SB(0, 1), cB + hB, voffB); PG8_STAGE(PG8_SA(0, 0), cA, voffA); PG8_STAGE(PG8_SA(0, 1), cA + hA, voffA);
    if (wr == 1) PG8_BAR;
    PG8_WAIT_V(2); PG8_BAR;
    PG8_STAGE(PG8_SB(1, 0), cB + kstep, voffB); PG8_STAGE(PG8_SA(1, 0), cA + kstep, voffA); PG8_STAGE(PG8_SB(1, 1), cB + hB + kstep, voffB);
    PG8_WAIT_V(6); PG8_BAR;
    for (;;) {
        const bool has_next = S.next(ui + 1, nxt);
        const char* nA = has_next ? g.a_ptr(nxt) : cA; const char* nB = has_next ? g.b_ptr(nxt) : cB;
#pragma nounroll
        for (int t = 0; t < nt; t += 2) {
            const bool last = (t == nt - 2);
            const char* a1 = cA + (size_t)(t + 1) * kstep;
            const char* a2 = last ? nA : cA + (size_t)(t + 2) * kstep; const char* b2 = last ? nB : cB + (size_t)(t + 2) * kstep;
            const char* a3 = a2 + kstep; const char* b3 = b2 + kstep;
            PG8_LDB(B0, 0, 0); PG8_LDB(B1, 0, 1); PG8_SCHED; PG8_LDA(At, 0, 0); PG8_STAGE(PG8_SA(1, 1), a1 + hA, voffA);
            PG8_WAIT_V(8); PG8_WAIT_L(0); PG8_BAR; PG8_MMA(0, 0, At, B0); PG8_MMA(0, 1, At, B1); PG8_BAR; PG8_SCHED;
            PG8_LDA(At, 0, 1); PG8_STAGE(PG8_SB(0, 0), b2, voffB); PG8_STAGE(PG8_SB(0, 1), b2 + hB, voffB); PG8_STAGE(PG8_SA(0, 0), a2, voffA);
            PG8_WAIT_V(8); PG8_WAIT_L(0); PG8_BAR; PG8_MMA(1, 0, At, B0); PG8_MMA(1, 1, At, B1); PG8_BAR; PG8_SCHED;
            PG8_LDB(B0, 1, 0); PG8_LDB(B1, 1, 1); PG8_SCHED; PG8_LDA(At, 1, 0); PG8_STAGE(PG8_SA(0, 1), a2 + hA, voffA);
            PG8_WAIT_V(8); PG8_WAIT_L(0); PG8_BAR; PG8_MMA(0, 0, At, B0); PG8_MMA(0, 1, At, B1); PG8_BAR; PG8_SCHED;
            PG8_LDA(At, 1, 1); PG8_STAGE(PG8_SB(1, 0), b3, voffB); PG8_STAGE(PG8_SB(1, 1), b3 + hB, voffB); PG8_STAGE(PG8_SA(1, 0), a3, voffA);
            PG8_WAIT_V(8); PG8_WAIT_L(0); PG8_BAR; PG8_MMA(1, 0, At, B0); PG8_MMA(1, 1, At, B1); PG8_BAR; PG8_SCHED;
        }
        if (wr == 0) PG8_BAR;
        E(acc, cur, wr, wc, fr, fq);
        if (!has_next) break;
#pragma unroll
        for (int a = 0; a < 2; ++a)
#pragma unroll
            for (int b = 0; b < 2; ++b)
#pragma unroll
                for (int m = 0; m < 4; ++m)
#pragma unroll
                    for (int n = 0; n < 2; ++n) acc[a][b][m][n] = (f32x4){0.f, 0.f, 0.f, 0.f};
        cur = nxt; cA = nA; cB = nB; ++ui;
        if (wr == 1) PG8_BAR;
    }
    PG8_WAIT_V(0);
    PG8_BAR;
#undef PG8_SA
#undef PG8_SB
#undef PG8_STAGE
#undef PG8_LDA
#undef PG8_LDB
#undef PG8_MMA
#undef PG8_WAIT_V
#undef PG8_WAIT_L
#undef PG8_BAR
#undef PG8_SCHED
}

typedef f32x4 Acc[2][2][4][2];
struct EpiIn { bf16_t* Z; const float* bias; const float* bqk; LAS float* red;
    __device__ __forceinline__ void operator()(Acc& acc, const Unit& u, int wr, int wc, int fr, int fq) const {
        const int pn = u.pn; const int act = (pn < 8) ? 1 : (pn < 24) ? 0 : (pn < 32) ? 2 : (pn < 36) ? 3 : 2;
        const int row0 = u.pm * BM + wr * 64 + fr, col0 = pn * BM + wc * 32 + 8 * fq;
        if (act == 3) {
            const int lane = fq * 16 + fr; const float* bp = bqk + (u.pm >> 4) * 1024 + (pn - 32) * BM + wc * 32 + 8 * fq;
            LAS float* RM = red; LAS float* RS = red + 1024;
#pragma unroll
            for (int bj = 0; bj < 2; ++bj) { const f32x4 b0 = *(const f32x4*)(bp + bj * HALF), b1 = *(const f32x4*)(bp + bj * HALF + 4);
#pragma unroll
                for (int ai = 0; ai < 2; ++ai)
#pragma unroll
                    for (int m = 0; m < 4; ++m) { acc[ai][bj][m][0] += b0; acc[ai][bj][m][1] += b1; } }
#pragma unroll
            for (int ai = 0; ai < 2; ++ai)
#pragma unroll
                for (int m = 0; m < 4; ++m) { float mx = -3.0e38f;
#pragma unroll
                    for (int bj = 0; bj < 2; ++bj)
#pragma unroll
                        for (int n = 0; n < 2; ++n) { const f32x4 v = acc[ai][bj][m][n]; mx = fmaxf(mx, fmaxf(fmaxf(v[0], v[1]), fmaxf(v[2], v[3]))); }
                    mx = fmaxf(mx, shx(mx, 16, lane)); mx = fmaxf(mx, shx(mx, 32, lane));
                    if (fq == 0) RM[(ai * HALF + wr * 64 + m * 16 + fr) * 4 + wc] = mx; }
            asm volatile("s_waitcnt lgkmcnt(0)" ::: "memory"); __builtin_amdgcn_s_barrier(); asm volatile("" ::: "memory");
#pragma unroll
            for (int ai = 0; ai < 2; ++ai)
#pragma unroll
                for (int m = 0; m < 4; ++m) { const f32x4 m4 = *(const LAS f32x4*)(RM + (ai * HALF + wr * 64 + m * 16 + fr) * 4); const float mx = fmaxf(fmaxf(m4[0], m4[1]), fmaxf(m4[2], m4[3])); float sm = 0.f;
#pragma unroll
                    for (int bj = 0; bj < 2; ++bj)
#pragma unroll
                        for (int n = 0; n < 2; ++n) { f32x4 v = acc[ai][bj][m][n];
#pragma unroll
                            for (int j = 0; j < 4; ++j) { v[j] = __builtin_amdgcn_exp2f(v[j] - mx); sm += v[j]; }
                            acc[ai][bj][m][n] = v; }
                    sm += shx(sm, 16, lane); sm += shx(sm, 32, lane);
                    if (fq == 0) RS[(ai * HALF + wr * 64 + m * 16 + fr) * 4 + wc] = sm; }
            asm volatile("s_waitcnt lgkmcnt(0)" ::: "memory"); __builtin_amdgcn_s_barrier(); asm volatile("" ::: "memory");
#pragma unroll
            for (int ai = 0; ai < 2; ++ai)
#pragma unroll
                for (int m = 0; m < 4; ++m) { const f32x4 s4 = *(const LAS f32x4*)(RS + (ai * HALF + wr * 64 + m * 16 + fr) * 4); const float inv = 1.f / ((s4[0] + s4[1]) + (s4[2] + s4[3]));
                    bf16_t* rowp = Z + (size_t)(row0 + ai * HALF + m * 16) * ZW + col0;
#pragma unroll
                    for (int bj = 0; bj < 2; ++bj) { const f32x4 v0 = acc[ai][bj][m][0] * inv, v1 = acc[ai][bj][m][1] * inv;
                        u32x4 w; w.x = cvt_pk_bf16(v0[0], v0[1]); w.y = cvt_pk_bf16(v0[2], v0[3]); w.z = cvt_pk_bf16(v1[0], v1[1]); w.w = cvt_pk_bf16(v1[2], v1[3]);
                        *(u32x4*)(rowp + bj * HALF) = w; } }
            return;
        }
#pragma unroll
        for (int bj = 0; bj < 2; ++bj) {
            const f32x4 b0 = *(const f32x4*)(bias + col0 + bj * HALF), b1 = *(const f32x4*)(bias + col0 + bj * HALF + 4);
#pragma unroll
            for (int ai = 0; ai < 2; ++ai)
#pragma unroll
                for (int m = 0; m < 4; ++m) { bf16_t* rowp = Z + (size_t)(row0 + ai * HALF + m * 16) * ZW + col0 + bj * HALF;
                    f32x4 v0 = acc[ai][bj][m][0] + b0, v1 = acc[ai][bj][m][1] + b1;
                    if (act == 1) {
#pragma unroll
                        for (int j = 0; j < 4; ++j) { v0[j] = gelu_tanh(v0[j]); v1[j] = gelu_tanh(v1[j]); } }
                    else if (act == 2) {
#pragma unroll
                        for (int j = 0; j < 4; ++j) { v0[j] = fast_sigmoid(v0[j]); v1[j] = fast_sigmoid(v1[j]); } }
                    u32x4 w; w.x = cvt_pk_bf16(v0[0], v0[1]); w.y = cvt_pk_bf16(v0[2], v0[3]); w.z = cvt_pk_bf16(v1[0], v1[1]); w.w = cvt_pk_bf16(v1[2], v1[3]);
                    *(u32x4*)rowp = w; }
        }
    }
};
__device__ __forceinline__ void store_tile_bf16(const Acc& acc, bf16_t* base, int ldc, float sc, int wr, int wc, int fr, int fq) {
#pragma unroll
    for (int ai = 0; ai < 2; ++ai)
#pragma unroll
        for (int m = 0; m < 4; ++m) { bf16_t* rowp = base + (size_t)(wr * 64 + fr + ai * HALF + m * 16) * ldc + wc * 32 + 8 * fq;
#pragma unroll
            for (int bj = 0; bj < 2; ++bj) { const f32x4 v0 = acc[ai][bj][m][0] * sc, v1 = acc[ai][bj][m][1] * sc;
                u32x4 w; w.x = cvt_pk_bf16(v0[0], v0[1]); w.y = cvt_pk_bf16(v0[2], v0[3]); w.z = cvt_pk_bf16(v1[0], v1[1]); w.w = cvt_pk_bf16(v1[2], v1[3]);
                *(u32x4*)(rowp + bj * HALF) = w; } }
}
constexpr float SCORE_SCALE = 0.0625f * 1.4426950408889634f;
struct GemmQK { const bf16_t* Km; const bf16_t* Wqn; static constexpr int lda = 4096, ldb = 1024, K = 256;
    __device__ __forceinline__ const char* a_ptr(const Unit& u) const { return (const char*)(Km + (size_t)(u.pm & 3) * 256 * 4096 + (size_t)(u.pm >> 2) * 256); }
    __device__ __forceinline__ const char* b_ptr(const Unit& u) const { return (const char*)(Wqn + (size_t)(u.pm >> 4) * 2048 * 1024 + (size_t)((u.pm >> 2) & 3) * 256 + (size_t)u.pn * 256 * 1024); } };
struct EpiQK { bf16_t* O;
    __device__ __forceinline__ void operator()(const Acc& acc, const Unit& u, int wr, int wc, int fr, int fq) const {
        store_tile_bf16(acc, O + ((size_t)((u.pm >> 4) * 4 + (u.pm & 3)) * 1024 + (size_t)((u.pm >> 2) & 3) * 256) * 2048 + (size_t)u.pn * 256, 2048, SCORE_SCALE, wr, wc, fr, fq); } };
struct GemmVW { const unsigned char* wl0; const bf16_t* Vm; static constexpr int lda = 1024, ldb = 4096, K = 256;
    __device__ __forceinline__ const char* a_ptr(const Unit& u) const { const int lbh = u.pm >> 3; return (const char*)((const bf16_t*)(wl0 + (size_t)(lbh >> 4) * WL_STRIDE + WL_PC) + (size_t)(u.pm & 7) * 256 * 1024 + (size_t)(lbh & 3) * 256); }
    __device__ __forceinline__ const char* b_ptr(const Unit& u) const { const int lbh = u.pm >> 3; return (const char*)(Vm + (size_t)((lbh >> 2) & 3) * 256 * 4096 + (size_t)(lbh >> 4) * 1024 + (size_t)(lbh & 3) * 256); } };
struct EpiVW { unsigned char* wsb;
    __device__ __forceinline__ void operator()(const Acc& acc, const Unit& u, int wr, int wc, int fr, int fq) const {
        const int lbh = u.pm >> 3, l = lbh >> 4, b = (lbh >> 2) & 3, h = lbh & 3;
        bf16_t* vw = (bf16_t*)(wsb + (l < 2 ? WS_VW01 + (size_t)l * 16 * MiB : WS_VW23 + (size_t)(l - 2) * 16 * MiB));
        store_tile_bf16(acc, vw + ((size_t)b * 2048 + (size_t)(u.pm & 7) * 256) * 1024 + h * 256, 1024, 1.0f, wr, wc, fr, fq); } };
struct GemmIn { const bf16_t* A; const bf16_t* W; const bf16_t* Wqk; static constexpr int lda = D, ldb = D, K = D;
    __device__ __forceinline__ const char* a_ptr(const Unit& u) const { return (const char*)(A + (size_t)u.pm * 256 * D); }
    __device__ __forceinline__ const char* b_ptr(const Unit& u) const { return (u.pn >= 32 && u.pn < 36) ? (const char*)(Wqk + ((size_t)(u.pm >> 4) * 1024 + (size_t)(u.pn - 32) * 256) * D) : (const char*)(W + (size_t)u.pn * 256 * D); } };
struct EpiF32 { float* C; int ldc;
    __device__ __forceinline__ void operator()(const Acc& acc, const Unit& u, int wr, int wc, int fr, int fq) const {
        const int row0 = u.pm * BM + wr * 64 + fr, col0 = u.pn * BM + wc * 32 + 8 * fq;
#pragma unroll
        for (int ai = 0; ai < 2; ++ai)
#pragma unroll
            for (int m = 0; m < 4; ++m) { float* rowp = C + (size_t)(row0 + ai * HALF + m * 16) * ldc + col0;
#pragma unroll
                for (int bj = 0; bj < 2; ++bj)
#pragma unroll
                    for (int n = 0; n < 2; ++n) *(f32x4*)(rowp + bj * HALF + 4 * n) = acc[ai][bj][m][n]; }
    }
};
struct EpiBf16 { bf16_t* O; int ldc;
    __device__ __forceinline__ void operator()(const Acc& acc, const Unit& u, int wr, int wc, int fr, int fq) const {
        const int row0 = u.pm * BM + wr * 64 + fr, col0 = u.pn * BM + wc * 32 + 8 * fq;
#pragma unroll
        for (int ai = 0; ai < 2; ++ai)
#pragma unroll
            for (int m = 0; m < 4; ++m) { bf16_t* rowp = O + (size_t)(row0 + ai * HALF + m * 16) * ldc + col0;
#pragma unroll
                for (int bj = 0; bj < 2; ++bj) { const f32x4 v0 = acc[ai][bj][m][0], v1 = acc[ai][bj][m][1];
                    u32x4 w; w.x = cvt_pk_bf16(v0[0], v0[1]); w.y = cvt_pk_bf16(v0[2], v0[3]); w.z = cvt_pk_bf16(v1[0], v1[1]); w.w = cvt_pk_bf16(v1[2], v1[3]);
                    *(u32x4*)(rowp + bj * HALF) = w; } }
    }
};
template <int MODE> struct EpiGate { const bf16_t* Gz; bf16_t* mrg;
    __device__ __forceinline__ void operator()(const Acc& acc, const Unit& u, int wr, int wc, int fr, int fq) const {
        const int row0 = u.pm * BM + wr * 64 + fr, col0 = u.pn * BM + wc * 32 + 8 * fq;
#pragma unroll
        for (int ai = 0; ai < 2; ++ai) {
            u32x4 gw[4][2], pw[4][2];
#pragma unroll
            for (int m = 0; m < 4; ++m) { const size_t r = (size_t)(row0 + ai * HALF + m * 16);
#pragma unroll
                for (int bj = 0; bj < 2; ++bj) { const int c = col0 + bj * HALF; gw[m][bj] = *(const u32x4*)(Gz + r * ZW + c); if (MODE != 0) pw[m][bj] = *(const u32x4*)(mrg + r * D + c); else pw[m][bj] = (u32x4){0u, 0u, 0u, 0u}; } }
            __builtin_amdgcn_sched_barrier(0);
#pragma unroll
            for (int m = 0; m < 4; ++m) { const size_t r = (size_t)(row0 + ai * HALF + m * 16);
#pragma unroll
                for (int bj = 0; bj < 2; ++bj) { const int c = col0 + bj * HALF; const u32x4 g4 = gw[m][bj];
                    f32x4 v0 = acc[ai][bj][m][0], v1 = acc[ai][bj][m][1];
                    v0[0] *= bflo(g4.x); v0[1] *= bfhi(g4.x); v0[2] *= bflo(g4.y); v0[3] *= bfhi(g4.y);
                    v1[0] *= bflo(g4.z); v1[1] *= bfhi(g4.z); v1[2] *= bflo(g4.w); v1[3] *= bfhi(g4.w);
                    if (MODE != 0) { const u32x4 p4 = pw[m][bj];
                        v0[0] += bflo(p4.x); v0[1] += bfhi(p4.x); v0[2] += bflo(p4.y); v0[3] += bfhi(p4.y); v1[0] += bflo(p4.z); v1[1] += bfhi(p4.z); v1[2] += bflo(p4.w); v1[3] += bfhi(p4.w); }
                    u32x4 w; w.x = cvt_pk_bf16(v0[0], v0[1]); w.y = cvt_pk_bf16(v0[2], v0[3]); w.z = cvt_pk_bf16(v1[0], v1[1]); w.w = cvt_pk_bf16(v1[2], v1[3]);
                    *(u32x4*)(mrg + r * D + c) = w; } }
            __builtin_amdgcn_sched_barrier(0);
        }
    }
};
struct EpiResid { float* P; const float* stat; const float* g; const float* b;
    __device__ __forceinline__ void operator()(const Acc& acc, const Unit& u, int wr, int wc, int fr, int fq) const {
        const int row0 = u.pm * BM + wr * 64 + fr, col0 = u.pn * BM + wc * 32 + 8 * fq;
        f32x4 g4[2][2], b4[2][2];
#pragma unroll
        for (int bj = 0; bj < 2; ++bj)
#pragma unroll
            for (int n = 0; n < 2; ++n) { const int c = col0 + bj * HALF + 4 * n; g4[bj][n] = *(const f32x4*)(g + c); b4[bj][n] = *(const f32x4*)(b + c); }
#pragma unroll
        for (int q = 0; q < 4; ++q) {
            const int ai = q >> 1, mb = (q & 1) * 2;
            f32x2 st[2]; f32x4 px[2][2][2];
#pragma unroll
            for (int mm = 0; mm < 2; ++mm) { const int row = row0 + ai * HALF + (mb + mm) * 16; const float* pp = P + (size_t)row * D + col0; st[mm] = *(const f32x2*)(stat + 2 * row);
#pragma unroll
                for (int bj = 0; bj < 2; ++bj)
#pragma unroll
                    for (int n = 0; n < 2; ++n) px[mm][bj][n] = *(const f32x4*)(pp + bj * HALF + 4 * n); }
            __builtin_amdgcn_sched_barrier(0);
#pragma unroll
            for (int mm = 0; mm < 2; ++mm) { const int row = row0 + ai * HALF + (mb + mm) * 16; float* pp = P + (size_t)row * D + col0;
#pragma unroll
                for (int bj = 0; bj < 2; ++bj)
#pragma unroll
                    for (int n = 0; n < 2; ++n) { const f32x4 x = (px[mm][bj][n] - st[mm].x) * st[mm].y * g4[bj][n] + b4[bj][n]; *(f32x4*)(pp + bj * HALF + 4 * n) = x * ALPHA + acc[ai][bj][mb + mm][n]; } }
            __builtin_amdgcn_sched_barrier(0);
        }
    }
};
struct EpiSwiglu { bf16_t* H;
    __device__ __forceinline__ void operator()(const Acc& acc, const Unit& u, int wr, int wc, int fr, int fq) const {
        const int row0 = u.pm * BM + wr * 64 + fr, col0 = u.pn * HALF + wc * 32 + 8 * fq;
#pragma unroll
        for (int ai = 0; ai < 2; ++ai)
#pragma unroll
            for (int m = 0; m < 4; ++m) { bf16_t* rowp = H + (size_t)(row0 + ai * HALF + m * 16) * FF + col0;
                f32x4 h0, h1;
#pragma unroll
                for (int j = 0; j < 4; ++j) { const float g0 = acc[ai][0][m][0][j], g1 = acc[ai][0][m][1][j];
                    h0[j] = g0 * fast_sigmoid(g0) * acc[ai][1][m][0][j]; h1[j] = g1 * fast_sigmoid(g1) * acc[ai][1][m][1][j]; }
                u32x4 w; w.x = cvt_pk_bf16(h0[0], h0[1]); w.y = cvt_pk_bf16(h0[2], h0[3]); w.z = cvt_pk_bf16(h1[0], h1[1]); w.w = cvt_pk_bf16(h1[2], h1[3]);
                *(u32x4*)rowp = w; }
    }
};
}

struct Args { const float* in[24]; float* out; unsigned char* ws; int ph_lo, ph_hi; };

struct Frame { LAS unsigned char* lds; int tid, lane, wave, gw, ngw, G, bid; };

__device__ __forceinline__ void transpose_tile(const float* src, size_t ldw, bf16_t* dst, size_t ldwt, LAS float* scr, int lane) {
    float tv[32];
#pragma unroll
    for (int i = 0; i < 32; ++i) tv[i] = src[(size_t)(2 * i + (lane >> 5)) * ldw + (lane & 31)];
#pragma unroll
    for (int i = 0; i < 32; ++i) scr[(2 * i + (lane >> 5)) * 33 + (lane & 31)] = tv[i];
    LDS_WAIT(); asm volatile("" ::: "memory");
    const int c = lane & 7;
#pragma unroll
    for (int j = 0; j < 4; ++j) { const int n = (lane >> 3) + 8 * j; const LAS float* s = scr + (8 * c) * 33 + n;
        u32x4 o; o.x = pk2(s[0 * 33], s[1 * 33]); o.y = pk2(s[2 * 33], s[3 * 33]); o.z = pk2(s[4 * 33], s[5 * 33]); o.w = pk2(s[6 * 33], s[7 * 33]);
        *(u32x4*)(dst + (size_t)n * ldwt + 8 * c) = o; }
    LDS_WAIT(); asm volatile("" ::: "memory");
}
__device__ __forceinline__ void transpose_item(const float* W, int ldw, int N, bf16_t* WT, int K, int item, LAS float* scr, int lane, int mode) {
    const int nblk = N / 32, kb = item / nblk, nb = item % nblk, k0 = 64 * kb, n0 = 32 * nb;
    int r0 = n0;
    if (mode == 1) { r0 = (n0 < FF) ? 256 * (n0 / 128) + (n0 % 128) : 256 * ((n0 - FF) / 128) + 128 + ((n0 - FF) % 128); }
    transpose_tile(W + (size_t)k0 * ldw + n0, (size_t)ldw, WT + (size_t)r0 * K + k0, (size_t)K, scr, lane);
}

struct TItem { const float* src; size_t ldw; bf16_t* dst; size_t ldwt; };
__device__ __forceinline__ void tt_load(f32x4 (&tv)[8], const TItem& t, int lane) {
#pragma unroll
    for (int i = 0; i < 8; ++i) tv[i] = *(const f32x4*)(t.src + (size_t)((lane >> 3) + 8 * i) * t.ldw + 4 * (lane & 7));
}
__device__ __forceinline__ void tt_store(const f32x4 (&tv)[8], const TItem& t, LAS float* scr, int lane) {
#pragma unroll
    for (int i = 0; i < 8; ++i) { LAS float* p = scr + ((lane >> 3) + 8 * i) * 33 + 4 * (lane & 7); p[0] = tv[i][0]; p[1] = tv[i][1]; p[2] = tv[i][2]; p[3] = tv[i][3]; }
    LDS_WAIT(); asm volatile("" ::: "memory");
    const int c = lane & 7;
#pragma unroll
    for (int j = 0; j < 4; ++j) { const int n = (lane >> 3) + 8 * j; const LAS float* s = scr + (8 * c) * 33 + n;
        u32x4 o; o.x = pk2(s[0 * 33], s[1 * 33]); o.y = pk2(s[2 * 33], s[3 * 33]); o.z = pk2(s[4 * 33], s[5 * 33]); o.w = pk2(s[6 * 33], s[7 * 33]);
        *(u32x4*)(t.dst + (size_t)n * t.ldwt + 8 * c) = o; }
    LDS_WAIT(); asm volatile("" ::: "memory");
}
__device__ __forceinline__ TItem titem(const float* W, int ldw, int nblk, int nb0, bf16_t* WT, int K, int item, int mode) {
    const int kb = item / nblk, nb = nb0 + item % nblk, k0 = 64 * kb, n0 = 32 * nb;
    int r0 = n0;
    if (mode == 1) { r0 = (n0 < FF) ? 256 * (n0 / 128) + (n0 % 128) : 256 * ((n0 - FF) / 128) + 128 + ((n0 - FF) % 128); }
    TItem t; t.src = W + (size_t)k0 * ldw + n0; t.ldw = (size_t)ldw; t.dst = WT + (size_t)r0 * K + k0; t.ldwt = (size_t)K; return t;
}
__device__ __forceinline__ void row_load(const float* src, f32x4 (&v)[8], int lane) {
#pragma unroll
    for (int j = 0; j < 8; ++j) v[j] = *(const f32x4*)(src + 256 * j + 4 * lane);
}
__device__ __forceinline__ void row_finish(f32x4 (&v)[8], bool do_ln, const float* lg, const float* lb, float* xf, bf16_t* xb, const LAS float* wg, const float* gb, float* gates, int lane, float* stat = nullptr) {
    if (do_ln) {
        float s = 0.f;
#pragma unroll
        for (int j = 0; j < 8; ++j) s += (v[j].x + v[j].y) + (v[j].z + v[j].w);
        const float mean = wave_sum(s, lane) * (1.f / D); float s2 = 0.f;
#pragma unroll
        for (int j = 0; j < 8; ++j) { v[j] = v[j] - mean; s2 += (v[j].x * v[j].x + v[j].y * v[j].y) + (v[j].z * v[j].z + v[j].w * v[j].w); }
        const float rstd = 1.f / sqrtf(wave_sum(s2, lane) * (1.f / D) + LN_EPS);
        if (stat && lane == 0) { stat[0] = mean; stat[1] = rstd; }
#pragma unroll
        for (int j = 0; j < 8; ++j) { const f32x4 g4 = *(const f32x4*)(lg + 256 * j + 4 * lane), b4 = *(const f32x4*)(lb + 256 * j + 4 * lane); v[j] = v[j] * rstd * g4 + b4; }
    }
    if (xf) {
#pragma unroll
        for (int j = 0; j < 8; ++j) *(f32x4*)(xf + 256 * j + 4 * lane) = v[j];
    }
    if (xb) {
#pragma unroll
        for (int j = 0; j < 8; ++j) { u32x2 w; w.x = cvt_pk_bf16(v[j].x, v[j].y); w.y = cvt_pk_bf16(v[j].z, v[j].w); *(u32x2*)(xb + 256 * j + 4 * lane) = w; }
    }
    if (gates) {
        asm volatile("" : "+s"(wg));
        float myg = 0.f;
#pragma unroll
        for (int q = 0; q < 8; ++q) { float s = 0.f;
#pragma unroll
            for (int j = 0; j < 8; ++j) { const f32x4 w4 = *(const LAS f32x4*)(wg + q * D + 256 * j + 4 * lane); s += (v[j].x * w4.x + v[j].y * w4.y) + (v[j].z * w4.z + v[j].w * w4.w); }
            s = wave_sum(s, lane); if (lane == q) myg = s + gb[q]; }
        if (lane < 8) gates[lane] = myg;
    }
}
__device__ __forceinline__ void row_pass(const float* src, bool do_ln, const float* lg, const float* lb, float* xf, bf16_t* xb, const LAS float* wg, const float* gb, float* gates, int lane, float* stat = nullptr) {
    f32x4 v[8]; row_load(src, v, lane); row_finish(v, do_ln, lg, lb, xf, xb, wg, gb, gates, lane, stat);
}
__device__ __forceinline__ void load_gate_w(const Frame& F, const float* WGl) {
    LAS float* wg = (LAS float*)F.lds;
    for (int i = F.tid; i < 8 * D / 4; i += 512) *(LAS f32x4*)(wg + 4 * i) = *(const f32x4*)(WGl + 4 * i);
    __syncthreads();
}

__global__ void __launch_bounds__(512, 2) fwd_kernel(Args args) {
    extern __shared__ __attribute__((aligned(16))) unsigned char lds_raw[];
    LAS unsigned char* const lds_base = (LAS unsigned char*)lds_raw;
    unsigned char* const ws = args.ws;
    volatile LAS unsigned* MISC = (volatile LAS unsigned*)(lds_base + MISC_OFF);
    if (threadIdx.x < 64) MISC[threadIdx.x] = 0u;
    const int wv0 = __builtin_amdgcn_readfirstlane((int)threadIdx.x >> 6);
    __syncthreads();
#if MK_PER_PHASE
    XcdBarrier bar; bar.bar = (unsigned*)(ws + WS_CTL) + CW_BAR; bar.x = 0; bar.st = nullptr;
#define GRID_BAR() do { } while (0)
#else
    XcdBarrier bar = xcd_barrier_post((unsigned*)(ws + WS_CTL) + CW_BAR, MISC + 8);
#define GRID_BAR() do { XcdBarrier b_ = bar; asm volatile("" : "+s"(b_.bar), "+s"(b_.x)); xcd_barrier(b_, fresh_tid(wv0)); } while (0)
#endif
#define IN(k) true
#define SEAM(k) GRID_BAR()
#define PHASE_CTX \
    unsigned char* wsb; { GAS unsigned char* g_ = (GAS unsigned char*)ws; asm volatile("" : "+s"(g_)); wsb = (unsigned char*)g_; }     \
    Frame F; { int t_ = fresh_tid(wv0); F.lds = lds_base; F.tid = t_; F.lane = t_ & 63; F.wave = __builtin_amdgcn_readfirstlane(t_ >> 6); \
      int g_ = gridDim.x, b_ = blockIdx.x; asm volatile("" : "+s"(g_), "+s"(b_)); F.G = g_; F.bid = b_; F.gw = b_ * 8 + F.wave; F.ngw = g_ * 8; }
#define WG ((float*)(wsb + WS_WG))
#define BIN ((float*)(wsb + WS_BIN))
#define GATES ((float*)(wsb + WS_GATES))
#define STAT ((float*)(wsb + WS_STAT))
#define MEMN ((bf16_t*)(wsb + WS_MEMN))
#define KMEM ((bf16_t*)(wsb + WS_KMEM))
#define VMEM ((bf16_t*)(wsb + WS_VMEM))
#define WQK ((bf16_t*)(wsb + WS_WQK))
#define WQN ((bf16_t*)(wsb + WS_WQN))
#define BQK ((float*)(wsb + WS_BQK))
#define WKT ((bf16_t*)(wsb + WS_WKT))
#define WVT ((bf16_t*)(wsb + WS_WVT))
#define PAR ((float*)(wsb + WS_PAR))
#define XF ((float*)(wsb + WS_XF))
#define PF ((float*)(wsb + WS_PF))
#define XB ((bf16_t*)(wsb + WS_XB))
#define Z ((bf16_t*)(wsb + WS_Z))
#define HFF ((bf16_t*)(wsb + WS_Z))
#define MRG ((bf16_t*)(wsb + WS_MRG))
#define HRAW ((bf16_t*)(wsb + WS_HRAW))
#define QF ((bf16_t*)(wsb + WS_QF))
#define KF ((bf16_t*)(wsb + WS_KF))
#define PFR ((bf16_t*)(wsb + WS_PFR))
#define VF ((bf16_t*)(wsb + WS_VF))
#define GS ((float*)(wsb + WS_GS))
#define DEN ((float*)(wsb + WS_DEN))
#define VSTAT ((float*)(wsb + WS_VSTAT))
#define WIG ((float*)(wsb + WS_WIG))
#define WF32 ((float*)(wsb + WS_WF32))
#define C2A ((float*)(wsb + WS_C2))

    if (IN(0)) {
        PHASE_CTX
        const float* x_in = args.in[0]; const float* w_in = args.in[4]; const float* b_in = args.in[5];
        LAS float* scr = (LAS float*)(F.lds + F.wave * 16384);
        {
            constexpr int I_IN1 = 32 * 256, I_IN2 = 32 * 192, I_GU = 32 * 352, I_DN = 88 * 64, I_PA = 16 * 64, I_PB = 32 * 64, I_PC = 16 * 64, I_OUT = 32 * 64, I_KV = 32 * 64;
            constexpr int NIT = I_IN1 + I_IN2 + I_GU + I_DN + I_PA + I_PB + I_PC + I_OUT + I_KV, NALL = DEPTH * NIT;
            auto decode = [&](int itx) -> TItem {
                const int l = itx / NIT; int r = itx - l * NIT;
                unsigned char* wl = wsb + WS_WL + (size_t)l * WL_STRIDE; const float* win_l = w_in + (size_t)l * D * INW;
                if (r < I_IN1) return titem(win_l, INW, 256, 0, (bf16_t*)(wl + WL_IN), D, r, 0); r -= I_IN1;
                if (r < I_IN2) return titem(win_l + 8200, INW, 192, 32, (bf16_t*)(wl + WL_IN) + (size_t)8192 * D, D, r, 0); r -= I_IN2;
                if (r < I_GU) return titem(args.in[20] + (size_t)l * D * 2 * FF, 2 * FF, 352, 0, (bf16_t*)(wl + WL_GU), D, r, 1); r -= I_GU;
                if (r < I_DN) return titem(args.in[21] + (size_t)l * FF * D, D, 64, 0, (bf16_t*)(wl + WL_DN), FF, r, 0); r -= I_DN;
                if (r < I_PA) return titem(args.in[14] + (size_t)l * 1024 * D, D, 64, 0, (bf16_t*)(wl + WL_PA), 1024, r, 0); r -= I_PA;
                if (r < I_PB) return titem(args.in[15] + (size_t)l * 2048 * D, D, 64, 0, (bf16_t*)(wl + WL_PB), 2048, r, 0); r -= I_PB;
                if (r < I_PC) return titem(args.in[16] + (size_t)l * 1024 * D, D, 64, 0, (bf16_t*)(wl + WL_PC), 1024, r, 0); r -= I_PC;
                if (r < I_OUT) return titem(args.in[17] + (size_t)l * D * D, D, 64, 0, (bf16_t*)(wl + WL_OUT), D, r, 0); r -= I_OUT;
                const int kb = r / 64, nb = r % 64, k0 = 64 * kb, n0 = 32 * nb;
                TItem t; t.src = args.in[13] + (size_t)l * D * 2048 + (size_t)k0 * 2048 + n0; t.ldw = 2048;
                t.dst = ((n0 < 1024) ? WKT + (size_t)(l * 1024 + n0) * D : WVT + (size_t)(l * 1024 + n0 - 1024) * D) + k0; t.ldwt = D; return t;
            };
            f32x4 ta[8], tb[8];
            int it = F.gw;
            TItem ca = decode(it < NALL ? it : NALL - 1), cb = ca;
            tt_load(ta, ca, F.lane);
#pragma nounroll
            while (it < NALL) {
                const int n1 = it + F.ngw; cb = decode(n1 < NALL ? n1 : NALL - 1); tt_load(tb, cb, F.lane);
                tt_store(ta, ca, scr, F.lane);
                if (n1 >= NALL) break;
                const int n2 = n1 + F.ngw; ca = decode(n2 < NALL ? n2 : NALL - 1); tt_load(ta, ca, F.lane);
                tt_store(tb, cb, scr, F.lane);
                it = n2;
            }
        }
        const int gt = F.bid * 512 + F.tid, ngt = F.G * 512;
        for (int i = gt; i < DEPTH * 8 * D; i += ngt) { const int l = i / (8 * D), q = (i / D) % 8, k = i % D; WG[i] = w_in[((size_t)l * D + k) * INW + SRC_GATE + q]; }
        for (int i = gt; i < DEPTH * ZW; i += ngt) { const int l = i / ZW, c = i % ZW; BIN[i] = b_in[(size_t)l * INW + (c < 8192 ? c : c + 8)]; }
        if (gt < 32) PAR[PAR_GBIAS + gt] = b_in[(size_t)(gt >> 3) * INW + SRC_GATE + (gt & 7)];
        if (gt < D) { PAR[PAR_ONE + gt] = 1.f; PAR[PAR_ZERO + gt] = 0.f; }
#define CPY(dst, src, n) do { const float* _s = (src); for (int i = gt; i < (n); i += ngt) PAR[(dst) + i] = _s[i]; } while (0)
        CPY(PAR_GWS, args.in[8], DEPTH * 8 * 128 * 128); CPY(PAR_GLNG, args.in[6], DEPTH * 1024); CPY(PAR_GLNB, args.in[7], DEPTH * 1024); CPY(PAR_GBS, args.in[9], DEPTH * 8 * 128);
        CPY(PAR_CONVW, args.in[10], DEPTH * 4 * 2048); CPY(PAR_CONVB, args.in[11], DEPTH * 2048); CPY(PAR_MNG, args.in[12], DEPTH * 2048);
        CPY(PAR_LN1G, args.in[18], DEPTH * D); CPY(PAR_LN1B, args.in[19], DEPTH * D); CPY(PAR_LN2G, args.in[22], DEPTH * D); CPY(PAR_LN2B, args.in[23], DEPTH * D);
#undef CPY
        { const float* gws = args.in[8];
          for (int i = gt; i < DEPTH * 8 * 16384; i += ngt) { const int lg = i >> 14, f = (i >> 9) & 31, ln = (i >> 3) & 63, j = i & 7; const int t = 16 * (f >> 2) + (ln & 15), sx = 32 * (f & 3) + 8 * (ln >> 4) + j;
              WF32[i] = (sx <= t) ? gws[((size_t)lg * 128 + t) * 128 + sx] : 0.f; }
          for (int i = gt; i < DEPTH * 8 * 128; i += ngt) { const int t = i & 127; const float* wr_ = gws + (size_t)i * 128; float sm = 0.f; for (int sx = 0; sx <= t; ++sx) sm += wr_[sx]; C2A[i] = sm; } }
        for (int i = gt; i < DEPTH * D * 256; i += ngt) { const int l = i / (D * 256), k = (i / 256) % D, c4 = (i & 255) * 4; const f32x4 v = *(const f32x4*)(w_in + ((size_t)l * D + k) * INW + 8200 + c4);
            u32x2 o; o.x = pk2(v.x, v.y); o.y = pk2(v.z, v.w); *(u32x2*)(WQN + ((size_t)l * D + k) * 1024 + c4) = o; }
        for (int i = gt; i < DEPTH * 1024; i += ngt) PAR[PAR_BQ + i] = b_in[(size_t)(i >> 10) * INW + 8200 + (i & 1023)];
        for (int m = F.gw; m < NBATCH * MEMLEN; m += F.ngw) row_pass(args.in[1] + (size_t)m * D, true, args.in[2], args.in[3], nullptr, MEMN + (size_t)m * D, nullptr, nullptr, nullptr, F.lane);
        __syncthreads();
        { LAS float* wg = (LAS float*)F.lds;
          for (int i = F.tid; i < 8 * D; i += 512) { const int q = i / D, k = i % D; wg[i] = w_in[(size_t)k * INW + SRC_GATE + q]; }
          __syncthreads();
          { f32x4 va[8], vb[8]; int m = F.gw; row_load(x_in + (size_t)m * D, va, F.lane);
            for (; m < T; m += F.ngw) { const int mn = (m + F.ngw < T) ? m + F.ngw : m; row_load(x_in + (size_t)mn * D, vb, F.lane);
                row_finish(va, false, nullptr, nullptr, PF + (size_t)m * D, XB + (size_t)m * D, wg, b_in + SRC_GATE, GATES + (size_t)m * 8, F.lane); if (F.lane == 0) { STAT[2 * m] = 0.f; STAT[2 * m + 1] = 1.f; }
#pragma unroll
                for (int j = 0; j < 8; ++j) va[j] = vb[j]; } }
          __syncthreads(); }
    }
    SEAM(0);
    if (IN(1)) {
        PHASE_CTX
        if (F.bid < 64) { pg8::GemmStd<D, D, D> g{MEMN, WKT}; pg8::StaticOrder<1024, 4096> S; S.init(64, F.bid); pg8::EpiBf16 E{KMEM, 4096};
          pg8::gemm_phase(F.lds, g, S, E, F.tid); }
        else if (F.bid < 128) { pg8::GemmStd<D, D, D> g{MEMN, WVT}; pg8::StaticOrder<1024, 4096> S; S.init(64, F.bid - 64); pg8::EpiBf16 E{VMEM, 4096};
          pg8::gemm_phase(F.lds, g, S, E, F.tid); }
    }
    SEAM(1);
    {
        PHASE_CTX
        { pg8::GemmQK g{KMEM, WQN}; pg8::StaticOrder<64 * 256, 2048> S; S.init(F.G, F.bid); pg8::EpiQK E{WQK};
          pg8::gemm_phase(F.lds, g, S, E, F.tid); }
        { pg8::GemmVW g{wsb + WS_WL, VMEM}; pg8::StaticOrder<512 * 256, 256> S; S.init(F.G, F.bid); pg8::EpiVW E{wsb};
          pg8::gemm_phase(F.lds, g, S, E, F.tid); }
        for (int i = F.bid * 512 + F.tid; i < DEPTH * 4 * 1024; i += F.G * 512) {
            const int l = i >> 12, b = (i >> 10) & 3, hm = i & 1023, h = hm >> 8, m = hm & 255;
            const bf16_t* kp = KMEM + (size_t)(b * 256 + m) * 4096 + l * 1024 + h * 256; const float* bq = PAR + PAR_BQ + l * 1024 + h * 256; float sm = 0.f;
            for (int d8 = 0; d8 < 256; d8 += 8) { const u32x4 kv = *(const u32x4*)(kp + d8); const f32x4 q0 = *(const f32x4*)(bq + d8), q1 = *(const f32x4*)(bq + d8 + 4);
                sm += bflo(kv.x) * q0[0] + bfhi(kv.x) * q0[1] + bflo(kv.y) * q0[2] + bfhi(kv.y) * q0[3] + bflo(kv.z) * q1[0] + bfhi(kv.z) * q1[1] + bflo(kv.w) * q1[2] + bfhi(kv.w) * q1[3]; }
            BQK[i] = sm * pg8::SCORE_SCALE; }
    }
    GRID_BAR();

    for (int lyr = 0; lyr < DEPTH; ++lyr) {
        const int pb = 2 + 10 * lyr;
#define LAYER_CTX PHASE_CTX int l = lyr; asm volatile("" : "+s"(l)); unsigned char* wl = wsb + WS_WL + (size_t)l * WL_STRIDE; (void)wl;
        if (IN(pb + 0)) {
            LAYER_CTX
            for (int ch = F.gw; ch < 1024; ch += F.ngw) {
                const int bh = ch >> 6, c = ch & 63, b = bh >> 2, h = bh & 3;
                const size_t row = (size_t)b * SEQ + 64 * c + F.lane;
                const float gi = GATES[row * 8 + h], gf = GATES[row * 8 + 4 + h];
                float bc = fminf(gf, 0.f) - log1pf(expf(-fabsf(gf)));
#pragma unroll
                for (int o = 1; o < 64; o <<= 1) { const float y = shup(bc, o, F.lane); if (F.lane >= o) bc += y; }
                const float bv = gi - bc; float pm = bv;
#pragma unroll
                for (int o = 1; o < 64; o <<= 1) { const float y = shup(pm, o, F.lane); if (F.lane >= o) pm = fmaxf(pm, y); }
                const int pos = bh * 4096 + 64 * c + F.lane;
                GS[GS_BCUM + pos] = bc; GS[GS_BV + pos] = bv; GS[GS_PMAX + pos] = pm;
                if (F.lane == 63) { GS[GS_BLAST + ch] = bc; GS[GS_MAXB + ch] = pm; }
            }
            pg8::GemmIn g{XB, (const bf16_t*)(wl + WL_IN), WQK + (size_t)l * 4 * 1024 * D}; pg8::StaticOrder<T, ZW> S; S.init(F.G, F.bid);
            pg8::EpiIn E{Z, BIN + (size_t)l * ZW, BQK + (size_t)l * 4096, (LAS float*)(F.lds + RING_BYTES)};
            pg8::gemm_phase(F.lds, g, S, E, F.tid);
        }
        SEAM(pb + 0);
        if (IN(pb + 1)) {
            LAYER_CTX
            {
                LAS bf16_t* QL = (LAS bf16_t*)F.lds; LAS bf16_t* KL = QL + 64 * 264; LAS bf16_t* PL = KL + 64 * 264;
                LAS float* WSL = (LAS float*)(PL + 64 * 72);
                LAS bf16_t* VTL = (LAS bf16_t*)(WSL + 64);
                const int w = F.wave, fr = F.lane & 15, fq = F.lane >> 4;
                u32x4 zr[11], va[8]; f32x4 cw[4][2], cb2[2]; float bl, mb;
                auto pp_load = [&](int chx) {
                    const int bhx = chx >> 6, cx = chx & 63, bx = bhx >> 2, hx = bhx & 3; const size_t row0x = (size_t)bx * SEQ + 64 * cx;
                    bl = GS[GS_BLAST + bhx * 64 + F.lane]; mb = GS[GS_MAXB + bhx * 64 + F.lane];
                    const int cg = F.tid & 63, rg = F.tid >> 6; const int chz = (cg < 32) ? hx * 256 + 8 * cg : 1024 + hx * 256 + 8 * (cg - 32);
                    const float* cwp = PAR + PAR_CONVW + l * 4 * 2048 + chz; const float* cbp = PAR + PAR_CONVB + l * 2048 + chz;
#pragma unroll
                    for (int j = 0; j < 4; ++j) { cw[j][0] = *(const f32x4*)(cwp + j * 2048); cw[j][1] = *(const f32x4*)(cwp + j * 2048 + 4); }
                    cb2[0] = *(const f32x4*)cbp; cb2[1] = *(const f32x4*)(cbp + 4);
                    const bf16_t* zp = Z + (row0x + 8 * rg) * ZW + ZQK + chz;
#pragma unroll
                    for (int k = 0; k < 11; ++k) { if (k >= 3 || rg > 0 || cx > 0) zr[k] = *(const u32x4*)(zp + (ptrdiff_t)(k - 3) * ZW); else zr[k] = (u32x4){0u, 0u, 0u, 0u}; }
                    const int sx = F.tid & 63, cq = F.tid >> 6; const bf16_t* vp = Z + (row0x + sx) * ZW + ZVM + hx * 512 + 64 * cq;
#pragma unroll
                    for (int q = 0; q < 8; ++q) va[q] = *(const u32x4*)(vp + 8 * q);
                };
                pp_load(F.bid);
                for (int ch = F.bid; ch < 1024; ch += F.G) {
                    const int bh = ch >> 6, c = ch & 63, b = bh >> 2, h = bh & 3; const size_t row0 = (size_t)b * SEQ + 64 * c; const int pos0 = bh * 4096 + 64 * c;
                    float mp = 0.f;
                    for (int cc = 0; cc < c; ++cc) mp = rdlane(bl, cc) + fmaxf(mp, rdlane(mb, cc));
                    const float mm = fmaxf(mp, GS[GS_MAXB + ch]);
                    if (F.tid == 0) GS[GS_MPREV + ch] = mp;
                    if (F.tid < 64) { WSL[F.tid] = expf(GS[GS_BV + pos0 + F.tid] - mm); WIG[(size_t)ch * 256 + F.tid] = expf(mp - fmaxf(GS[GS_PMAX + pos0 + F.tid], mp)); }
                    if (F.tid == 64) WIG[(size_t)ch * 256 + 64] = expf(mp - mm);
                    {
                      const int cg = F.tid & 63, rg = F.tid >> 6;
                      const float osc = (cg < 32) ? 1.0f : 0.0625f;
                      f32x4 zf[11][2];
#pragma unroll
                      for (int k = 0; k < 11; ++k) { zf[k][0] = (f32x4){bflo(zr[k].x), bfhi(zr[k].x), bflo(zr[k].y), bfhi(zr[k].y)}; zf[k][1] = (f32x4){bflo(zr[k].z), bfhi(zr[k].z), bflo(zr[k].w), bfhi(zr[k].w)}; }
                      LAS bf16_t* dst = ((cg < 32) ? QL : KL) + (8 * rg) * 264 + 8 * (cg & 31);
#pragma unroll
                      for (int rr = 0; rr < 8; ++rr) { f32x4 y0 = cb2[0], y1 = cb2[1];
#pragma unroll
                          for (int j = 0; j < 4; ++j) { y0 += cw[j][0] * zf[rr + j][0]; y1 += cw[j][1] * zf[rr + j][1]; }
#pragma unroll
                          for (int e = 0; e < 4; ++e) { y0[e] = y0[e] * fast_sigmoid(y0[e]) * osc; y1[e] = y1[e] * fast_sigmoid(y1[e]) * osc; }
                          u32x4 o; o.x = cvt_pk_bf16(y0[0], y0[1]); o.y = cvt_pk_bf16(y0[2], y0[3]); o.z = cvt_pk_bf16(y1[0], y1[1]); o.w = cvt_pk_bf16(y1[2], y1[3]);
                          *(LAS u32x4*)(dst + rr * 264) = o; } }
                    {
                      const int sx = F.tid & 63, cq = F.tid >> 6;
#pragma unroll
                      for (int q = 0; q < 8; ++q) { const u32x4 a = va[q]; LAS bf16_t* d0 = VTL + (64 * cq + 8 * q) * 72 + sx;
                          d0[0] = (bf16_t)(a.x & 0xffffu); d0[72] = (bf16_t)(a.x >> 16); d0[2 * 72] = (bf16_t)(a.y & 0xffffu); d0[3 * 72] = (bf16_t)(a.y >> 16);
                          d0[4 * 72] = (bf16_t)(a.z & 0xffffu); d0[5 * 72] = (bf16_t)(a.z >> 16); d0[6 * 72] = (bf16_t)(a.w & 0xffffu); d0[7 * 72] = (bf16_t)(a.w >> 16); } }
                    pp_load(ch + F.G < 1024 ? ch + F.G : ch);
                    __syncthreads();
                    const int tb = w >> 1, half = w & 1;
                    bf16x8 qa[8];
#pragma unroll
                    for (int i = 0; i < 8; ++i) qa[i] = *(const LAS bf16x8*)(QL + (16 * tb + fr) * 264 + 32 * i + 8 * fq);
                    { bf16_t* qf = QF + ((size_t)ch * 32 + tb * 8 + 4 * half) * 512 + F.lane * 8;
                      const float wir = expf(mp - fmaxf(GS[GS_PMAX + pos0 + 16 * tb + fr], mp));
#pragma unroll
                      for (int ii = 0; ii < 4; ++ii) { const int i = 4 * half + ii; const LAS bf16_t* qp = QL + (16 * tb + fr) * 264 + 32 * i + 4 * fq;
                          u32x4 o; const u32x2 lo = *(const LAS u32x2*)qp, hi = *(const LAS u32x2*)(qp + 16);
                          o.x = cvt_pk_bf16(bflo(lo.x) * wir, bfhi(lo.x) * wir); o.y = cvt_pk_bf16(bflo(lo.y) * wir, bfhi(lo.y) * wir); o.z = cvt_pk_bf16(bflo(hi.x) * wir, bfhi(hi.x) * wir); o.w = cvt_pk_bf16(bflo(hi.y) * wir, bfhi(hi.y) * wir);
                          *(u32x4*)(qf + ii * 512) = o; } }
                    const f32x4 pm4 = *(const f32x4*)(GS + GS_PMAX + pos0 + 16 * tb + 4 * fq);
#pragma unroll
                    for (int sbi = 0; sbi < 2; ++sbi) { const int sb = 2 * half + sbi; f32x4 acc = (f32x4){0.f, 0.f, 0.f, 0.f};
                        if (sb <= tb) {
#pragma unroll
                            for (int i = 0; i < 8; ++i) { const bf16x8 kb = *(const LAS bf16x8*)(KL + (16 * sb + fr) * 264 + 32 * i + 8 * fq); acc = mfma16(qa[i], kb, acc); }
                            const float Bs = GS[GS_BV + pos0 + 16 * sb + fr]; const int sx = 16 * sb + fr;
#pragma unroll
                            for (int r = 0; r < 4; ++r) { const int t = 16 * tb + 4 * fq + r; const float At = -fmaxf(pm4[r], mp); acc[r] = (sx <= t) ? expf(At + Bs) * acc[r] : 0.f; } }
#pragma unroll
                        for (int r = 0; r < 4; ++r) PL[(16 * tb + 4 * fq + r) * 72 + 16 * sb + fr] = (bf16_t)f2bf(acc[r]); }
                    __syncthreads();
                    { const int i = w & 1; const bf16x8 pf = *(const LAS bf16x8*)(PL + (16 * tb + fr) * 72 + 32 * i + 8 * fq);
                      *(bf16x8*)(PFR + ((size_t)ch * 8 + tb * 2 + i) * 512 + F.lane * 8) = pf; }
#pragma unroll
                    for (int dbi = 0; dbi < 2; ++dbi)
#pragma unroll
                        for (int i = 0; i < 2; ++i) { const int db = 2 * w + dbi; float kv[8];
#pragma unroll
                            for (int j = 0; j < 8; ++j) { const int sx = 32 * i + 8 * fq + j; kv[j] = WSL[sx] * bf2f(KL[sx * 264 + 16 * db + fr]); }
                            u32x4 o; o.x = pk2(kv[0], kv[1]); o.y = pk2(kv[2], kv[3]); o.z = pk2(kv[4], kv[5]); o.w = pk2(kv[6], kv[7]);
                            *(u32x4*)(KF + ((size_t)ch * 32 + db * 2 + i) * 512 + F.lane * 8) = o; }
#pragma unroll
                    for (int vi = 0; vi < 4; ++vi)
#pragma unroll
                        for (int i = 0; i < 2; ++i) { const int vblk = 4 * w + vi; const u32x4 o = *(const LAS u32x4*)(VTL + (16 * vblk + fr) * 72 + 32 * i + 8 * fq);
                            *(u32x4*)(VF + ((size_t)ch * 64 + vblk * 2 + i) * 512 + F.lane * 8) = o; }
                    __syncthreads();
                }
            }
            for (int m0 = F.gw * 8; m0 < T; m0 += F.ngw * 8) {
                u32x4 ra[8], rbv[8];
#pragma unroll
                for (int rr = 0; rr < 8; ++rr) { const bf16_t* vp = Z + (size_t)(m0 + rr) * ZW + ZV; ra[rr] = *(const u32x4*)(vp + 8 * F.lane); rbv[rr] = *(const u32x4*)(vp + 512 + 8 * F.lane); }
                float s1[8], s2[8];
#pragma unroll
                for (int rr = 0; rr < 8; ++rr) { const u32x4 a = ra[rr], b = rbv[rr];
                    const float e[16] = {bflo(a.x), bfhi(a.x), bflo(a.y), bfhi(a.y), bflo(a.z), bfhi(a.z), bflo(a.w), bfhi(a.w), bflo(b.x), bfhi(b.x), bflo(b.y), bfhi(b.y), bflo(b.z), bfhi(b.z), bflo(b.w), bfhi(b.w)};
                    float t1 = 0.f, t2 = 0.f;
#pragma unroll
                    for (int j = 0; j < 16; ++j) { t1 += e[j]; t2 += e[j] * e[j]; }
                    s1[rr] = t1; s2[rr] = t2; }
#pragma unroll
                for (int rr = 0; rr < 8; ++rr) { s1[rr] = wave_sum(s1[rr], F.lane); s2[rr] = wave_sum(s2[rr], F.lane); }
#pragma unroll
                for (int rr = 0; rr < 8; ++rr) { const float mean = s1[rr] * (1.f / 1024.f); const float var = fmaxf(s2[rr] * (1.f / 1024.f) - mean * mean, 0.f);
                    if (F.lane == 0) { VSTAT[2 * (m0 + rr)] = mean; VSTAT[2 * (m0 + rr) + 1] = 1.f / sqrtf(var + LN_EPS); } }
            }
        }
        SEAM(pb + 1);
        {
            LAYER_CTX
            if (F.bid < 80) {
            LAS unsigned char* RG = F.lds;
            const int w = F.wave, fr = F.lane & 15, fq = F.lane >> 4;
            const bool is_den = F.bid >= 64;
            const int it = is_den ? F.bid - 64 : F.bid;
            const int bh = is_den ? (it & 7) * 2 + (it >> 3) : (it & 7) * 2 + (it >> 5), jq = is_den ? 0 : (it >> 3) & 3, b = bh >> 2, h = bh & 3;
            const bool active = w < 4 && (!is_den || w == 0);
            bf16x8 ones; { const short o1 = (fr == 0) ? (short)0x3f80 : (short)0; ones = (bf16x8){o1, o1, o1, o1, o1, o1, o1, o1}; }
            const int lo8 = F.lane * 8;
            f32x4 CA[16], CB[16];
#pragma unroll
            for (int i = 0; i < 16; ++i) { CA[i] = (f32x4){0.f, 0.f, 0.f, 0.f}; CB[i] = (f32x4){0.f, 0.f, 0.f, 0.f}; }
            bf16x8 vA[2], vB[2];
            vA[0] = ones; vA[1] = ones; vB[0] = ones; vB[1] = ones;
            float* const dmy = (float*)(wsb + WS_DUMMY) + ((size_t)F.bid * 512 + F.tid) * 4;
#define SC_DMA(c_, sl_) do { const size_t chh = (size_t)bh * 64 + (c_); int wd_ = w - 4; asm volatile("" : "+s"(wd_));        \
                _Pragma("unroll") for (int i = 0; i < 18; ++i) { const int p_ = 18 * wd_ + i; if (p_ == 33 || p_ == 35) continue; \
                    const bf16_t* src_ = (p_ < 32) ? QF + (chh * 32 + p_) * 512 : (p_ < 40) ? PFR + (chh * 8 + (p_ - 32)) * 512 : KF + (chh * 32 + (p_ - 40)) * 512; \
                    __builtin_amdgcn_global_load_lds((const unsigned*)(src_ + lo8), (LAS unsigned*)(RG + (sl_) * 74752 + p_ * 1024), 16, 0, 0); } \
                if (wd_ == 0) { int l4_ = lo8; asm volatile("" : "+v"(l4_)); l4_ >>= 1; __builtin_amdgcn_global_load_lds((const unsigned*)(WIG + chh * 256 + l4_), (LAS unsigned*)(RG + (sl_) * 74752 + 72 * 1024), 16, 0, 0); } } while (0)
#define SC_LOADV(c_) do { if (active && !is_den) { int ln_ = F.lane; asm volatile("" : "+v"(ln_)); const bf16_t* v_ = VF + (((size_t)bh * 64 + (c_)) * 64 + (8 * jq + 2 * w) * 2) * 512 + ln_ * 8; \
                vA[0] = *(const bf16x8*)v_; vA[1] = *(const bf16x8*)(v_ + 512); vB[0] = *(const bf16x8*)(v_ + 1024); vB[1] = *(const bf16x8*)(v_ + 1536); } } while (0)
#define SC_SB __builtin_amdgcn_sched_barrier(0)
#define SC_RD4(dst, p0, p1, p2, p3) do { dst[0] = *(const LAS bf16x8*)(sb_ + (p0) * 1024); dst[1] = *(const LAS bf16x8*)(sb_ + (p1) * 1024); dst[2] = *(const LAS bf16x8*)(sb_ + (p2) * 1024); dst[3] = *(const LAS bf16x8*)(sb_ + (p3) * 1024); SC_SB; } while (0)
#define SC_W4 do { asm volatile("s_waitcnt lgkmcnt(4)" ::: "memory"); SC_SB; } while (0)
#define SC_INTER2(j, cur) do { \
                { const bf16x8 ca_ = pack8(CA[4 * (j)], CA[4 * (j) + 1]), cb_ = pack8(CB[4 * (j)], CB[4 * (j) + 1]); a0A = mfma16(cur[0], ca_, a0A); a0B = mfma16(cur[0], cb_, a0B); a1A = mfma16(cur[2], ca_, a1A); a1B = mfma16(cur[2], cb_, a1B); } \
                { const bf16x8 ca_ = pack8(CA[4 * (j) + 2], CA[4 * (j) + 3]), cb_ = pack8(CB[4 * (j) + 2], CB[4 * (j) + 3]); a0A = mfma16(cur[1], ca_, a0A); a0B = mfma16(cur[1], cb_, a0B); a1A = mfma16(cur[3], ca_, a1A); a1B = mfma16(cur[3], cb_, a1B); } SC_SB; } while (0)
#define SC_INTRA2(cur) do { a0A = mfma16(cur[0], vA[0], a0A); a0B = mfma16(cur[0], vB[0], a0B); a1A = mfma16(cur[2], vA[0], a1A); a1B = mfma16(cur[2], vB[0], a1B); \
                a0A = mfma16(cur[1], vA[1], a0A); a0B = mfma16(cur[1], vB[1], a0B); a1A = mfma16(cur[3], vA[1], a1A); a1B = mfma16(cur[3], vB[1], a1B); SC_SB; } while (0)
#define SC_OUT(p) do { if (!is_den) { bf16_t* hp = HRAW + (row0 + 32 * (p)) * 2048 + h * 512 + 128 * jq + 32 * w + ((4 * fq) * 2048 + fr); \
                    _Pragma("unroll") for (int r = 0; r < 4; ++r) { hp[r * 2048] = (bf16_t)f2bf(a0A[r]); hp[r * 2048 + 16] = (bf16_t)f2bf(a0B[r]); hp[(16 + r) * 2048] = (bf16_t)f2bf(a1A[r]); hp[(16 + r) * 2048 + 16] = (bf16_t)f2bf(a1B[r]); } } \
                else { float* dp = (fr == 0) ? DEN + (row0 + 32 * (p)) * 4 + h + (4 * fq) * 4 : dmy; const int ds_ = (fr == 0) ? 4 : 0; \
                    _Pragma("unroll") for (int r = 0; r < 4; ++r) { dp[r * ds_] = a0A[r]; dp[(16 + r) * ds_] = a1A[r]; } } \
                SC_SB; } while (0)
#define SC_ZERO do { a0A = (f32x4){0.f, 0.f, 0.f, 0.f}; a0B = a0A; a1A = a0A; a1B = a0A; } while (0)
#define SC_UPD(u, cur) do { f32x4 t0_ = scale4(CA[2 * (u)], dec), t1_ = scale4(CB[2 * (u)], dec), t2_ = scale4(CA[2 * (u) + 1], dec), t3_ = scale4(CB[2 * (u) + 1], dec); \
                t0_ = mfma16(cur[0], vA[0], t0_); t1_ = mfma16(cur[0], vB[0], t1_); t2_ = mfma16(cur[2], vA[0], t2_); t3_ = mfma16(cur[2], vB[0], t3_); \
                CA[2 * (u)] = mfma16(cur[1], vA[1], t0_); CB[2 * (u)] = mfma16(cur[1], vB[1], t1_); CA[2 * (u) + 1] = mfma16(cur[3], vA[1], t2_); CB[2 * (u) + 1] = mfma16(cur[3], vB[1], t3_); SC_SB; } while (0)
#define SC_STEP(c_, sl_, cn_, sn_) do { const size_t row0 = (size_t)b * SEQ + 64 * (c_); \
                const LAS unsigned char* sb_ = RG + (sl_) * 74752 + F.lane * 16; const LAS float* wip_ = (const LAS float*)(RG + (sl_) * 74752 + 72 * 1024); \
                if (active) { \
                const float dec = wip_[64]; \
                f32x4 a0A, a0B, a1A, a1B; bf16x8 fa[4], fb[4]; \
                SC_ZERO; \
                SC_RD4(fa, 0, 1, 8, 9); \
                SC_RD4(fb, 2, 3, 10, 11); SC_W4; SC_INTER2(0, fa); \
                SC_RD4(fa, 4, 5, 12, 13); SC_W4; SC_INTER2(1, fb); \
                SC_RD4(fb, 6, 7, 14, 15); SC_W4; SC_INTER2(2, fa); \
                fa[0] = *(const LAS bf16x8*)(sb_ + 32 * 1024); fa[2] = *(const LAS bf16x8*)(sb_ + 34 * 1024); SC_SB; asm volatile("s_waitcnt lgkmcnt(2)" ::: "memory"); SC_SB; SC_INTER2(3, fb);        \
                SC_RD4(fb, 16, 17, 24, 25); SC_W4; a0A = mfma16(fa[0], vA[0], a0A); a0B = mfma16(fa[0], vB[0], a0B); a1A = mfma16(fa[2], vA[0], a1A); a1B = mfma16(fa[2], vB[0], a1B); SC_SB; SC_OUT(0); SC_ZERO; \
                _Pragma("unroll") for (int i = 0; i < 16; ++i) asm volatile("" : "+v"(CA[i]), "+v"(CB[i]));        \
                SC_RD4(fa, 18, 19, 26, 27); SC_W4; SC_INTER2(0, fb); \
                SC_RD4(fb, 20, 21, 28, 29); SC_W4; SC_INTER2(1, fa); \
                SC_RD4(fa, 22, 23, 30, 31); SC_W4; SC_INTER2(2, fb); \
                SC_RD4(fb, 36, 37, 38, 39); SC_W4; SC_INTER2(3, fa); \
                SC_RD4(fa, 40, 41, 42, 43); SC_W4; SC_INTRA2(fb); SC_OUT(1); \
                SC_RD4(fb, 44, 45, 46, 47); SC_W4; SC_UPD(0, fa); \
                SC_RD4(fa, 48, 49, 50, 51); SC_W4; SC_UPD(1, fb); \
                SC_RD4(fb, 52, 53, 54, 55); SC_W4; SC_UPD(2, fa); \
                SC_RD4(fa, 56, 57, 58, 59); SC_W4; SC_UPD(3, fb); \
                SC_RD4(fb, 60, 61, 62, 63); SC_W4; SC_UPD(4, fa); \
                SC_RD4(fa, 64, 65, 66, 67); SC_W4; SC_UPD(5, fb); \
                SC_RD4(fb, 68, 69, 70, 71); SC_W4; SC_UPD(6, fa); \
                asm volatile("s_waitcnt lgkmcnt(0)" ::: "memory"); SC_SB; SC_UPD(7, fb); \
                SC_LOADV(cn_);        \
                } else if (w >= 4) { SC_DMA(cn_, sn_); asm volatile("" ::: "memory"); __builtin_amdgcn_s_waitcnt(0x0070); }       \
                __builtin_amdgcn_s_barrier(); asm volatile("" ::: "memory"); } while (0)
            if (w >= 4) { SC_DMA(0, 0); }
            asm volatile("" ::: "memory"); __builtin_amdgcn_s_waitcnt(0x0070); __builtin_amdgcn_s_barrier(); asm volatile("" ::: "memory");
#define SC_TRIP(c) do { { SC_STEP((c), 0, (c) + 1, 1); } \
                { const int cnx_ = (c) + 2 < 64 ? (c) + 2 : 63; SC_STEP((c) + 1, 1, cnx_, 0); } } while (0)
            SC_LOADV(0);
#pragma nounroll
            for (int c = 0; c < 64; c += 2) SC_TRIP(c);
#undef SC_TRIP
#undef SC_STEP
#undef SC_UPD
#undef SC_ZERO
#undef SC_OUT
#undef SC_INTRA2
#undef SC_INTER2
#undef SC_W4
#undef SC_RD4
#undef SC_SB
#undef SC_LOADV
#undef SC_DMA
            asm volatile("s_waitcnt vmcnt(0)" ::: "memory");
            __syncthreads();
            } else {
            {
                LAS bf16_t* VT = (LAS bf16_t*)F.lds;
                LAS float* ST = (LAS float*)(F.lds + 128 * 136 * 2);
                LAS float* C1 = ST + 256;
                const int w = F.wave, fr = F.lane & 15, fq = F.lane >> 4, nst = (w >> 1) + 1;
                for (int un = F.bid - 80; un < 256; un += 176) {
                    const int cc = un >> 1, hf = un & 1; const size_t r0 = (size_t)cc * 128;
                    if (F.tid < 128) { const f32x2 sv = *(const f32x2*)(VSTAT + 2 * (r0 + F.tid)); ST[F.tid] = sv.x; ST[128 + F.tid] = sv.y; }
                    __syncthreads();
                    u32x4 ta[4]; f32x4 wa[4][2]; unsigned short uvA[8][4];
#pragma unroll
                    for (int i = 0; i < 4; ++i) { ta[i] = (u32x4){0u, 0u, 0u, 0u}; wa[i][0] = (f32x4){0.f, 0.f, 0.f, 0.f}; wa[i][1] = (f32x4){0.f, 0.f, 0.f, 0.f}; }
#pragma unroll
                    for (int db = 0; db < 8; ++db)
#pragma unroll
                        for (int r = 0; r < 4; ++r) uvA[db][r] = 0;
#define BRA_LOAD_TW(gi_) do { const int gq_ = 4 * hf + (gi_), lg_ = l * 8 + gq_; const bf16_t* vp = Z + (r0 + (F.tid & 127)) * ZW + ZV + gq_ * 128 + (F.tid >> 7) * 32; \
                        _Pragma("unroll") for (int q = 0; q < 4; ++q) ta[q] = *(const u32x4*)(vp + 8 * q); \
                        _Pragma("unroll") for (int i = 0; i < 4; ++i) if (i < nst) { const float* wp = WF32 + ((size_t)lg_ * 32 + w * 4 + i) * 512 + F.lane * 8; wa[i][0] = *(const f32x4*)wp; wa[i][1] = *(const f32x4*)(wp + 4); } } while (0)
#define BRA_LOAD_UV(gi_, UV) do { const bf16_t* up0 = Z + (r0 + 16 * w + 4 * fq) * ZW + ZU + (4 * hf + (gi_)) * 128 + fr; \
                        _Pragma("unroll") for (int db = 0; db < 8; ++db) _Pragma("unroll") for (int r = 0; r < 4; ++r) UV[db][r] = up0[(size_t)r * ZW + 16 * db]; } while (0)
                    BRA_LOAD_TW(0); BRA_LOAD_UV(0, uvA);
#pragma nounroll
                    for (int gi = 0; gi < 4; ++gi) { const int gq = 4 * hf + gi, lg = l * 8 + gq;
                        { const int sx = F.tid & 127, c0 = (F.tid >> 7) * 32;
#pragma unroll
                          for (int q = 0; q < 4; ++q) { const u32x4 a = ta[q]; LAS bf16_t* d0 = VT + (c0 + 8 * q) * 136 + sx;
                              d0[0] = (bf16_t)(a.x & 0xffffu); d0[136] = (bf16_t)(a.x >> 16); d0[2 * 136] = (bf16_t)(a.y & 0xffffu); d0[3 * 136] = (bf16_t)(a.y >> 16);
                              d0[4 * 136] = (bf16_t)(a.z & 0xffffu); d0[5 * 136] = (bf16_t)(a.z >> 16); d0[6 * 136] = (bf16_t)(a.w & 0xffffu); d0[7 * 136] = (bf16_t)(a.w >> 16); } }
                        bf16x8 af[4]; float c1p = 0.f;
#pragma unroll
                        for (int i = 0; i < 4; ++i) { u32x4 o = (u32x4){0u, 0u, 0u, 0u};
                            if (i < nst) { const f32x4 w0 = wa[i][0], w1 = wa[i][1];
                                const LAS float* sp = ST + 32 * i + 8 * fq; const f32x4 m0 = *(const LAS f32x4*)sp, m1 = *(const LAS f32x4*)(sp + 4), q0 = *(const LAS f32x4*)(sp + 128), q1 = *(const LAS f32x4*)(sp + 132);
                                const f32x4 p0 = w0 * q0, p1 = w1 * q1;
                                o.x = pk2(p0[0], p0[1]); o.y = pk2(p0[2], p0[3]); o.z = pk2(p1[0], p1[1]); o.w = pk2(p1[2], p1[3]);
                                c1p += bflo(o.x) * m0[0] + bfhi(o.x) * m0[1] + bflo(o.y) * m0[2] + bfhi(o.y) * m0[3] + bflo(o.z) * m1[0] + bfhi(o.z) * m1[1] + bflo(o.w) * m1[2] + bfhi(o.w) * m1[3]; }
                            af[i] = __builtin_bit_cast(bf16x8, o); }
                        c1p += shx(c1p, 16, F.lane); c1p += shx(c1p, 32, F.lane);
                        if (fq == 0) C1[w * 16 + fr] = c1p;
                        __syncthreads();
                        if (gi < 3) BRA_LOAD_TW(gi + 1);
                        const f32x4 c14 = *(const LAS f32x4*)(C1 + w * 16 + 4 * fq);
                        const f32x4 c24 = *(const f32x4*)(C2A + lg * 128 + 16 * w + 4 * fq), bs4 = *(const f32x4*)(PAR + PAR_GBS + lg * 128 + 16 * w + 4 * fq);
#pragma unroll
                        for (int db = 0; db < 8; ++db) { f32x4 acc = (f32x4){0.f, 0.f, 0.f, 0.f};
#pragma unroll
                            for (int i = 0; i < 4; ++i) if (i < nst) { const bf16x8 bb = *(const LAS bf16x8*)(VT + (16 * db + fr) * 136 + 32 * i + 8 * fq); acc = mfma16(af[i], bb, acc); }
                            const int dcol = gq * 128 + 16 * db + fr; const float gg = PAR[PAR_GLNG + l * 1024 + dcol], bbv = PAR[PAR_GLNB + l * 1024 + dcol];
                            bf16_t* up = Z + (r0 + 16 * w + 4 * fq) * ZW + ZU + dcol;
#pragma unroll
                            for (int r = 0; r < 4; ++r) { const float mixed = gg * (acc[r] - c14[r]) + bbv * c24[r] + bs4[r]; up[(size_t)r * ZW] = (bf16_t)f2bf(bf2f(uvA[db][r]) * mixed); } }
                        asm volatile("" ::: "memory");
                        if (gi < 3) BRA_LOAD_UV(gi + 1, uvA);
                        __syncthreads();
                    }
#undef BRA_LOAD_TW
#undef BRA_LOAD_UV
                }
            }
                __syncthreads();
                { pg8::GemmT<ZW, 1024, 1024, 256L * ZW, 0L, 2048L * 1024, 256L * 1024> g{Z + ZQX, (const bf16_t*)(wsb + (l < 2 ? WS_VW01 + (size_t)l * 16 * MiB : WS_VW23 + (size_t)(l - 2) * 16 * MiB))};
                  pg8::StaticOrder<T, D> S; S.init(176, F.bid - 80); pg8::EpiGate<0> E{Z + ZG + 4096, MRG};
                  pg8::gemm_phase(F.lds, g, S, E, F.tid); }
            }
        }
        GRID_BAR();
        if (IN(pb + 2)) {
            LAYER_CTX
            for (int it0 = F.gw; it0 < T * 4; it0 += 4 * F.ngw) {
                u32x4 hw[4], ow[4]; float g0_[4], g1_[4], g2_[4], dnr[4]; f32x4 ga[4], gb[4];
#pragma unroll
                for (int q = 0; q < 4; ++q) { const int it = it0 + q * F.ngw; const size_t r = (size_t)(it >> 2); const int hq = it & 3; const int c0 = hq * 512 + 8 * F.lane;
                    hw[q] = *(const u32x4*)(HRAW + r * 2048 + c0); ow[q] = *(const u32x4*)(Z + r * ZW + ZO + c0);
                    const int bh = (int)(r >> 12) * 4 + hq, tp = (int)(r & 4095), pos = bh * 4096 + tp;
                    g0_[q] = GS[GS_BCUM + pos]; g1_[q] = GS[GS_PMAX + pos]; g2_[q] = GS[GS_MPREV + bh * 64 + (tp >> 6)]; dnr[q] = DEN[r * 4 + hq];
                    ga[q] = *(const f32x4*)(PAR + PAR_MNG + l * 2048 + c0); gb[q] = *(const f32x4*)(PAR + PAR_MNG + l * 2048 + c0 + 4); }
#pragma unroll
                for (int q = 0; q < 4; ++q) { const int it = it0 + q * F.ngw; const size_t r = (size_t)(it >> 2); const int hq = it & 3; const int c0 = hq * 512 + 8 * F.lane;
                    f32x4 a = (f32x4){bflo(hw[q].x), bfhi(hw[q].x), bflo(hw[q].y), bfhi(hw[q].y)}, b4 = (f32x4){bflo(hw[q].z), bfhi(hw[q].z), bflo(hw[q].w), bfhi(hw[q].w)};
                    { const float mrow = g0_[q] + fmaxf(g1_[q], g2_[q]); const float dn = 1.f / fmaxf(fabsf(dnr[q]), expf(-mrow)); a = a * dn; b4 = b4 * dn; }
                    const float mean = wave_sum((a.x + a.y) + (a.z + a.w) + (b4.x + b4.y) + (b4.z + b4.w), F.lane) * (1.f / 512.f);
                    const f32x4 da = a - mean, db = b4 - mean;
                    const float var = wave_sum((da.x * da.x + da.y * da.y) + (da.z * da.z + da.w * da.w) + (db.x * db.x + db.y * db.y) + (db.z * db.z + db.w * db.w), F.lane) * (1.f / 512.f);
                    const float rstd = 1.f / sqrtf(var + LN_EPS);
                    const f32x4 ya = da * rstd * ga[q], yb = db * rstd * gb[q]; const u32x4 o4 = ow[q];
                    u32x4 w; w.x = pk2(ya.x * bflo(o4.x), ya.y * bfhi(o4.x)); w.y = pk2(ya.z * bflo(o4.y), ya.w * bfhi(o4.y)); w.z = pk2(yb.x * bflo(o4.z), yb.y * bfhi(o4.z)); w.w = pk2(yb.z * bflo(o4.w), yb.w * bfhi(o4.w));
                    *(u32x4*)(Z + r * ZW + ZO + c0) = w; }
            }
        }
        SEAM(pb + 2);
        if (IN(pb + 4)) {
            LAYER_CTX
            int og = (F.bid >> 3) & 1; asm volatile("" : "+s"(og));
            if (og == 0) {
                { pg8::GemmStd<ZW, 1024, 1024> g{Z + ZU, (const bf16_t*)(wl + WL_PA)}; pg8::StaticOrder<T, D> S; S.init(F.G, F.bid); pg8::EpiGate<1> E{Z + ZG, MRG};
                  pg8::gemm_phase(F.lds, g, S, E, F.tid); }
                { pg8::GemmStd<ZW, 2048, 2048> g{Z + ZO, (const bf16_t*)(wl + WL_PB)}; pg8::StaticOrder<T, D> S; S.init(F.G, F.bid); pg8::EpiGate<1> E{Z + ZG + 2048, MRG};
                  pg8::gemm_phase(F.lds, g, S, E, F.tid); }
            } else {
                { pg8::GemmStd<ZW, 2048, 2048> g{Z + ZO, (const bf16_t*)(wl + WL_PB)}; pg8::StaticOrder<T, D> S; S.init(F.G, F.bid); pg8::EpiGate<1> E{Z + ZG + 2048, MRG};
                  pg8::gemm_phase(F.lds, g, S, E, F.tid); }
                { pg8::GemmStd<ZW, 1024, 1024> g{Z + ZU, (const bf16_t*)(wl + WL_PA)}; pg8::StaticOrder<T, D> S; S.init(F.G, F.bid); pg8::EpiGate<1> E{Z + ZG, MRG};
                  pg8::gemm_phase(F.lds, g, S, E, F.tid); }
            }
        }
        SEAM(pb + 4);
        if (IN(pb + 5)) {
            LAYER_CTX
            pg8::GemmStd<D, D, D> g{MRG, (const bf16_t*)(wl + WL_OUT)}; pg8::StaticOrder<T, D> S; S.init(F.G, F.bid);
            pg8::EpiResid E{PF, STAT, l ? PAR + PAR_LN2G + (l - 1) * D : PAR + PAR_ONE, l ? PAR + PAR_LN2B + (l - 1) * D : PAR + PAR_ZERO};
            pg8::gemm_phase(F.lds, g, S, E, F.tid);
        }
        SEAM(pb + 5);
        if (IN(pb + 6)) {
            LAYER_CTX
            { f32x4 va[8], vb[8]; int m = F.gw; row_load(PF + (size_t)m * D, va, F.lane);
              for (; m < T; m += F.ngw) { const int mn = (m + F.ngw < T) ? m + F.ngw : m; row_load(PF + (size_t)mn * D, vb, F.lane);
                  row_finish(va, true, PAR + PAR_LN1G + l * D, PAR + PAR_LN1B + l * D, nullptr, XB + (size_t)m * D, nullptr, nullptr, nullptr, F.lane, STAT + 2 * (size_t)m);
#pragma unroll
                  for (int j = 0; j < 8; ++j) va[j] = vb[j]; } }
        }
        SEAM(pb + 6);
        if (IN(pb + 7)) {
            LAYER_CTX
            pg8::GemmStd<D, D, D> g{XB, (const bf16_t*)(wl + WL_GU)}; pg8::StaticOrder<T, 2 * FF> S; S.init(F.G, F.bid); pg8::EpiSwiglu E{HFF};
            pg8::gemm_phase(F.lds, g, S, E, F.tid);
        }
        SEAM(pb + 7);
        if (IN(pb + 8)) {
            LAYER_CTX
            pg8::GemmStd<FF, FF, FF> g{HFF, (const bf16_t*)(wl + WL_DN)}; pg8::StaticOrder<T, D> S; S.init(F.G, F.bid); pg8::EpiResid E{PF, STAT, PAR + PAR_LN1G + l * D, PAR + PAR_LN1B + l * D};
            pg8::gemm_phase(F.lds, g, S, E, F.tid);
        }
        SEAM(pb + 8);
        if (IN(pb + 9)) {
            LAYER_CTX
            const bool lastl = (l == DEPTH - 1);
            if (!lastl) load_gate_w(F, WG + (size_t)(l + 1) * 8 * D);
            { f32x4 va[8], vb[8]; int m = F.gw; row_load(PF + (size_t)m * D, va, F.lane);
              for (; m < T; m += F.ngw) { const int mn = (m + F.ngw < T) ? m + F.ngw : m; row_load(PF + (size_t)mn * D, vb, F.lane);
                  row_finish(va, true, PAR + PAR_LN2G + l * D, PAR + PAR_LN2B + l * D, lastl ? args.out + (size_t)m * D : nullptr, lastl ? nullptr : XB + (size_t)m * D,
                             (const LAS float*)F.lds, lastl ? nullptr : PAR + PAR_GBIAS + (l + 1) * 8, lastl ? nullptr : GATES + (size_t)m * 8, F.lane, STAT + 2 * (size_t)m);
#pragma unroll
                  for (int j = 0; j < 8; ++j) va[j] = vb[j]; } }
            __syncthreads();
        }
        if (lyr != DEPTH - 1) GRID_BAR();
    }
#undef IN
#undef SEAM
#undef GRID_BAR
#undef PHASE_CTX
#undef LAYER_CTX
#undef WG
#undef BIN
#undef GATES
#undef STAT
#undef MEMN
#undef KMEM
#undef VMEM
#undef WQK
#undef WQN
#undef BQK
#undef WKT
#undef WVT
#undef PAR
#undef XF
#undef PF
#undef XB
#undef Z
#undef HFF
#undef MRG
#undef HRAW
#undef QF
#undef KF
#undef PFR
#undef VF
#undef GS
#undef DEN
#undef VSTAT
#undef WIG
#undef WF32
#undef C2A
}

extern "C" void kernel_launch(void* const* d_in, const int* in_sizes, int n_in, void* d_out, int out_size, void* d_ws, size_t ws_size, hipStream_t stream) {
    static int grid = 0;
    if (grid == 0) {
        if (n_in != 24 || out_size != T * D || ws_size < WS_END) { fprintf(stderr, "kernel_launch: unexpected shapes (n_in %d, out %d, ws %zu < %zu)\n", n_in, out_size, ws_size, (size_t)WS_END); grid = -1; return; }
        int dev = 0, cus = 0, per_cu = 0;
        if (hipGetDevice(&dev) != hipSuccess || hipDeviceGetAttribute(&cus, hipDeviceAttributeMultiprocessorCount, dev) != hipSuccess) { grid = -1; return; }
        if (hipFuncSetAttribute((const void*)fwd_kernel, hipFuncAttributeMaxDynamicSharedMemorySize, LDS_BYTES) != hipSuccess) { fprintf(stderr, "kernel_launch: hipFuncSetAttribute failed\n"); grid = -1; return; }
        if (hipOccupancyMaxActiveBlocksPerMultiprocessor(&per_cu, (const void*)fwd_kernel, 512, LDS_BYTES) != hipSuccess || per_cu < 1) fprintf(stderr, "kernel_launch: occupancy query says %d\n", per_cu);
        (void)hipGetLastError();
        grid = cus;
    }
    if (grid < 0) return;
    (void)hipMemsetAsync((char*)d_ws + WS_CTL, 0, CTL_ZERO_BYTES, stream);
    Args a{};
    for (int i = 0; i < 24; ++i) a.in[i] = (const float*)d_in[i];
    a.out = (float*)d_out; a.ws = (unsigned char*)d_ws;
    constexpr int NPH = 2 + 10 * DEPTH;
#if MK_PER_PHASE
    for (int p = 0; p < NPH; ++p) { a.ph_lo = p; a.ph_hi = p + 1; hipLaunchKernelGGL(fwd_kernel, dim3(grid), dim3(512), LDS_BYTES, stream, a); }
#else
    a.ph_lo = 0; a.ph_hi = NPH;
    hipLaunchKernelGGL(fwd_kernel, dim3(grid), dim3(512), LDS_BYTES, stream, a);
#endif
    const hipError_t le = hipPeekAtLastError();
    if (le != hipSuccess) fprintf(stderr, "kernel_launch: launch failed: %s\n", hipGetErrorName(le));
}
```

```cpp
#include <hip/hip_runtime.h>
#include <cstdio>
#include <cstdint>

#ifndef MK_PER_PHASE
#define MK_PER_PHASE 0
#endif

#define LAS __attribute__((address_space(3)))
#define GAS __attribute__((address_space(1)))
typedef unsigned short bf16_t;
typedef short bf16x8 __attribute__((ext_vector_type(8)));
typedef float f32x4 __attribute__((ext_vector_type(4)));
typedef float f32x2 __attribute__((ext_vector_type(2)));
typedef unsigned u32x4 __attribute__((ext_vector_type(4)));
typedef unsigned u32x2 __attribute__((ext_vector_type(2)));

constexpr int T = 16384, D = 2048, SEQ = 4096, NBATCH = 4, DEPTH = 4, MEMLEN = 256;
constexpr int INW = 15368, ZW = 15360, FF = 5632;
constexpr int ZU = 0, ZV = 1024, ZQK = 2048, ZVM = 4096, ZO = 6144, ZQX = 8192, ZG = 9216;
constexpr int SRC_GATE = 8192;
constexpr float LN_EPS = 1e-5f;
constexpr float ALPHA = 1.681792830507429f;

constexpr size_t MiB = 1u << 20;
constexpr size_t WS_CTL = 0, CTL_ZERO_BYTES = 1 * MiB;
constexpr size_t WS_WG = 1 * MiB;
constexpr size_t WS_BIN = 2 * MiB;
constexpr size_t WS_GATES = 3 * MiB;
constexpr size_t WS_STAT = 3 * MiB + 512 * 1024;
constexpr size_t WS_MEMN = 4 * MiB;
constexpr size_t WS_KMEM = 8 * MiB;
constexpr size_t WS_VMEM = 16 * MiB;
constexpr size_t WS_PAR = 24 * MiB;
constexpr int PAR_GWS = 0, PAR_GLNG = 524288, PAR_GLNB = 528384, PAR_GBS = 532480, PAR_CONVW = 536576, PAR_CONVB = 569344, PAR_MNG = 577536,
              PAR_LN1G = 585728, PAR_LN1B = 593920, PAR_LN2G = 602112, PAR_LN2B = 610304, PAR_GBIAS = 618496, PAR_ONE = 618528, PAR_ZERO = 620576, PAR_BQ = 622624, PAR_END = 626720;
constexpr size_t WS_WF32 = 28 * MiB;
constexpr size_t WS_C2 = 30 * MiB;
constexpr size_t WS_WKT = 32 * MiB;
constexpr size_t WS_WVT = 48 * MiB;
constexpr size_t WS_WL = 64 * MiB;
constexpr size_t WL_STRIDE = 150 * MiB;
constexpr size_t WL_IN = 0, WL_GU = 60 * MiB, WL_DN = 104 * MiB, WL_PA = 126 * MiB, WL_PB = 130 * MiB, WL_PC = 138 * MiB, WL_OUT = 142 * MiB;
constexpr size_t WS_XF = 664 * MiB;
constexpr size_t WS_PF = 792 * MiB;
constexpr size_t WS_XB = 920 * MiB;
constexpr size_t WS_Z = 984 * MiB;
constexpr size_t WS_MRG = 1464 * MiB;
constexpr size_t WS_WQK = 1528 * MiB;
constexpr size_t WS_VW01 = 1592 * MiB;
constexpr size_t WS_VW23 = 32 * MiB;
constexpr size_t WS_WQN = 984 * MiB;
constexpr size_t WS_BQK = 3 * MiB + 768 * 1024;
constexpr size_t WS_HRAW = 1624 * MiB;
constexpr size_t WS_QF = 1752 * MiB;
constexpr size_t WS_KF = 1784 * MiB;
constexpr size_t WS_PFR = 1816 * MiB;
constexpr size_t WS_VF = 1824 * MiB;
constexpr size_t WS_GS = 1888 * MiB;
constexpr int GS_BCUM = 0, GS_BV = 65536, GS_PMAX = 131072, GS_BLAST = 196608, GS_MAXB = 197632, GS_MPREV = 198656;
constexpr size_t WS_VSTAT = 1889 * MiB;
constexpr size_t WS_DEN = 1890 * MiB;
constexpr size_t WS_WIG = 1893 * MiB;
constexpr size_t WS_DUMMY = 1891 * MiB;
constexpr size_t WS_END = 1894 * MiB;
static_assert(WL_OUT + 8 * MiB == WL_STRIDE && WS_WL + 4 * WL_STRIDE == WS_XF, "weights map");

constexpr int CW_BAR = 4096;

constexpr int LDS_BYTES = 163840;
constexpr int RING_BYTES = 131072;
constexpr int MISC_OFF = LDS_BYTES - 256;

__device__ __forceinline__ unsigned f2bf(float f) { unsigned u = __builtin_bit_cast(unsigned, f); return (u + 0x7fffu + ((u >> 16) & 1u)) >> 16; }
__device__ __forceinline__ unsigned pk2(float lo, float hi) { return f2bf(lo) | (f2bf(hi) << 16); }
__device__ __forceinline__ float bf2f(unsigned b) { return __builtin_bit_cast(float, b << 16); }
__device__ __forceinline__ float bflo(unsigned w) { return __builtin_bit_cast(float, w << 16); }
__device__ __forceinline__ float bfhi(unsigned w) { return __builtin_bit_cast(float, w & 0xffff0000u); }
typedef __bf16 bf16x2_t __attribute__((ext_vector_type(2)));
__device__ __forceinline__ unsigned cvt_pk_bf16(float lo, float hi) { const f32x2 v = {lo, hi}; const bf16x2_t b = __builtin_convertvector(v, bf16x2_t); return __builtin_bit_cast(unsigned, b); }
__device__ __forceinline__ float fast_sigmoid(float x) { return __builtin_amdgcn_rcpf(1.0f + __builtin_amdgcn_exp2f(-1.4426950408889634f * x)); }
__device__ __forceinline__ float gelu_tanh(float v) { const float y = 1.5957691216057308f * (v + 0.044715f * v * v * v); return v * fast_sigmoid(y); }
__device__ __forceinline__ float shx(float v, int o, int lane) { return __builtin_bit_cast(float, __builtin_amdgcn_ds_bpermute((lane ^ o) << 2, __builtin_bit_cast(int, v))); }
__device__ __forceinline__ float shup(float v, int o, int lane) { return __builtin_bit_cast(float, __builtin_amdgcn_ds_bpermute((lane - o) << 2, __builtin_bit_cast(int, v))); }
__device__ __forceinline__ float rdlane(float v, int l) { return __builtin_bit_cast(float, __builtin_amdgcn_readlane(__builtin_bit_cast(int, v), l)); }
__device__ __forceinline__ f32x4 scale4(f32x4 v, float s) { asm volatile("v_mul_f32 %0, %0, %4\n\tv_mul_f32 %1, %1, %4\n\tv_mul_f32 %2, %2, %4\n\tv_mul_f32 %3, %3, %4" : "+v"(v[0]), "+v"(v[1]), "+v"(v[2]), "+v"(v[3]) : "v"(s)); return v; }
__device__ __forceinline__ bf16x8 pack8(f32x4 a, f32x4 b) { u32x4 o; o.x = cvt_pk_bf16(a[0], a[1]); o.y = cvt_pk_bf16(a[2], a[3]); o.z = cvt_pk_bf16(b[0], b[1]); o.w = cvt_pk_bf16(b[2], b[3]); return __builtin_bit_cast(bf16x8, o); }
__device__ __forceinline__ f32x4 mfma16(bf16x8 a, bf16x8 b, f32x4 c) { return __builtin_amdgcn_mfma_f32_16x16x32_bf16(a, b, c, 0, 0, 0); }
template <int CTRL> __device__ __forceinline__ float dpp_f(float v) { return __builtin_bit_cast(float, __builtin_amdgcn_update_dpp(0, __builtin_bit_cast(int, v), CTRL, 0xf, 0xf, true)); }
__device__ __forceinline__ float wave_sum(float v, int lane) {
    v += dpp_f<0xB1>(v); v += dpp_f<0x4E>(v); v += dpp_f<0x141>(v); v += dpp_f<0x140>(v);
    v += shx(v, 16, lane); v += shx(v, 32, lane);
    return v;
}
__device__ __forceinline__ float wave_max(float v, int lane) {
    v = fmaxf(v, dpp_f<0xB1>(v)); v = fmaxf(v, dpp_f<0x4E>(v)); v = fmaxf(v, dpp_f<0x141>(v)); v = fmaxf(v, dpp_f<0x140>(v));
    v = fmaxf(v, shx(v, 16, lane)); v = fmaxf(v, shx(v, 32, lane));
    return v;
}
#define LDS_WAIT() asm volatile("s_waitcnt lgkmcnt(0)" ::: "memory")
#define VM_WAIT() asm volatile("s_waitcnt vmcnt(0)" ::: "memory")

#define XB_TMO      128
#define XB_XCNT(j)  (256  + 64 * (j))
#define XB_XSUB(j)  (1280 + 64 * (j))
#define XB_XGEN(j)  (2304 + 64 * (j))
#define XB_TOP      3328
#define XB_TOPGEN   3392
#define XCD_BAR_WORDS 3456
#define XB_SPIN_CAP (1u << 22)
__device__ __forceinline__ unsigned xb_ld(unsigned* p)              { return __hip_atomic_load(p, __ATOMIC_RELAXED, __HIP_MEMORY_SCOPE_AGENT); }
__device__ __forceinline__ unsigned xb_add(unsigned* p, unsigned v) { return __hip_atomic_fetch_add(p, v, __ATOMIC_RELAXED, __HIP_MEMORY_SCOPE_AGENT); }
__device__ __forceinline__ unsigned xb_xcc_id() { return (unsigned)__builtin_amdgcn_s_getreg((3 << 11) | 20) & 0xFu; }
#define XB_SPIN(cond, bar) do { unsigned _sp = 0; while (cond) { __builtin_amdgcn_s_sleep(1); \
    if ((++_sp & 255u) == 0u) { if (xb_ld(&(bar)[XB_TMO])) break; if (_sp > XB_SPIN_CAP) { atomicAdd(&(bar)[XB_TMO], 1u); break; } } } } while (0)
__device__ __forceinline__ int fresh_tid(const int wv) { int l_; asm volatile("v_mbcnt_lo_u32_b32 %0, -1, 0\n\tv_mbcnt_hi_u32_b32 %0, -1, %0" : "=v"(l_)); return wv * 64 + l_; }
struct XcdBarrier { unsigned* bar; unsigned x; volatile LAS unsigned* st; };
__device__ __forceinline__ XcdBarrier xcd_barrier_post(unsigned* bar, volatile LAS unsigned* st) {
    XcdBarrier b; b.bar = bar; b.x = xb_xcc_id(); b.st = st;
    if (threadIdx.x == 0) (void)xb_add(&bar[XB_XCNT(b.x)], 1u);
    return b;
}
__device__ __forceinline__ void xcd_barrier_complete(unsigned* bar, unsigned x, unsigned& nloc, unsigned& nx) {
    const unsigned G = gridDim.x * gridDim.y * gridDim.z;
    unsigned sum, cnt, mine, sp = 0u;
    for (;;) {
        sum = 0u; cnt = 0u; mine = 0u;
#pragma unroll
        for (unsigned j = 0; j < 16; ++j) { const unsigned c = xb_ld(&bar[XB_XCNT(j)]); sum += c; cnt += (c > 0u) ? 1u : 0u; mine = (j == x) ? c : mine; }
        if (sum == G) break;
        __builtin_amdgcn_s_sleep(1);
        if ((++sp & 255u) == 0u) { if (xb_ld(&bar[XB_TMO])) break; if (sp > XB_SPIN_CAP) { atomicAdd(&bar[XB_TMO], 1u); break; } }
    }
    nloc = mine > 0u ? mine : 1u; nx = cnt > 0u ? cnt : 1u;
}
__device__ __forceinline__ void xcd_barrier(const XcdBarrier& b, const int tid_) {
    asm volatile("s_waitcnt vmcnt(0)" ::: "memory");
    __syncthreads();
    if (tid_ == 0) {
        unsigned* bar = b.bar;
        __builtin_amdgcn_s_waitcnt(0);
        unsigned nloc = b.st[0], nx = b.st[1];
        if (nloc == 0u) { xcd_barrier_complete(bar, b.x, nloc, nx); b.st[0] = nloc; b.st[1] = nx; }
        const unsigned old = xb_add(&bar[XB_XSUB(b.x)], 1u);
        const unsigned gen = old / nloc;
        if (old + 1u == (gen + 1u) * nloc) {
            __builtin_amdgcn_fence(__ATOMIC_RELEASE, "agent");
            asm volatile("s_waitcnt vmcnt(0)" ::: "memory");
            const unsigned og = xb_add(&bar[XB_TOP], 1u);
            const unsigned tg = og / nx;
            if (og + 1u == (tg + 1u) * nx) xb_add(&bar[XB_TOPGEN], 1u);
            else XB_SPIN(xb_ld(&bar[XB_TOPGEN]) == tg, bar);
            __builtin_amdgcn_fence(__ATOMIC_ACQUIRE, "agent");
            xb_add(&bar[XB_XGEN(b.x)], 1u);
            asm volatile("s_waitcnt vmcnt(0)" ::: "memory");
        } else {
            XB_SPIN(xb_ld(&bar[XB_XGEN(b.x)]) == gen, bar);
            __builtin_amdgcn_fence(__ATOMIC_ACQUIRE, "agent");
            asm volatile("s_waitcnt vmcnt(0)" ::: "memory");
        }
    }
    __syncthreads();
}

namespace pg8 {
constexpr int BM = 256, BK = 64, HALF = 128, HTB = HALF * BK * 2, STAGE_BYTES = 8 * HTB, NXCD = 8, WGM = 8;
__host__ __device__ __forceinline__ int lds_byte(int r, int c) { const int st = (r >> 4) * 2 + (c >> 5), rr = r & 15, cc = c & 31, ob = rr * 64 + cc * 2; return st * 1024 + (ob ^ (((ob >> 9) & 1) << 5)); }
__host__ __device__ __forceinline__ void stage_rc(int b, int& R, int& C) { const int st = b / 1024, sb = b % 1024, swz = sb ^ (((sb >> 9) & 1) << 5); R = (st >> 1) * 16 + swz / 64; C = (st & 1) * 32 + (swz % 64) / 2; }
__host__ __device__ __forceinline__ int perm32(int rho) { const int n = rho >> 4, i = rho & 15; return 8 * (i >> 2) + 4 * n + (i & 3); }
struct Unit { int pm, pn; };
template <int LDA_, int LDB_, int K_, long A_PM, long A_PN, long B_PB, long B_PN> struct GemmT { const bf16_t* A; const bf16_t* Bt;
    static constexpr int lda = LDA_, ldb = LDB_, K = K_;
    __device__ __forceinline__ const char* a_ptr(const Unit& u) const { return (const char*)(A + (size_t)((long)u.pm * A_PM + (long)u.pn * A_PN)); }
    __device__ __forceinline__ const char* b_ptr(const Unit& u) const { return (const char*)(Bt + (size_t)((long)(u.pm >> 4) * B_PB + (long)u.pn * B_PN)); } };
template <int LDA_, int LDB_, int K_> using GemmStd = GemmT<LDA_, LDB_, K_, 256L * LDA_, 0L, 0L, 256L * LDB_>;
template <int M_, int N_, int WGM_ = WGM> struct StaticOrder {
    static constexpr int nM = M_ / BM, nN = N_ / BM, nwg = nM * nN;
    int G, c;
    __device__ __forceinline__ void init(int G_, int c_) { G = G_; c = c_; }
    __device__ __forceinline__ bool next(int i, Unit& u) const {
        const int L = i * G + c; if (L >= nwg) return false;
        int wgid = L; { constexpr int q = nwg / NXCD, r = nwg % NXCD; const int xcd = wgid % NXCD, off = wgid / NXCD; wgid = (xcd < r ? xcd * (q + 1) : r * (q + 1) + (xcd - r) * q) + off; }
        constexpr int nig = WGM_ * nN; const int gid = wgid / nig, fm = gid * WGM_, gsz = (nM - fm) < WGM_ ? (nM - fm) : WGM_;
        u.pm = fm + ((wgid % nig) % gsz); u.pn = (wgid % nig) / gsz; return true;
    }
};
template <int M_, int N_, int WGM_, int ROT_> struct RotOrder { StaticOrder<M_, N_, WGM_> S;
    __device__ __forceinline__ void init(int G_, int c_) { S.init(G_, c_); }
    __device__ __forceinline__ bool next(int i, Unit& u) const { const bool ok = S.next(i, u); const int p = u.pn + ROT_; u.pn = p >= N_ / BM ? p - N_ / BM : p; return ok; } };
template <int M_, int N_, int WGM_> struct RevOrder { StaticOrder<M_, N_, WGM_> S;
    __device__ __forceinline__ void init(int G_, int c_) { S.init(G_, c_); }
    __device__ __forceinline__ bool next(int i, Unit& u) const { const bool ok = S.next(i, u); u.pn = N_ / BM - 1 - u.pn; return ok; } };
template <class Epi, class GemmD, class Sched>
__device__ __forceinline__ void gemm_phase(LAS unsigned char* lds, const GemmD g, const Sched& S, const Epi& E, int tid) {
    asm volatile("" : "+v"(tid));
    const int wid = __builtin_amdgcn_readfirstlane(tid >> 6), lane = tid & 63, wr = wid >> 2, wc = wid & 3, fr = lane & 15, fq = lane >> 4;
    constexpr int K = GemmD::K, nt = K / BK;
    unsigned voffA[2], voffB[2];
#pragma unroll
    for (int i = 0; i < 2; ++i) { int R, C; stage_rc(tid * 16 + i * 8192, R, C); const int Rb = (R & ~31) + perm32(R & 31);
        voffA[i] = (unsigned)(R * GemmD::lda + C) * 2u; voffB[i] = (unsigned)(Rb * GemmD::ldb + C) * 2u; }
    constexpr size_t kstep = (size_t)(BK * 2);
    constexpr size_t hA = (size_t)HALF * GemmD::lda * 2, hB = (size_t)HALF * GemmD::ldb * 2;
    const unsigned ldsw = (unsigned)wid * 1024u;
    const int aoff = lds_byte(wr * 64 + fr, fq * 8), boff = lds_byte(wc * 32 + fr, fq * 8);
#define PG8_SA(b, h) (((b) * 2 + (h)) * HTB)
#define PG8_SB(b, h) ((4 + (b) * 2 + (h)) * HTB)
#define PG8_STAGE(bufoff, gbase, voff) do { _Pragma("unroll") for (int _i = 0; _i < 2; ++_i) \
        __builtin_amdgcn_global_load_lds((const unsigned*)((const char*)(gbase) + (voff)[_i]), (LAS unsigned*)(lds + (bufoff) + ldsw + _i * 8192), 16, 0, 0); } while (0)
#define PG8_LDA(dst, b, h) do { _Pragma("unroll") for (int m = 0; m < 4; ++m) _Pragma("unroll") for (int k = 0; k < 2; ++k) dst[m][k] = *(const LAS bf16x8*)(lds + PG8_SA(b, h) + aoff + m * 2048 + k * 1024); } while (0)
#define PG8_LDB(dst, b, h) do { _Pragma("unroll") for (int n = 0; n < 2; ++n) _Pragma("unroll") for (int k = 0; k < 2; ++k) dst[n][k] = *(const LAS bf16x8*)(lds + PG8_SB(b, h) + boff + n * 2048 + k * 1024); } while (0)
#define PG8_MMA(ai, bj, At, Bt) do { __builtin_amdgcn_s_setprio(1); _Pragma("unroll") for (int m = 0; m < 4; ++m) _Pragma("unroll") for (int n = 0; n < 2; ++n) _Pragma("unroll") for (int k = 0; k < 2; ++k) \
        acc[ai][bj][m][n] = __builtin_amdgcn_mfma_f32_16x16x32_bf16(Bt[n][k], At[m][k], acc[ai][bj][m][n], 0, 0, 0); __builtin_amdgcn_s_setprio(0); } while (0)
#define PG8_WAIT_V(n) asm volatile("s_waitcnt vmcnt(" #n ")" ::: "memory")
#define PG8_WAIT_L(n) asm volatile("s_waitcnt lgkmcnt(" #n ")" ::: "memory")
#define PG8_BAR __builtin_amdgcn_s_barrier()
#define PG8_SCHED __builtin_amdgcn_sched_barrier(0)
    Unit cur, nxt; int ui = 0;
    if (!S.next(0, cur)) return;
    f32x4 acc[2][2][4][2];
#pragma unroll
    for (int a = 0; a < 2; ++a)
#pragma unroll
        for (int b = 0; b < 2; ++b)
#pragma unroll
            for (int m = 0; m < 4; ++m)
#pragma unroll
                for (int n = 0; n < 2; ++n) acc[a][b][m][n] = (f32x4){0.f, 0.f, 0.f, 0.f};
    bf16x8 At[4][2], B0[2][2], B1[2][2];
    const char* cA = g.a_ptr(cur); const char* cB = g.b_ptr(cur);
    PG8_STAGE(PG8_SB(0, 0), cB, voffB); PG8_STAGE(PG8_SB(0, 1), cB + hB, voffB); PG8_STAGE(PG8_SA(0, 0), cA, voffA); PG8_STAGE(PG8_SA(0, 1), cA + hA, voffA);
    if (wr == 1) PG8_BAR;
    PG8_WAIT_V(2); PG8_BAR;
    PG8_STAGE(PG8_SB(1, 0), cB + kstep, voffB); PG8_STAGE(PG8_SA(1, 0), cA + kstep, voffA); PG8_STAGE(PG8_SB(1, 1), cB + hB + kstep, voffB);
    PG8_WAIT_V(6); PG8_BAR;
    for (;;) {
        const bool has_next = S.next(ui + 1, nxt);
        const char* nA = has_next ? g.a_ptr(nxt) : cA; const char* nB = has_next ? g.b_ptr(nxt) : cB;
#pragma nounroll
        for (int t = 0; t < nt; t += 2) {
            const bool last = (t == nt - 2);
            const char* a1 = cA + (size_t)(t + 1) * kstep;
            const char* a2 = last ? nA : cA + (size_t)(t + 2) * kstep; const char* b2 = last ? nB : cB + (size_t)(t + 2) * kstep;
            const char* a3 = a2 + kstep; const char* b3 = b2 + kstep;
            PG8_LDB(B0, 0, 0); PG8_LDB(B1, 0, 1); PG8_SCHED; PG8_LDA(At, 0, 0); PG8_STAGE(PG8_SA(1, 1), a1 + hA, voffA);
            PG8_WAIT_V(8); PG8_WAIT_L(0); PG8_BAR; PG8_MMA(0, 0, At, B0); PG8_MMA(0, 1, At, B1); PG8_BAR; PG8_SCHED;
            PG8_LDA(At, 0, 1); PG8_STAGE(PG8_SB(0, 0), b2, voffB); PG8_STAGE(PG8_SB(0, 1), b2 + hB, voffB); PG8_STAGE(PG8_SA(0, 0), a2, voffA);
            PG8_WAIT_V(8); PG8_WAIT_L(0); PG8_BAR; PG8_MMA(1, 0, At, B0); PG8_MMA(1, 1, At, B1); PG8_BAR; PG8_SCHED;
            PG8_LDB(B0, 1, 0); PG8_LDB(B1, 1, 1); PG8_SCHED; PG8_LDA(At, 1, 0); PG8_STAGE(PG8_SA(0, 1), a2 + hA, voffA);
            PG8_WAIT_V(8); PG8_WAIT_L(0); PG8_BAR; PG8_MMA(0, 0, At, B0); PG8_MMA(0, 1, At, B1); PG8_BAR; PG8_SCHED;
            PG8_LDA(At, 1, 1); PG8_STAGE(PG8_SB(1, 0), b3, voffB); PG8_STAGE(PG8_SB(1, 1), b3 + hB, voffB); PG8_STAGE(PG8_SA(1, 0), a3, voffA);
            PG8_WAIT_V(8); PG8_WAIT_L(0); PG8_BAR; PG8_MMA(1, 0, At, B0); PG8_MMA(1, 1, At, B1); PG8_BAR; PG8_SCHED;
        }
        if (wr == 0) PG8_BAR;
        E(acc, cur, wr, wc, fr, fq);
        if (!has_next) break;
#pragma unroll
        for (int a = 0; a < 2; ++a)
#pragma unroll
            for (int b = 0; b < 2; ++b)
#pragma unroll
                for (int m = 0; m < 4; ++m)
#pragma unroll
                    for (int n = 0; n < 2; ++n) acc[a][b][m][n] = (f32x4){0.f, 0.f, 0.f, 0.f};
        cur = nxt; cA = nA; cB = nB; ++ui;
        if (wr == 1) PG8_BAR;
    }
    PG8_WAIT_V(0);
    PG8_BAR;
#undef PG8_SA
#undef PG8_SB
#undef PG8_STAGE
#undef PG8_LDA
#undef PG8_LDB
#undef PG8_MMA
#undef PG8_WAIT_V
#undef PG8_WAIT_L
#undef PG8_BAR
#undef PG8_SCHED
}

typedef f32x4 Acc[2][2][4][2];
struct EpiIn { bf16_t* Z; const float* bias; const float* bqk; LAS float* red;
    __device__ __forceinline__ void operator()(Acc& acc, const Unit& u, int wr, int wc, int fr, int fq) const {
        const int pn = u.pn; const int act = (pn < 8) ? 1 : (pn < 24) ? 0 : (pn < 32) ? 2 : (pn < 36) ? 3 : 2;
        const int row0 = u.pm * BM + wr * 64 + fr, col0 = pn * BM + wc * 32 + 8 * fq;
        if (act == 3) {
            const int lane = fq * 16 + fr; const float* bp = bqk + (u.pm >> 4) * 1024 + (pn - 32) * BM + wc * 32 + 8 * fq;
            LAS float* RM = red; LAS float* RS = red + 1024;
#pragma unroll
            for (int bj = 0; bj < 2; ++bj) { const f32x4 b0 = *(const f32x4*)(bp + bj * HALF), b1 = *(const f32x4*)(bp + bj * HALF + 4);
#pragma unroll
                for (int ai = 0; ai < 2; ++ai)
#pragma unroll
                    for (int m = 0; m < 4; ++m) { acc[ai][bj][m][0] += b0; acc[ai][bj][m][1] += b1; } }
#pragma unroll
            for (int ai = 0; ai < 2; ++ai)
#pragma unroll
                for (int m = 0; m < 4; ++m) { float mx = -3.0e38f;
#pragma unroll
                    for (int bj = 0; bj < 2; ++bj)
#pragma unroll
                        for (int n = 0; n < 2; ++n) { const f32x4 v = acc[ai][bj][m][n]; mx = fmaxf(mx, fmaxf(fmaxf(v[0], v[1]), fmaxf(v[2], v[3]))); }
                    mx = fmaxf(mx, shx(mx, 16, lane)); mx = fmaxf(mx, shx(mx, 32, lane));
                    if (fq == 0) RM[(ai * HALF + wr * 64 + m * 16 + fr) * 4 + wc] = mx; }
            asm volatile("s_waitcnt lgkmcnt(0)" ::: "memory"); __builtin_amdgcn_s_barrier(); asm volatile("" ::: "memory");
#pragma unroll
            for (int ai = 0; ai < 2; ++ai)
#pragma unroll
                for (int m = 0; m < 4; ++m) { const f32x4 m4 = *(const LAS f32x4*)(RM + (ai * HALF + wr * 64 + m * 16 + fr) * 4); const float mx = fmaxf(fmaxf(m4[0], m4[1]), fmaxf(m4[2], m4[3])); float sm = 0.f;
#pragma unroll
                    for (int bj = 0; bj < 2; ++bj)
#pragma unroll
                        for (int n = 0; n < 2; ++n) { f32x4 v = acc[ai][bj][m][n];
#pragma unroll
                            for (int j = 0; j < 4; ++j) { v[j] = __builtin_amdgcn_exp2f(v[j] - mx); sm += v[j]; }
                            acc[ai][bj][m][n] = v; }
                    sm += shx(sm, 16, lane); sm += shx(sm, 32, lane);
                    if (fq == 0) RS[(ai * HALF + wr * 64 + m * 16 + fr) * 4 + wc] = sm; }
            asm volatile("s_waitcnt lgkmcnt(0)" ::: "memory"); __builtin_amdgcn_s_barrier(); asm volatile("" ::: "memory");
#pragma unroll
            for (int ai = 0; ai < 2; ++ai)
#pragma unroll
                for (int m = 0; m < 4; ++m) { const f32x4 s4 = *(const LAS f32x4*)(RS + (ai * HALF + wr * 64 + m * 16 + fr) * 4); const float inv = 1.f / ((s4[0] + s4[1]) + (s4[2] + s4[3]));
                    bf16_t* rowp = Z + (size_t)(row0 + ai * HALF + m * 16) * ZW + col0;
#pragma unroll
                    for (int bj = 0; bj < 2; ++bj) { const f32x4 v0 = acc[ai][bj][m][0] * inv, v1 = acc[ai][bj][m][1] * inv;
                        u32x4 w; w.x = cvt_pk_bf16(v0[0], v0[1]); w.y = cvt_pk_bf16(v0[2], v0[3]); w.z = cvt_pk_bf16(v1[0], v1[1]); w.w = cvt_pk_bf16(v1[2], v1[3]);
                        *(u32x4*)(rowp + bj * HALF) = w; } }
            return;
        }
#pragma unroll
        for (int bj = 0; bj < 2; ++bj) {
            const f32x4 b0 = *(const f32x4*)(bias + col0 + bj * HALF), b1 = *(const f32x4*)(bias + col0 + bj * HALF + 4);
#pragma unroll
            for (int ai = 0; ai < 2; ++ai)
#pragma unroll
                for (int m = 0; m < 4; ++m) { bf16_t* rowp = Z + (size_t)(row0 + ai * HALF + m * 16) * ZW + col0 + bj * HALF;
                    f32x4 v0 = acc[ai][bj][m][0] + b0, v1 = acc[ai][bj][m][1] + b1;
                    if (act == 1) {
#pragma unroll
                        for (int j = 0; j < 4; ++j) { v0[j] = gelu_tanh(v0[j]); v1[j] = gelu_tanh(v1[j]); } }
                    else if (act == 2) {
#pragma unroll
                        for (int j = 0; j < 4; ++j) { v0[j] = fast_sigmoid(v0[j]); v1[j] = fast_sigmoid(v1[j]); } }
                    u32x4 w; w.x = cvt_pk_bf16(v0[0], v0[1]); w.y = cvt_pk_bf16(v0[2], v0[3]); w.z = cvt_pk_bf16(v1[0], v1[1]); w.w = cvt_pk_bf16(v1[2], v1[3]);
                    *(u32x4*)rowp = w; }
        }
    }
};
__device__ __forceinline__ void store_tile_bf16(const Acc& acc, bf16_t* base, int ldc, float sc, int wr, int wc, int fr, int fq) {
#pragma unroll
    for (int ai = 0; ai < 2; ++ai)
#pragma unroll
        for (int m = 0; m < 4; ++m) { bf16_t* rowp = base + (size_t)(wr * 64 + fr + ai * HALF + m * 16) * ldc + wc * 32 + 8 * fq;
#pragma unroll
            for (int bj = 0; bj < 2; ++bj) { const f32x4 v0 = acc[ai][bj][m][0] * sc, v1 = acc[ai][bj][m][1] * sc;
                u32x4 w; w.x = cvt_pk_bf16(v0[0], v0[1]); w.y = cvt_pk_bf16(v0[2], v0[3]); w.z = cvt_pk_bf16(v1[0], v1[1]); w.w = cvt_pk_bf16(v1[2], v1[3]);
                *(u32x4*)(rowp + bj * HALF) = w; } }
}
constexpr float SCORE_SCALE = 0.0625f * 1.4426950408889634f;
struct GemmQK { const bf16_t* Km; const bf16_t* Wqn; static constexpr int lda = 4096, ldb = 1024, K = 256;
    __device__ __forceinline__ const char* a_ptr(const Unit& u) const { return (const char*)(Km + (size_t)(u.pm & 3) * 256 * 4096 + (size_t)(u.pm >> 2) * 256); }
    __device__ __forceinline__ const char* b_ptr(const Unit& u) const { return (const char*)(Wqn + (size_t)(u.pm >> 4) * 2048 * 1024 + (size_t)((u.pm >> 2) & 3) * 256 + (size_t)u.pn * 256 * 1024); } };
struct EpiQK { bf16_t* O;
    __device__ __forceinline__ void operator()(const Acc& acc, const Unit& u, int wr, int wc, int fr, int fq) const {
        store_tile_bf16(acc, O + ((size_t)((u.pm >> 4) * 4 + (u.pm & 3)) * 1024 + (size_t)((u.pm >> 2) & 3) * 256) * 2048 + (size_t)u.pn * 256, 2048, SCORE_SCALE, wr, wc, fr, fq); } };
struct GemmVW { const unsigned char* wl0; const bf16_t* Vm; static constexpr int lda = 1024, ldb = 4096, K = 256;
    __device__ __forceinline__ const char* a_ptr(const Unit& u) const { const int lbh = u.pm >> 3; return (const char*)((const bf16_t*)(wl0 + (size_t)(lbh >> 4) * WL_STRIDE + WL_PC) + (size_t)(u.pm & 7) * 256 * 1024 + (size_t)(lbh & 3) * 256); }
    __device__ __forceinline__ const char* b_ptr(const Unit& u) const { const int lbh = u.pm >> 3; return (const char*)(Vm + (size_t)((lbh >> 2) & 3) * 256 * 4096 + (size_t)(lbh >> 4) * 1024 + (size_t)(lbh & 3) * 256); } };
struct EpiVW { unsigned char* wsb;
    __device__ __forceinline__ void operator()(const Acc& acc, const Unit& u, int wr, int wc, int fr, int fq) const {
        const int lbh = u.pm >> 3, l = lbh >> 4, b = (lbh >> 2) & 3, h = lbh & 3;
        bf16_t* vw = (bf16_t*)(wsb + (l < 2 ? WS_VW01 + (size_t)l * 16 * MiB : WS_VW23 + (size_t)(l - 2) * 16 * MiB));
        store_tile_bf16(acc, vw + ((size_t)b * 2048 + (size_t)(u.pm & 7) * 256) * 1024 + h * 256, 1024, 1.0f, wr, wc, fr, fq); } };
struct GemmIn { const bf16_t* A; const bf16_t* W; const bf16_t* Wqk; static constexpr int lda = D, ldb = D, K = D;
    __device__ __forceinline__ const char* a_ptr(const Unit& u) const { return (const char*)(A + (size_t)u.pm * 256 * D); }
    __device__ __forceinline__ const char* b_ptr(const Unit& u) const { return (u.pn >= 32 && u.pn < 36) ? (const char*)(Wqk + ((size_t)(u.pm >> 4) * 1024 + (size_t)(u.pn - 32) * 256) * D) : (const char*)(W + (size_t)u.pn * 256 * D); } };
struct EpiF32 { float* C; int ldc;
    __device__ __forceinline__ void operator()(const Acc& acc, const Unit& u, int wr, int wc, int fr, int fq) const {
        const int row0 = u.pm * BM + wr * 64 + fr, col0 = u.pn * BM + wc * 32 + 8 * fq;
#pragma unroll
        for (int ai = 0; ai < 2; ++ai)
#pragma unroll
            for (int m = 0; m < 4; ++m) { float* rowp = C + (size_t)(row0 + ai * HALF + m * 16) * ldc + col0;
#pragma unroll
                for (int bj = 0; bj < 2; ++bj)
#pragma unroll
                    for (int n = 0; n < 2; ++n) *(f32x4*)(rowp + bj * HALF + 4 * n) = acc[ai][bj][m][n]; }
    }
};
struct EpiBf16 { bf16_t* O; int ldc;
    __device__ __forceinline__ void operator()(const Acc& acc, const Unit& u, int wr, int wc, int fr, int fq) const {
        const int row0 = u.pm * BM + wr * 64 + fr, col0 = u.pn * BM + wc * 32 + 8 * fq;
#pragma unroll
        for (int ai = 0; ai < 2; ++ai)
#pragma unroll
            for (int m = 0; m < 4; ++m) { bf16_t* rowp = O + (size_t)(row0 + ai * HALF + m * 16) * ldc + col0;
#pragma unroll
                for (int bj = 0; bj < 2; ++bj) { const f32x4 v0 = acc[ai][bj][m][0], v1 = acc[ai][bj][m][1];
                    u32x4 w; w.x = cvt_pk_bf16(v0[0], v0[1]); w.y = cvt_pk_bf16(v0[2], v0[3]); w.z = cvt_pk_bf16(v1[0], v1[1]); w.w = cvt_pk_bf16(v1[2], v1[3]);
                    *(u32x4*)(rowp + bj * HALF) = w; } }
    }
};
template <int MODE> struct EpiGate { const bf16_t* Gz; bf16_t* mrg;
    __device__ __forceinline__ void operator()(const Acc& acc, const Unit& u, int wr, int wc, int fr, int fq) const {
        const int row0 = u.pm * BM + wr * 64 + fr, col0 = u.pn * BM + wc * 32 + 8 * fq;
#pragma unroll
        for (int ai = 0; ai < 2; ++ai) {
            u32x4 gw[4][2], pw[4][2];
#pragma unroll
            for (int m = 0; m < 4; ++m) { const size_t r = (size_t)(row0 + ai * HALF + m * 16);
#pragma unroll
                for (int bj = 0; bj < 2; ++bj) { const int c = col0 + bj * HALF; gw[m][bj] = *(const u32x4*)(Gz + r * ZW + c); if (MODE != 0) pw[m][bj] = *(const u32x4*)(mrg + r * D + c); else pw[m][bj] = (u32x4){0u, 0u, 0u, 0u}; } }
            __builtin_amdgcn_sched_barrier(0);
#pragma unroll
            for (int m = 0; m < 4; ++m) { const size_t r = (size_t)(row0 + ai * HALF + m * 16);
#pragma unroll
                for (int bj = 0; bj < 2; ++bj) { const int c = col0 + bj * HALF; const u32x4 g4 = gw[m][bj];
                    f32x4 v0 = acc[ai][bj][m][0], v1 = acc[ai][bj][m][1];
                    v0[0] *= bflo(g4.x); v0[1] *= bfhi(g4.x); v0[2] *= bflo(g4.y); v0[3] *= bfhi(g4.y);
                    v1[0] *= bflo(g4.z); v1[1] *= bfhi(g4.z); v1[2] *= bflo(g4.w); v1[3] *= bfhi(g4.w);
                    if (MODE != 0) { const u32x4 p4 = pw[m][bj];
                        v0[0] += bflo(p4.x); v0[1] += bfhi(p4.x); v0[2] += bflo(p4.y); v0[3] += bfhi(p4.y); v1[0] += bflo(p4.z); v1[1] += bfhi(p4.z); v1[2] += bflo(p4.w); v1[3] += bfhi(p4.w); }
                    u32x4 w; w.x = cvt_pk_bf16(v0[0], v0[1]); w.y = cvt_pk_bf16(v0[2], v0[3]); w.z = cvt_pk_bf16(v1[0], v1[1]); w.w = cvt_pk_bf16(v1[2], v1[3]);
                    *(u32x4*)(mrg + r * D + c) = w; } }
            __builtin_amdgcn_sched_barrier(0);
        }
    }
};
struct EpiResid { float* P; const float* stat; const float* g; const float* b;
    __device__ __forceinline__ void operator()(const Acc& acc, const Unit& u, int wr, int wc, int fr, int fq) const {
        const int row0 = u.pm * BM + wr * 64 + fr, col0 = u.pn * BM + wc * 32 + 8 * fq;
        f32x4 g4[2][2], b4[2][2];
#pragma unroll
        for (int bj = 0; bj < 2; ++bj)
#pragma unroll
            for (int n = 0; n < 2; ++n) { const int c = col0 + bj * HALF + 4 * n; g4[bj][n] = *(const f32x4*)(g + c); b4[bj][n] = *(const f32x4*)(b + c); }
#pragma unroll
        for (int q = 0; q < 4; ++q) {
            const int ai = q >> 1, mb = (q & 1) * 2;
            f32x2 st[2]; f32x4 px[2][2][2];
#pragma unroll
            for (int mm = 0; mm < 2; ++mm) { const int row = row0 + ai * HALF + (mb + mm) * 16; const float* pp = P + (size_t)row * D + col0; st[mm] = *(const f32x2*)(stat + 2 * row);
#pragma unroll
                for (int bj = 0; bj < 2; ++bj)
#pragma unroll
                    for (int n = 0; n < 2; ++n) px[mm][bj][n] = *(const f32x4*)(pp + bj * HALF + 4 * n); }
            __builtin_amdgcn_sched_barrier(0);
#pragma unroll
            for (int mm = 0; mm < 2; ++mm) { const int row = row0 + ai * HALF + (mb + mm) * 16; float* pp = P + (size_t)row * D + col0;
#pragma unroll
                for (int bj = 0; bj < 2; ++bj)
#pragma unroll
                    for (int n = 0; n < 2; ++n) { const f32x4 x = (px[mm][bj][n] - st[mm].x) * st[mm].y * g4[bj][n] + b4[bj][n]; *(f32x4*)(pp + bj * HALF + 4 * n) = x * ALPHA + acc[ai][bj][mb + mm][n]; } }
            __builtin_amdgcn_sched_barrier(0);
        }
    }
};
struct EpiSwiglu { bf16_t* H;
    __device__ __forceinline__ void operator()(const Acc& acc, const Unit& u, int wr, int wc, int fr, int fq) const {
        const int row0 = u.pm * BM + wr * 64 + fr, col0 = u.pn * HALF + wc * 32 + 8 * fq;
#pragma unroll
        for (int ai = 0; ai < 2; ++ai)
#pragma unroll
            for (int m = 0; m < 4; ++m) { bf16_t* rowp = H + (size_t)(row0 + ai * HALF + m * 16) * FF + col0;
                f32x4 h0, h1;
#pragma unroll
                for (int j = 0; j < 4; ++j) { const float g0 = acc[ai][0][m][0][j], g1 = acc[ai][0][m][1][j];
                    h0[j] = g0 * fast_sigmoid(g0) * acc[ai][1][m][0][j]; h1[j] = g1 * fast_sigmoid(g1) * acc[ai][1][m][1][j]; }
                u32x4 w; w.x = cvt_pk_bf16(h0[0], h0[1]); w.y = cvt_pk_bf16(h0[2], h0[3]); w.z = cvt_pk_bf16(h1[0], h1[1]); w.w = cvt_pk_bf16(h1[2], h1[3]);
                *(u32x4*)rowp = w; }
    }
};
}

struct Args { const float* in[24]; float* out; unsigned char* ws; int ph_lo, ph_hi; };

struct Frame { LAS unsigned char* lds; int tid, lane, wave, gw, ngw, G, bid; };

__device__ __forceinline__ void transpose_tile(const float* src, size_t ldw, bf16_t* dst, size_t ldwt, LAS float* scr, int lane) {
    float tv[32];
#pragma unroll
    for (int i = 0; i < 32; ++i) tv[i] = src[(size_t)(2 * i + (lane >> 5)) * ldw + (lane & 31)];
#pragma unroll
    for (int i = 0; i < 32; ++i) scr[(2 * i + (lane >> 5)) * 33 + (lane & 31)] = tv[i];
    LDS_WAIT(); asm volatile("" ::: "memory");
    const int c = lane & 7;
#pragma unroll
    for (int j = 0; j < 4; ++j) { const int n = (lane >> 3) + 8 * j; const LAS float* s = scr + (8 * c) * 33 + n;
        u32x4 o; o.x = pk2(s[0 * 33], s[1 * 33]); o.y = pk2(s[2 * 33], s[3 * 33]); o.z = pk2(s[4 * 33], s[5 * 33]); o.w = pk2(s[6 * 33], s[7 * 33]);
        *(u32x4*)(dst + (size_t)n * ldwt + 8 * c) = o; }
    LDS_WAIT(); asm volatile("" ::: "memory");
}
__device__ __forceinline__ void transpose_item(const float* W, int ldw, int N, bf16_t* WT, int K, int item, LAS float* scr, int lane, int mode) {
    const int nblk = N / 32, kb = item / nblk, nb = item % nblk, k0 = 64 * kb, n0 = 32 * nb;
    int r0 = n0;
    if (mode == 1) { r0 = (n0 < FF) ? 256 * (n0 / 128) + (n0 % 128) : 256 * ((n0 - FF) / 128) + 128 + ((n0 - FF) % 128); }
    transpose_tile(W + (size_t)k0 * ldw + n0, (size_t)ldw, WT + (size_t)r0 * K + k0, (size_t)K, scr, lane);
}

struct TItem { const float* src; size_t ldw; bf16_t* dst; size_t ldwt; };
__device__ __forceinline__ void tt_load(f32x4 (&tv)[8], const TItem& t, int lane) {
#pragma unroll
    for (int i = 0; i < 8; ++i) tv[i] = *(const f32x4*)(t.src + (size_t)((lane >> 3) + 8 * i) * t.ldw + 4 * (lane & 7));
}
__device__ __forceinline__ void tt_store(const f32x4 (&tv)[8], const TItem& t, LAS float* scr, int lane) {
#pragma unroll
    for (int i = 0; i < 8; ++i) { LAS float* p = scr + ((lane >> 3) + 8 * i) * 33 + 4 * (lane & 7); p[0] = tv[i][0]; p[1] = tv[i][1]; p[2] = tv[i][2]; p[3] = tv[i][3]; }
    LDS_WAIT(); asm volatile("" ::: "memory");
    const int c = lane & 7;
#pragma unroll
    for (int j = 0; j < 4; ++j) { const int n = (lane >> 3) + 8 * j; const LAS float* s = scr + (8 * c) * 33 + n;
        u32x4 o; o.x = pk2(s[0 * 33], s[1 * 33]); o.y = pk2(s[2 * 33], s[3 * 33]); o.z = pk2(s[4 * 33], s[5 * 33]); o.w = pk2(s[6 * 33], s[7 * 33]);
        *(u32x4*)(t.dst + (size_t)n * t.ldwt + 8 * c) = o; }
    LDS_WAIT(); asm volatile("" ::: "memory");
}
__device__ __forceinline__ TItem titem(const float* W, int ldw, int nblk, int nb0, bf16_t* WT, int K, int item, int mode) {
    const int kb = item / nblk, nb = nb0 + item % nblk, k0 = 64 * kb, n0 = 32 * nb;
    int r0 = n0;
    if (mode == 1) { r0 = (n0 < FF) ? 256 * (n0 / 128) + (n0 % 128) : 256 * ((n0 - FF) / 128) + 128 + ((n0 - FF) % 128); }
    TItem t; t.src = W + (size_t)k0 * ldw + n0; t.ldw = (size_t)ldw; t.dst = WT + (size_t)r0 * K + k0; t.ldwt = (size_t)K; return t;
}
__device__ __forceinline__ void row_load(const float* src, f32x4 (&v)[8], int lane) {
#pragma unroll
    for (int j = 0; j < 8; ++j) v[j] = *(const f32x4*)(src + 256 * j + 4 * lane);
}
__device__ __forceinline__ void row_finish(f32x4 (&v)[8], bool do_ln, const float* lg, const float* lb, float* xf, bf16_t* xb, const LAS float* wg, const float* gb, float* gates, int lane, float* stat = nullptr) {
    if (do_ln) {
        float s = 0.f;
#pragma unroll
        for (int j = 0; j < 8; ++j) s += (v[j].x + v[j].y) + (v[j].z + v[j].w);
        const float mean = wave_sum(s, lane) * (1.f / D); float s2 = 0.f;
#pragma unroll
        for (int j = 0; j < 8; ++j) { v[j] = v[j] - mean; s2 += (v[j].x * v[j].x + v[j].y * v[j].y) + (v[j].z * v[j].z + v[j].w * v[j].w); }
        const float rstd = 1.f / sqrtf(wave_sum(s2, lane) * (1.f / D) + LN_EPS);
        if (stat && lane == 0) { stat[0] = mean; stat[1] = rstd; }
#pragma unroll
        for (int j = 0; j < 8; ++j) { const f32x4 g4 = *(const f32x4*)(lg + 256 * j + 4 * lane), b4 = *(const f32x4*)(lb + 256 * j + 4 * lane); v[j] = v[j] * rstd * g4 + b4; }
    }
    if (xf) {
#pragma unroll
        for (int j = 0; j < 8; ++j) *(f32x4*)(xf + 256 * j + 4 * lane) = v[j];
    }
    if (xb) {
#pragma unroll
        for (int j = 0; j < 8; ++j) { u32x2 w; w.x = cvt_pk_bf16(v[j].x, v[j].y); w.y = cvt_pk_bf16(v[j].z, v[j].w); *(u32x2*)(xb + 256 * j + 4 * lane) = w; }
    }
    if (gates) {
        asm volatile("" : "+s"(wg));
        float myg = 0.f;
#pragma unroll
        for (int q = 0; q < 8; ++q) { float s = 0.f;
#pragma unroll
            for (int j = 0; j < 8; ++j) { const f32x4 w4 = *(const LAS f32x4*)(wg + q * D + 256 * j + 4 * lane); s += (v[j].x * w4.x + v[j].y * w4.y) + (v[j].z * w4.z + v[j].w * w4.w); }
            s = wave_sum(s, lane); if (lane == q) myg = s + gb[q]; }
        if (lane < 8) gates[lane] = myg;
    }
}
__device__ __forceinline__ void row_pass(const float* src, bool do_ln, const float* lg, const float* lb, float* xf, bf16_t* xb, const LAS float* wg, const float* gb, float* gates, int lane, float* stat = nullptr) {
    f32x4 v[8]; row_load(src, v, lane); row_finish(v, do_ln, lg, lb, xf, xb, wg, gb, gates, lane, stat);
}
__device__ __forceinline__ void load_gate_w(const Frame& F, const float* WGl) {
    LAS float* wg = (LAS float*)F.lds;
    for (int i = F.tid; i < 8 * D / 4; i += 512) *(LAS f32x4*)(wg + 4 * i) = *(const f32x4*)(WGl + 4 * i);
    __syncthreads();
}

__global__ void __launch_bounds__(512, 2) fwd_kernel(Args args) {
    extern __shared__ __attribute__((aligned(16))) unsigned char lds_raw[];
    LAS unsigned char* const lds_base = (LAS unsigned char*)lds_raw;
    unsigned char* const ws = args.ws;
    volatile LAS unsigned* MISC = (volatile LAS unsigned*)(lds_base + MISC_OFF);
    if (threadIdx.x < 64) MISC[threadIdx.x] = 0u;
    const int wv0 = __builtin_amdgcn_readfirstlane((int)threadIdx.x >> 6);
    __syncthreads();
#if MK_PER_PHASE
    XcdBarrier bar; bar.bar = (unsigned*)(ws + WS_CTL) + CW_BAR; bar.x = 0; bar.st = nullptr;
#define GRID_BAR() do { } while (0)
#else
    XcdBarrier bar = xcd_barrier_post((unsigned*)(ws + WS_CTL) + CW_BAR, MISC + 8);
#define GRID_BAR() do { XcdBarrier b_ = bar; asm volatile("" : "+s"(b_.bar), "+s"(b_.x)); xcd_barrier(b_, fresh_tid(wv0)); } while (0)
#endif
#define IN(k) true
#define SEAM(k) GRID_BAR()
#define PHASE_CTX \
    unsigned char* wsb; { GAS unsigned char* g_ = (GAS unsigned char*)ws; asm volatile("" : "+s"(g_)); wsb = (unsigned char*)g_; }     \
    Frame F; { int t_ = fresh_tid(wv0); F.lds = lds_base; F.tid = t_; F.lane = t_ & 63; F.wave = __builtin_amdgcn_readfirstlane(t_ >> 6); \
      int g_ = gridDim.x, b_ = blockIdx.x; asm volatile("" : "+s"(g_), "+s"(b_)); F.G = g_; F.bid = b_; F.gw = b_ * 8 + F.wave; F.ngw = g_ * 8; }
#define WG ((float*)(wsb + WS_WG))
#define BIN ((float*)(wsb + WS_BIN))
#define GATES ((float*)(wsb + WS_GATES))
#define STAT ((float*)(wsb + WS_STAT))
#define MEMN ((bf16_t*)(wsb + WS_MEMN))
#define KMEM ((bf16_t*)(wsb + WS_KMEM))
#define VMEM ((bf16_t*)(wsb + WS_VMEM))
#define WQK ((bf16_t*)(wsb + WS_WQK))
#define WQN ((bf16_t*)(wsb + WS_WQN))
#define BQK ((float*)(wsb + WS_BQK))
#define WKT ((bf16_t*)(wsb + WS_WKT))
#define WVT ((bf16_t*)(wsb + WS_WVT))
#define PAR ((float*)(wsb + WS_PAR))
#define XF ((float*)(wsb + WS_XF))
#define PF ((float*)(wsb + WS_PF))
#define XB ((bf16_t*)(wsb + WS_XB))
#define Z ((bf16_t*)(wsb + WS_Z))
#define HFF ((bf16_t*)(wsb + WS_Z))
#define MRG ((bf16_t*)(wsb + WS_MRG))
#define HRAW ((bf16_t*)(wsb + WS_HRAW))
#define QF ((bf16_t*)(wsb + WS_QF))
#define KF ((bf16_t*)(wsb + WS_KF))
#define PFR ((bf16_t*)(wsb + WS_PFR))
#define VF ((bf16_t*)(wsb + WS_VF))
#define GS ((float*)(wsb + WS_GS))
#define DEN ((float*)(wsb + WS_DEN))
#define VSTAT ((float*)(wsb + WS_VSTAT))
#define WIG ((float*)(wsb + WS_WIG))
#define WF32 ((float*)(wsb + WS_WF32))
#define C2A ((float*)(wsb + WS_C2))

    if (IN(0)) {
        PHASE_CTX
        const float* x_in = args.in[0]; const float* w_in = args.in[4]; const float* b_in = args.in[5];
        LAS float* scr = (LAS float*)(F.lds + F.wave * 16384);
        {
            constexpr int I_IN1 = 32 * 256, I_IN2 = 32 * 192, I_GU = 32 * 352, I_DN = 88 * 64, I_PA = 16 * 64, I_PB = 32 * 64, I_PC = 16 * 64, I_OUT = 32 * 64, I_KV = 32 * 64;
            constexpr int NIT = I_IN1 + I_IN2 + I_GU + I_DN + I_PA + I_PB + I_PC + I_OUT + I_KV, NALL = DEPTH * NIT;
            auto decode = [&](int itx) -> TItem {
                const int l = itx / NIT; int r = itx - l * NIT;
                unsigned char* wl = wsb + WS_WL + (size_t)l * WL_STRIDE; const float* win_l = w_in + (size_t)l * D * INW;
                if (r < I_IN1) return titem(win_l, INW, 256, 0, (bf16_t*)(wl + WL_IN), D, r, 0); r -= I_IN1;
                if (r < I_IN2) return titem(win_l + 8200, INW, 192, 32, (bf16_t*)(wl + WL_IN) + (size_t)8192 * D, D, r, 0); r -= I_IN2;
                if (r < I_GU) return titem(args.in[20] + (size_t)l * D * 2 * FF, 2 * FF, 352, 0, (bf16_t*)(wl + WL_GU), D, r, 1); r -= I_GU;
                if (r < I_DN) return titem(args.in[21] + (size_t)l * FF * D, D, 64, 0, (bf16_t*)(wl + WL_DN), FF, r, 0); r -= I_DN;
                if (r < I_PA) return titem(args.in[14] + (size_t)l * 1024 * D, D, 64, 0, (bf16_t*)(wl + WL_PA), 1024, r, 0); r -= I_PA;
                if (r < I_PB) return titem(args.in[15] + (size_t)l * 2048 * D, D, 64, 0, (bf16_t*)(wl + WL_PB), 2048, r, 0); r -= I_PB;
                if (r < I_PC) return titem(args.in[16] + (size_t)l * 1024 * D, D, 64, 0, (bf16_t*)(wl + WL_PC), 1024, r, 0); r -= I_PC;
                if (r < I_OUT) return titem(args.in[17] + (size_t)l * D * D, D, 64, 0, (bf16_t*)(wl + WL_OUT), D, r, 0); r -= I_OUT;
                const int kb = r / 64, nb = r % 64, k0 = 64 * kb, n0 = 32 * nb;
                TItem t; t.src = args.in[13] + (size_t)l * D * 2048 + (size_t)k0 * 2048 + n0; t.ldw = 2048;
                t.dst = ((n0 < 1024) ? WKT + (size_t)(l * 1024 + n0) * D : WVT + (size_t)(l * 1024 + n0 - 1024) * D) + k0; t.ldwt = D; return t;
            };
            f32x4 ta[8], tb[8];
            int it = F.gw;
            TItem ca = decode(it < NALL ? it : NALL - 1), cb = ca;
            tt_load(ta, ca, F.lane);
#pragma nounroll
            while (it < NALL) {
                const int n1 = it + F.ngw; cb = decode(n1 < NALL ? n1 : NALL - 1); tt_load(tb, cb, F.lane);
                tt_store(ta, ca, scr, F.lane);
                if (n1 >= NALL) break;
                const int n2 = n1 + F.ngw; ca = decode(n2 < NALL ? n2 : NALL - 1); tt_load(ta, ca, F.lane);
                tt_store(tb, cb, scr, F.lane);
                it = n2;
            }
        }
        const int gt = F.bid * 512 + F.tid, ngt = F.G * 512;
        for (int i = gt; i < DEPTH * 8 * D; i += ngt) { const int l = i / (8 * D), q = (i / D) % 8, k = i % D; WG[i] = w_in[((size_t)l * D + k) * INW + SRC_GATE + q]; }
        for (int i = gt; i < DEPTH * ZW; i += ngt) { const int l = i / ZW, c = i % ZW; BIN[i] = b_in[(size_t)l * INW + (c < 8192 ? c : c + 8)]; }
        if (gt < 32) PAR[PAR_GBIAS + gt] = b_in[(size_t)(gt >> 3) * INW + SRC_GATE + (gt & 7)];
        if (gt < D) { PAR[PAR_ONE + gt] = 1.f; PAR[PAR_ZERO + gt] = 0.f; }
#define CPY(dst, src, n) do { const float* _s = (src); for (int i = gt; i < (n); i += ngt) PAR[(dst) + i] = _s[i]; } while (0)
        CPY(PAR_GWS, args.in[8], DEPTH * 8 * 128 * 128); CPY(PAR_GLNG, args.in[6], DEPTH * 1024); CPY(PAR_GLNB, args.in[7], DEPTH * 1024); CPY(PAR_GBS, args.in[9], DEPTH * 8 * 128);
        CPY(PAR_CONVW, args.in[10], DEPTH * 4 * 2048); CPY(PAR_CONVB, args.in[11], DEPTH * 2048); CPY(PAR_MNG, args.in[12], DEPTH * 2048);
        CPY(PAR_LN1G, args.in[18], DEPTH * D); CPY(PAR_LN1B, args.in[19], DEPTH * D); CPY(PAR_LN2G, args.in[22], DEPTH * D); CPY(PAR_LN2B, args.in[23], DEPTH * D);
#undef CPY
        { const float* gws = args.in[8];
          for (int i = gt; i < DEPTH * 8 * 16384; i += ngt) { const int lg = i >> 14, f = (i >> 9) & 31, ln = (i >> 3) & 63, j = i & 7; const int t = 16 * (f >> 2) + (ln & 15), sx = 32 * (f & 3) + 8 * (ln >> 4) + j;
              WF32[i] = (sx <= t) ? gws[((size_t)lg * 128 + t) * 128 + sx] : 0.f; }
          for (int i = gt; i < DEPTH * 8 * 128; i += ngt) { const int t = i & 127; const float* wr_ = gws + (size_t)i * 128; float sm = 0.f; for (int sx = 0; sx <= t; ++sx) sm += wr_[sx]; C2A[i] = sm; } }
        for (int i = gt; i < DEPTH * D * 256; i += ngt) { const int l = i / (D * 256), k = (i / 256) % D, c4 = (i & 255) * 4; const f32x4 v = *(const f32x4*)(w_in + ((size_t)l * D + k) * INW + 8200 + c4);
            u32x2 o; o.x = pk2(v.x, v.y); o.y = pk2(v.z, v.w); *(u32x2*)(WQN + ((size_t)l * D + k) * 1024 + c4) = o; }
        for (int i = gt; i < DEPTH * 1024; i += ngt) PAR[PAR_BQ + i] = b_in[(size_t)(i >> 10) * INW + 8200 + (i & 1023)];
        for (int m = F.gw; m < NBATCH * MEMLEN; m += F.ngw) row_pass(args.in[1] + (size_t)m * D, true, args.in[2], args.in[3], nullptr, MEMN + (size_t)m * D, nullptr, nullptr, nullptr, F.lane);
        __syncthreads();
        { LAS float* wg = (LAS float*)F.lds;
          for (int i = F.tid; i < 8 * D; i += 512) { const int q = i / D, k = i % D; wg[i] = w_in[(size_t)k * INW + SRC_GATE + q]; }
          __syncthreads();
          { f32x4 va[8], vb[8]; int m = F.gw; row_load(x_in + (size_t)m * D, va, F.lane);
            for (; m < T; m += F.ngw) { const int mn = (m + F.ngw < T) ? m + F.ngw : m; row_load(x_in + (size_t)mn * D, vb, F.lane);
                row_finish(va, false, nullptr, nullptr, PF + (size_t)m * D, XB + (size_t)m * D, wg, b_in + SRC_GATE, GATES + (size_t)m * 8, F.lane); if (F.lane == 0) { STAT[2 * m] = 0.f; STAT[2 * m + 1] = 1.f; }
#pragma unroll
                for (int j = 0; j < 8; ++j) va[j] = vb[j]; } }
          __syncthreads(); }
    }
    SEAM(0);
    if (IN(1)) {
        PHASE_CTX
        if (F.bid < 64) { pg8::GemmStd<D, D, D> g{MEMN, WKT}; pg8::StaticOrder<1024, 4096> S; S.init(64, F.bid); pg8::EpiBf16 E{KMEM, 4096};
          pg8::gemm_phase(F.lds, g, S, E, F.tid); }
        else if (F.bid < 128) { pg8::GemmStd<D, D, D> g{MEMN, WVT}; pg8::StaticOrder<1024, 4096> S; S.init(64, F.bid - 64); pg8::EpiBf16 E{VMEM, 4096};
          pg8::gemm_phase(F.lds, g, S, E, F.tid); }
    }
    SEAM(1);
    {
        PHASE_CTX
        { pg8::GemmQK g{KMEM, WQN}; pg8::StaticOrder<64 * 256, 2048> S; S.init(F.G, F.bid); pg8::EpiQK E{WQK};
          pg8::gemm_phase(F.lds, g, S, E, F.tid); }
        { pg8::GemmVW g{wsb + WS_WL, VMEM}; pg8::StaticOrder<512 * 256, 256> S; S.init(F.G, F.bid); pg8::EpiVW E{wsb};
          pg8::gemm_phase(F.lds, g, S, E, F.tid); }
        for (int i = F.bid * 512 + F.tid; i < DEPTH * 4 * 1024; i += F.G * 512) {
            const int l = i >> 12, b = (i >> 10) & 3, hm = i & 1023, h = hm >> 8, m = hm & 255;
            const bf16_t* kp = KMEM + (size_t)(b * 256 + m) * 4096 + l * 1024 + h * 256; const float* bq = PAR + PAR_BQ + l * 1024 + h * 256; float sm = 0.f;
            for (int d8 = 0; d8 < 256; d8 += 8) { const u32x4 kv = *(const u32x4*)(kp + d8); const f32x4 q0 = *(const f32x4*)(bq + d8), q1 = *(const f32x4*)(bq + d8 + 4);
                sm += bflo(kv.x) * q0[0] + bfhi(kv.x) * q0[1] + bflo(kv.y) * q0[2] + bfhi(kv.y) * q0[3] + bflo(kv.z) * q1[0] + bfhi(kv.z) * q1[1] + bflo(kv.w) * q1[2] + bfhi(kv.w) * q1[3]; }
            BQK[i] = sm * pg8::SCORE_SCALE; }
    }
    GRID_BAR();

    for (int lyr = 0; lyr < DEPTH; ++lyr) {
        const int pb = 2 + 10 * lyr;
#define LAYER_CTX PHASE_CTX int l = lyr; asm volatile("" : "+s"(l)); unsigned char* wl = wsb + WS_WL + (size_t)l * WL_STRIDE; (void)wl;
        if (IN(pb + 0)) {
            LAYER_CTX
            for (int ch = F.gw; ch < 1024; ch += F.ngw) {
                const int bh = ch >> 6, c = ch & 63, b = bh >> 2, h = bh & 3;
                const size_t row = (size_t)b * SEQ + 64 * c + F.lane;
                const float gi = GATES[row * 8 + h], gf = GATES[row * 8 + 4 + h];
                float bc = fminf(gf, 0.f) - log1pf(expf(-fabsf(gf)));
#pragma unroll
                for (int o = 1; o < 64; o <<= 1) { const float y = shup(bc, o, F.lane); if (F.lane >= o) bc += y; }
                const float bv = gi - bc; float pm = bv;
#pragma unroll
                for (int o = 1; o < 64; o <<= 1) { const float y = shup(pm, o, F.lane); if (F.lane >= o) pm = fmaxf(pm, y); }
                const int pos = bh * 4096 + 64 * c + F.lane;
                GS[GS_BCUM + pos] = bc; GS[GS_BV + pos] = bv; GS[GS_PMAX + pos] = pm;
                if (F.lane == 63) { GS[GS_BLAST + ch] = bc; GS[GS_MAXB + ch] = pm; }
            }
            pg8::GemmIn g{XB, (const bf16_t*)(wl + WL_IN), WQK + (size_t)l * 4 * 1024 * D}; pg8::RotOrder<T, ZW, 8, 24> S; S.init(F.G, F.bid);
            pg8::EpiIn E{Z, BIN + (size_t)l * ZW, BQK + (size_t)l * 4096, (LAS float*)(F.lds + RING_BYTES)};
            pg8::gemm_phase(F.lds, g, S, E, F.tid);
        }
        SEAM(pb + 0);
        if (IN(pb + 1)) {
            LAYER_CTX
            {
                LAS bf16_t* QL = (LAS bf16_t*)F.lds; LAS bf16_t* KL = QL + 64 * 264; LAS bf16_t* PL = KL + 64 * 264;
                LAS float* WSL = (LAS float*)(PL + 64 * 72);
                LAS bf16_t* VTL = (LAS bf16_t*)(WSL + 64);
                const int w = F.wave, fr = F.lane & 15, fq = F.lane >> 4;
                u32x4 zr[11], va[8]; f32x4 cw[4][2], cb2[2]; float bl, mb;
                auto pp_load = [&](int chx) {
                    const int bhx = chx >> 6, cx = chx & 63, bx = bhx >> 2, hx = bhx & 3; const size_t row0x = (size_t)bx * SEQ + 64 * cx;
                    bl = GS[GS_BLAST + bhx * 64 + F.lane]; mb = GS[GS_MAXB + bhx * 64 + F.lane];
                    const int cg = F.tid & 63, rg = F.tid >> 6; const int chz = (cg < 32) ? hx * 256 + 8 * cg : 1024 + hx * 256 + 8 * (cg - 32);
                    const float* cwp = PAR + PAR_CONVW + l * 4 * 2048 + chz; const float* cbp = PAR + PAR_CONVB + l * 2048 + chz;
#pragma unroll
                    for (int j = 0; j < 4; ++j) { cw[j][0] = *(const f32x4*)(cwp + j * 2048); cw[j][1] = *(const f32x4*)(cwp + j * 2048 + 4); }
                    cb2[0] = *(const f32x4*)cbp; cb2[1] = *(const f32x4*)(cbp + 4);
                    const bf16_t* zp = Z + (row0x + 8 * rg) * ZW + ZQK + chz;
#pragma unroll
                    for (int k = 0; k < 11; ++k) { if (k >= 3 || rg > 0 || cx > 0) zr[k] = *(const u32x4*)(zp + (ptrdiff_t)(k - 3) * ZW); else zr[k] = (u32x4){0u, 0u, 0u, 0u}; }
                    const int sx = F.tid & 63, cq = F.tid >> 6; const bf16_t* vp = Z + (row0x + sx) * ZW + ZVM + hx * 512 + 64 * cq;
#pragma unroll
                    for (int q = 0; q < 8; ++q) va[q] = *(const u32x4*)(vp + 8 * q);
                };
                const int chb_ = 128 * (F.bid & 7) + 4 * (F.bid >> 3);
                pp_load(chb_);
                for (int ch = chb_; ch < chb_ + 4; ++ch) {
                    const int bh = ch >> 6, c = ch & 63, b = bh >> 2, h = bh & 3; const size_t row0 = (size_t)b * SEQ + 64 * c; const int pos0 = bh * 4096 + 64 * c;
                    float mp = 0.f;
                    for (int cc = 0; cc < c; ++cc) mp = rdlane(bl, cc) + fmaxf(mp, rdlane(mb, cc));
                    const float mm = fmaxf(mp, GS[GS_MAXB + ch]);
                    if (F.tid == 0) GS[GS_MPREV + ch] = mp;
                    if (F.tid < 64) { WSL[F.tid] = expf(GS[GS_BV + pos0 + F.tid] - mm); WIG[(size_t)ch * 256 + F.tid] = expf(mp - fmaxf(GS[GS_PMAX + pos0 + F.tid], mp)); }
                    if (F.tid == 64) WIG[(size_t)ch * 256 + 64] = expf(mp - mm);
                    {
                      const int cg = F.tid & 63, rg = F.tid >> 6;
                      const float osc = (cg < 32) ? 1.0f : 0.0625f;
                      f32x4 zf[11][2];
#pragma unroll
                      for (int k = 0; k < 11; ++k) { zf[k][0] = (f32x4){bflo(zr[k].x), bfhi(zr[k].x), bflo(zr[k].y), bfhi(zr[k].y)}; zf[k][1] = (f32x4){bflo(zr[k].z), bfhi(zr[k].z), bflo(zr[k].w), bfhi(zr[k].w)}; }
                      LAS bf16_t* dst = ((cg < 32) ? QL : KL) + (8 * rg) * 264 + 8 * (cg & 31);
#pragma unroll
                      for (int rr = 0; rr < 8; ++rr) { f32x4 y0 = cb2[0], y1 = cb2[1];
#pragma unroll
                          for (int j = 0; j < 4; ++j) { y0 += cw[j][0] * zf[rr + j][0]; y1 += cw[j][1] * zf[rr + j][1]; }
#pragma unroll
                          for (int e = 0; e < 4; ++e) { y0[e] = y0[e] * fast_sigmoid(y0[e]) * osc; y1[e] = y1[e] * fast_sigmoid(y1[e]) * osc; }
                          u32x4 o; o.x = cvt_pk_bf16(y0[0], y0[1]); o.y = cvt_pk_bf16(y0[2], y0[3]); o.z = cvt_pk_bf16(y1[0], y1[1]); o.w = cvt_pk_bf16(y1[2], y1[3]);
                          *(LAS u32x4*)(dst + rr * 264) = o; } }
                    {
                      const int sx = F.tid & 63, cq = F.tid >> 6;
#pragma unroll
                      for (int q = 0; q < 8; ++q) { const u32x4 a = va[q]; LAS bf16_t* d0 = VTL + (64 * cq + 8 * q) * 72 + sx;
                          d0[0] = (bf16_t)(a.x & 0xffffu); d0[72] = (bf16_t)(a.x >> 16); d0[2 * 72] = (bf16_t)(a.y & 0xffffu); d0[3 * 72] = (bf16_t)(a.y >> 16);
                          d0[4 * 72] = (bf16_t)(a.z & 0xffffu); d0[5 * 72] = (bf16_t)(a.z >> 16); d0[6 * 72] = (bf16_t)(a.w & 0xffffu); d0[7 * 72] = (bf16_t)(a.w >> 16); } }
                    pp_load(ch + 1 < chb_ + 4 ? ch + 1 : ch);
                    __syncthreads();
                    const int tb = w >> 1, half = w & 1;
                    bf16x8 qa[8];
#pragma unroll
                    for (int i = 0; i < 8; ++i) qa[i] = *(const LAS bf16x8*)(QL + (16 * tb + fr) * 264 + 32 * i + 8 * fq);
                    { bf16_t* qf = QF + ((size_t)ch * 32 + tb * 8 + 4 * half) * 512 + F.lane * 8;
                      const float wir = expf(mp - fmaxf(GS[GS_PMAX + pos0 + 16 * tb + fr], mp));
#pragma unroll
                      for (int ii = 0; ii < 4; ++ii) { const int i = 4 * half + ii; const LAS bf16_t* qp = QL + (16 * tb + fr) * 264 + 32 * i + 4 * fq;
                          u32x4 o; const u32x2 lo = *(const LAS u32x2*)qp, hi = *(const LAS u32x2*)(qp + 16);
                          o.x = cvt_pk_bf16(bflo(lo.x) * wir, bfhi(lo.x) * wir); o.y = cvt_pk_bf16(bflo(lo.y) * wir, bfhi(lo.y) * wir); o.z = cvt_pk_bf16(bflo(hi.x) * wir, bfhi(hi.x) * wir); o.w = cvt_pk_bf16(bflo(hi.y) * wir, bfhi(hi.y) * wir);
                          *(u32x4*)(qf + ii * 512) = o; } }
                    const f32x4 pm4 = *(const f32x4*)(GS + GS_PMAX + pos0 + 16 * tb + 4 * fq);
#pragma unroll
                    for (int sbi = 0; sbi < 2; ++sbi) { const int sb = 2 * half + sbi; f32x4 acc = (f32x4){0.f, 0.f, 0.f, 0.f};
                        if (sb <= tb) {
#pragma unroll
                            for (int i = 0; i < 8; ++i) { const bf16x8 kb = *(const LAS bf16x8*)(KL + (16 * sb + fr) * 264 + 32 * i + 8 * fq); acc = mfma16(qa[i], kb, acc); }
                            const float Bs = GS[GS_BV + pos0 + 16 * sb + fr]; const int sx = 16 * sb + fr;
#pragma unroll
                            for (int r = 0; r < 4; ++r) { const int t = 16 * tb + 4 * fq + r; const float At = -fmaxf(pm4[r], mp); acc[r] = (sx <= t) ? expf(At + Bs) * acc[r] : 0.f; } }
#pragma unroll
                        for (int r = 0; r < 4; ++r) PL[(16 * tb + 4 * fq + r) * 72 + 16 * sb + fr] = (bf16_t)f2bf(acc[r]); }
                    __syncthreads();
                    { const int i = w & 1; const bf16x8 pf = *(const LAS bf16x8*)(PL + (16 * tb + fr) * 72 + 32 * i + 8 * fq);
                      *(bf16x8*)(PFR + ((size_t)ch * 8 + tb * 2 + i) * 512 + F.lane * 8) = pf; }
#pragma unroll
                    for (int dbi = 0; dbi < 2; ++dbi)
#pragma unroll
                        for (int i = 0; i < 2; ++i) { const int db = 2 * w + dbi; float kv[8];
#pragma unroll
                            for (int j = 0; j < 8; ++j) { const int sx = 32 * i + 8 * fq + j; kv[j] = WSL[sx] * bf2f(KL[sx * 264 + 16 * db + fr]); }
                            u32x4 o; o.x = pk2(kv[0], kv[1]); o.y = pk2(kv[2], kv[3]); o.z = pk2(kv[4], kv[5]); o.w = pk2(kv[6], kv[7]);
                            *(u32x4*)(KF + ((size_t)ch * 32 + db * 2 + i) * 512 + F.lane * 8) = o; }
#pragma unroll
                    for (int vi = 0; vi < 4; ++vi)
#pragma unroll
                        for (int i = 0; i < 2; ++i) { const int vblk = 4 * w + vi; const u32x4 o = *(const LAS u32x4*)(VTL + (16 * vblk + fr) * 72 + 32 * i + 8 * fq);
                            *(u32x4*)(VF + ((size_t)ch * 64 + vblk * 2 + i) * 512 + F.lane * 8) = o; }
                    __syncthreads();
                }
            }
            for (int m0 = F.gw * 8; m0 < T; m0 += F.ngw * 8) {
                u32x4 ra[8], rbv[8];
#pragma unroll
                for (int rr = 0; rr < 8; ++rr) { const bf16_t* vp = Z + (size_t)(m0 + rr) * ZW + ZV; ra[rr] = *(const u32x4*)(vp + 8 * F.lane); rbv[rr] = *(const u32x4*)(vp + 512 + 8 * F.lane); }
                float s1[8], s2[8];
#pragma unroll
                for (int rr = 0; rr < 8; ++rr) { const u32x4 a = ra[rr], b = rbv[rr];
                    const float e[16] = {bflo(a.x), bfhi(a.x), bflo(a.y), bfhi(a.y), bflo(a.z), bfhi(a.z), bflo(a.w), bfhi(a.w), bflo(b.x), bfhi(b.x), bflo(b.y), bfhi(b.y), bflo(b.z), bfhi(b.z), bflo(b.w), bfhi(b.w)};
                    float t1 = 0.f, t2 = 0.f;
#pragma unroll
                    for (int j = 0; j < 16; ++j) { t1 += e[j]; t2 += e[j] * e[j]; }
                    s1[rr] = t1; s2[rr] = t2; }
#pragma unroll
                for (int rr = 0; rr < 8; ++rr) { s1[rr] = wave_sum(s1[rr], F.lane); s2[rr] = wave_sum(s2[rr], F.lane); }
#pragma unroll
                for (int rr = 0; rr < 8; ++rr) { const float mean = s1[rr] * (1.f / 1024.f); const float var = fmaxf(s2[rr] * (1.f / 1024.f) - mean * mean, 0.f);
                    if (F.lane == 0) { VSTAT[2 * (m0 + rr)] = mean; VSTAT[2 * (m0 + rr) + 1] = 1.f / sqrtf(var + LN_EPS); } }
            }
        }
        SEAM(pb + 1);
        {
            LAYER_CTX
            if (F.bid < 80) {
            LAS unsigned char* RG = F.lds;
            const int w = F.wave, fr = F.lane & 15, fq = F.lane >> 4;
            const bool is_den = F.bid >= 64;
            const int it = is_den ? F.bid - 64 : F.bid;
            const int bh = is_den ? (it & 7) * 2 + (it >> 3) : (it & 7) * 2 + (it >> 5), jq = is_den ? 0 : (it >> 3) & 3, b = bh >> 2, h = bh & 3;
            const bool active = w < 4 && (!is_den || w == 0);
            bf16x8 ones; { const short o1 = (fr == 0) ? (short)0x3f80 : (short)0; ones = (bf16x8){o1, o1, o1, o1, o1, o1, o1, o1}; }
            const int lo8 = F.lane * 8;
            f32x4 CA[16], CB[16];
#pragma unroll
            for (int i = 0; i < 16; ++i) { CA[i] = (f32x4){0.f, 0.f, 0.f, 0.f}; CB[i] = (f32x4){0.f, 0.f, 0.f, 0.f}; }
            bf16x8 vA[2], vB[2];
            vA[0] = ones; vA[1] = ones; vB[0] = ones; vB[1] = ones;
            float* const dmy = (float*)(wsb + WS_DUMMY) + ((size_t)F.bid * 512 + F.tid) * 4;
#define SC_DMA(c_, sl_) do { const size_t chh = (size_t)bh * 64 + (c_); int wd_ = w - 4; asm volatile("" : "+s"(wd_));        \
                _Pragma("unroll") for (int i = 0; i < 18; ++i) { const int p_ = 18 * wd_ + i; if (p_ == 33 || p_ == 35) continue; \
                    const bf16_t* src_ = (p_ < 32) ? QF + (chh * 32 + p_) * 512 : (p_ < 40) ? PFR + (chh * 8 + (p_ - 32)) * 512 : KF + (chh * 32 + (p_ - 40)) * 512; \
                    __builtin_amdgcn_global_load_lds((const unsigned*)(src_ + lo8), (LAS unsigned*)(RG + (sl_) * 74752 + p_ * 1024), 16, 0, 0); } \
                if (wd_ == 0) { int l4_ = lo8; asm volatile("" : "+v"(l4_)); l4_ >>= 1; __builtin_amdgcn_global_load_lds((const unsigned*)(WIG + chh * 256 + l4_), (LAS unsigned*)(RG + (sl_) * 74752 + 72 * 1024), 16, 0, 0); } } while (0)
#define SC_LOADV(c_) do { if (active && !is_den) { int ln_ = F.lane; asm volatile("" : "+v"(ln_)); const bf16_t* v_ = VF + (((size_t)bh * 64 + (c_)) * 64 + (8 * jq + 2 * w) * 2) * 512 + ln_ * 8; \
                vA[0] = *(const bf16x8*)v_; vA[1] = *(const bf16x8*)(v_ + 512); vB[0] = *(const bf16x8*)(v_ + 1024); vB[1] = *(const bf16x8*)(v_ + 1536); } } while (0)
#define SC_SB __builtin_amdgcn_sched_barrier(0)
#define SC_RD4(dst, p0, p1, p2, p3) do { dst[0] = *(const LAS bf16x8*)(sb_ + (p0) * 1024); dst[1] = *(const LAS bf16x8*)(sb_ + (p1) * 1024); dst[2] = *(const LAS bf16x8*)(sb_ + (p2) * 1024); dst[3] = *(const LAS bf16x8*)(sb_ + (p3) * 1024); SC_SB; } while (0)
#define SC_W4 do { asm volatile("s_waitcnt lgkmcnt(4)" ::: "memory"); SC_SB; } while (0)
#define SC_INTER2(j, cur) do { \
                { const bf16x8 ca_ = pack8(CA[4 * (j)], CA[4 * (j) + 1]), cb_ = pack8(CB[4 * (j)], CB[4 * (j) + 1]); a0A = mfma16(cur[0], ca_, a0A); a0B = mfma16(cur[0], cb_, a0B); a1A = mfma16(cur[2], ca_, a1A); a1B = mfma16(cur[2], cb_, a1B); } \
                { const bf16x8 ca_ = pack8(CA[4 * (j) + 2], CA[4 * (j) + 3]), cb_ = pack8(CB[4 * (j) + 2], CB[4 * (j) + 3]); a0A = mfma16(cur[1], ca_, a0A); a0B = mfma16(cur[1], cb_, a0B); a1A = mfma16(cur[3], ca_, a1A); a1B = mfma16(cur[3], cb_, a1B); } SC_SB; } while (0)
#define SC_INTRA2(cur) do { a0A = mfma16(cur[0], vA[0], a0A); a0B = mfma16(cur[0], vB[0], a0B); a1A = mfma16(cur[2], vA[0], a1A); a1B = mfma16(cur[2], vB[0], a1B); \
                a0A = mfma16(cur[1], vA[1], a0A); a0B = mfma16(cur[1], vB[1], a0B); a1A = mfma16(cur[3], vA[1], a1A); a1B = mfma16(cur[3], vB[1], a1B); SC_SB; } while (0)
#define SC_OUT(p) do { if (!is_den) { bf16_t* hp = HRAW + (row0 + 32 * (p)) * 2048 + h * 512 + 128 * jq + 32 * w + ((4 * fq) * 2048 + fr); \
                    _Pragma("unroll") for (int r = 0; r < 4; ++r) { hp[r * 2048] = (bf16_t)f2bf(a0A[r]); hp[r * 2048 + 16] = (bf16_t)f2bf(a0B[r]); hp[(16 + r) * 2048] = (bf16_t)f2bf(a1A[r]); hp[(16 + r) * 2048 + 16] = (bf16_t)f2bf(a1B[r]); } } \
                else { float* dp = (fr == 0) ? DEN + (row0 + 32 * (p)) * 4 + h + (4 * fq) * 4 : dmy; const int ds_ = (fr == 0) ? 4 : 0; \
                    _Pragma("unroll") for (int r = 0; r < 4; ++r) { dp[r * ds_] = a0A[r]; dp[(16 + r) * ds_] = a1A[r]; } } \
                SC_SB; } while (0)
#define SC_ZERO do { a0A = (f32x4){0.f, 0.f, 0.f, 0.f}; a0B = a0A; a1A = a0A; a1B = a0A; } while (0)
#define SC_UPD(u, cur) do { f32x4 t0_ = scale4(CA[2 * (u)], dec), t1_ = scale4(CB[2 * (u)], dec), t2_ = scale4(CA[2 * (u) + 1], dec), t3_ = scale4(CB[2 * (u) + 1], dec); \
                t0_ = mfma16(cur[0], vA[0], t0_); t1_ = mfma16(cur[0], vB[0], t1_); t2_ = mfma16(cur[2], vA[0], t2_); t3_ = mfma16(cur[2], vB[0], t3_); \
                CA[2 * (u)] = mfma16(cur[1], vA[1], t0_); CB[2 * (u)] = mfma16(cur[1], vB[1], t1_); CA[2 * (u) + 1] = mfma16(cur[3], vA[1], t2_); CB[2 * (u) + 1] = mfma16(cur[3], vB[1], t3_); SC_SB; } while (0)
#define SC_STEP(c_, sl_, cn_, sn_) do { const size_t row0 = (size_t)b * SEQ + 64 * (c_); \
                const LAS unsigned char* sb_ = RG + (sl_) * 74752 + F.lane * 16; const LAS float* wip_ = (const LAS float*)(RG + (sl_) * 74752 + 72 * 1024); \
                if (active) { \
                const float dec = wip_[64]; \
                f32x4 a0A, a0B, a1A, a1B; bf16x8 fa[4], fb[4]; \
                SC_ZERO; \
                SC_RD4(fa, 0, 1, 8, 9); \
                SC_RD4(fb, 2, 3, 10, 11); SC_W4; SC_INTER2(0, fa); \
                SC_RD4(fa, 4, 5, 12, 13); SC_W4; SC_INTER2(1, fb); \
                SC_RD4(fb, 6, 7, 14, 15); SC_W4; SC_INTER2(2, fa); \
                fa[0] = *(const LAS bf16x8*)(sb_ + 32 * 1024); fa[2] = *(const LAS bf16x8*)(sb_ + 34 * 1024); SC_SB; asm volatile("s_waitcnt lgkmcnt(2)" ::: "memory"); SC_SB; SC_INTER2(3, fb);        \
                SC_RD4(fb, 16, 17, 24, 25); SC_W4; a0A = mfma16(fa[0], vA[0], a0A); a0B = mfma16(fa[0], vB[0], a0B); a1A = mfma16(fa[2], vA[0], a1A); a1B = mfma16(fa[2], vB[0], a1B); SC_SB; SC_OUT(0); SC_ZERO; \
                _Pragma("unroll") for (int i = 0; i < 16; ++i) asm volatile("" : "+v"(CA[i]), "+v"(CB[i]));        \
                SC_RD4(fa, 18, 19, 26, 27); SC_W4; SC_INTER2(0, fb); \
                SC_RD4(fb, 20, 21, 28, 29); SC_W4; SC_INTER2(1, fa); \
                SC_RD4(fa, 22, 23, 30, 31); SC_W4; SC_INTER2(2, fb); \
                SC_RD4(fb, 36, 37, 38, 39); SC_W4; SC_INTER2(3, fa); \
                SC_RD4(fa, 40, 41, 42, 43); SC_W4; SC_INTRA2(fb); SC_OUT(1); \
                SC_RD4(fb, 44, 45, 46, 47); SC_W4; SC_UPD(0, fa); \
                SC_RD4(fa, 48, 49, 50, 51); SC_W4; SC_UPD(1, fb); \
                SC_RD4(fb, 52, 53, 54, 55); SC_W4; SC_UPD(2, fa); \
                SC_RD4(fa, 56, 57, 58, 59); SC_W4; SC_UPD(3, fb); \
                SC_RD4(fb, 60, 61, 62, 63); SC_W4; SC_UPD(4, fa); \
                SC_RD4(fa, 64, 65, 66, 67); SC_W4; SC_UPD(5, fb); \
                SC_RD4(fb, 68, 69, 70, 71); SC_W4; SC_UPD(6, fa); \
                asm volatile("s_waitcnt lgkmcnt(0)" ::: "memory"); SC_SB; SC_UPD(7, fb); \
                SC_LOADV(cn_);        \
                } else if (w >= 4) { SC_DMA(cn_, sn_); asm volatile("" ::: "memory"); __builtin_amdgcn_s_waitcnt(0x0070); }       \
                __builtin_amdgcn_s_barrier(); asm volatile("" ::: "memory"); } while (0)
            if (w >= 4) { SC_DMA(0, 0); }
            asm volatile("" ::: "memory"); __builtin_amdgcn_s_waitcnt(0x0070); __builtin_amdgcn_s_barrier(); asm volatile("" ::: "memory");
#define SC_TRIP(c) do { { SC_STEP((c), 0, (c) + 1, 1); } \
                { const int cnx_ = (c) + 2 < 64 ? (c) + 2 : 63; SC_STEP((c) + 1, 1, cnx_, 0); } } while (0)
            SC_LOADV(0);
#pragma nounroll
            for (int c = 0; c < 64; c += 2) SC_TRIP(c);
#undef SC_TRIP
#undef SC_STEP
#undef SC_UPD
#undef SC_ZERO
#undef SC_OUT
#undef SC_INTRA2
#undef SC_INTER2
#undef SC_W4
#undef SC_RD4
#undef SC_SB
#undef SC_LOADV
#undef SC_DMA
            asm volatile("s_waitcnt vmcnt(0)" ::: "memory");
            __syncthreads();
            } else {
            {
                LAS bf16_t* VT = (LAS bf16_t*)F.lds;
                LAS float* ST = (LAS float*)(F.lds + 128 * 136 * 2);
                LAS float* C1 = ST + 256;
                const int w = F.wave, fr = F.lane & 15, fq = F.lane >> 4, nst = (w >> 1) + 1;
                for (int un = F.bid - 80; un < 256; un += 176) {
                    const int cc = un >> 1, hf = un & 1; const size_t r0 = (size_t)cc * 128;
                    if (F.tid < 128) { const f32x2 sv = *(const f32x2*)(VSTAT + 2 * (r0 + F.tid)); ST[F.tid] = sv.x; ST[128 + F.tid] = sv.y; }
                    __syncthreads();
                    u32x4 ta[4]; f32x4 wa[4][2]; unsigned short uvA[8][4];
#pragma unroll
                    for (int i = 0; i < 4; ++i) { ta[i] = (u32x4){0u, 0u, 0u, 0u}; wa[i][0] = (f32x4){0.f, 0.f, 0.f, 0.f}; wa[i][1] = (f32x4){0.f, 0.f, 0.f, 0.f}; }
#pragma unroll
                    for (int db = 0; db < 8; ++db)
#pragma unroll
                        for (int r = 0; r < 4; ++r) uvA[db][r] = 0;
#define BRA_LOAD_TW(gi_) do { const int gq_ = 4 * hf + (gi_), lg_ = l * 8 + gq_; const bf16_t* vp = Z + (r0 + (F.tid & 127)) * ZW + ZV + gq_ * 128 + (F.tid >> 7) * 32; \
                        _Pragma("unroll") for (int q = 0; q < 4; ++q) ta[q] = *(const u32x4*)(vp + 8 * q); \
                        _Pragma("unroll") for (int i = 0; i < 4; ++i) if (i < nst) { const float* wp = WF32 + ((size_t)lg_ * 32 + w * 4 + i) * 512 + F.lane * 8; wa[i][0] = *(const f32x4*)wp; wa[i][1] = *(const f32x4*)(wp + 4); } } while (0)
#define BRA_LOAD_UV(gi_, UV) do { const bf16_t* up0 = Z + (r0 + 16 * w + 4 * fq) * ZW + ZU + (4 * hf + (gi_)) * 128 + fr; \
                        _Pragma("unroll") for (int db = 0; db < 8; ++db) _Pragma("unroll") for (int r = 0; r < 4; ++r) UV[db][r] = up0[(size_t)r * ZW + 16 * db]; } while (0)
                    BRA_LOAD_TW(0); BRA_LOAD_UV(0, uvA);
#pragma nounroll
                    for (int gi = 0; gi < 4; ++gi) { const int gq = 4 * hf + gi, lg = l * 8 + gq;
                        { const int sx = F.tid & 127, c0 = (F.tid >> 7) * 32;
#pragma unroll
                          for (int q = 0; q < 4; ++q) { const u32x4 a = ta[q]; LAS bf16_t* d0 = VT + (c0 + 8 * q) * 136 + sx;
                              d0[0] = (bf16_t)(a.x & 0xffffu); d0[136] = (bf16_t)(a.x >> 16); d0[2 * 136] = (bf16_t)(a.y & 0xffffu); d0[3 * 136] = (bf16_t)(a.y >> 16);
                              d0[4 * 136] = (bf16_t)(a.z & 0xffffu); d0[5 * 136] = (bf16_t)(a.z >> 16); d0[6 * 136] = (bf16_t)(a.w & 0xffffu); d0[7 * 136] = (bf16_t)(a.w >> 16); } }
                        bf16x8 af[4]; float c1p = 0.f;
#pragma unroll
                        for (int i = 0; i < 4; ++i) { u32x4 o = (u32x4){0u, 0u, 0u, 0u};
                            if (i < nst) { const f32x4 w0 = wa[i][0], w1 = wa[i][1];
                                const LAS float* sp = ST + 32 * i + 8 * fq; const f32x4 m0 = *(const LAS f32x4*)sp, m1 = *(const LAS f32x4*)(sp + 4), q0 = *(const LAS f32x4*)(sp + 128), q1 = *(const LAS f32x4*)(sp + 132);
                                const f32x4 p0 = w0 * q0, p1 = w1 * q1;
                                o.x = pk2(p0[0], p0[1]); o.y = pk2(p0[2], p0[3]); o.z = pk2(p1[0], p1[1]); o.w = pk2(p1[2], p1[3]);
                                c1p += bflo(o.x) * m0[0] + bfhi(o.x) * m0[1] + bflo(o.y) * m0[2] + bfhi(o.y) * m0[3] + bflo(o.z) * m1[0] + bfhi(o.z) * m1[1] + bflo(o.w) * m1[2] + bfhi(o.w) * m1[3]; }
                            af[i] = __builtin_bit_cast(bf16x8, o); }
                        c1p += shx(c1p, 16, F.lane); c1p += shx(c1p, 32, F.lane);
                        if (fq == 0) C1[w * 16 + fr] = c1p;
                        __syncthreads();
                        if (gi < 3) BRA_LOAD_TW(gi + 1);
                        const f32x4 c14 = *(const LAS f32x4*)(C1 + w * 16 + 4 * fq);
                        const f32x4 c24 = *(const f32x4*)(C2A + lg * 128 + 16 * w + 4 * fq), bs4 = *(const f32x4*)(PAR + PAR_GBS + lg * 128 + 16 * w + 4 * fq);
#pragma unroll
                        for (int db = 0; db < 8; ++db) { f32x4 acc = (f32x4){0.f, 0.f, 0.f, 0.f};
#pragma unroll
                            for (int i = 0; i < 4; ++i) if (i < nst) { const bf16x8 bb = *(const LAS bf16x8*)(VT + (16 * db + fr) * 136 + 32 * i + 8 * fq); acc = mfma16(af[i], bb, acc); }
                            const int dcol = gq * 128 + 16 * db + fr; const float gg = PAR[PAR_GLNG + l * 1024 + dcol], bbv = PAR[PAR_GLNB + l * 1024 + dcol];
                            bf16_t* up = Z + (r0 + 16 * w + 4 * fq) * ZW + ZU + dcol;
#pragma unroll
                            for (int r = 0; r < 4; ++r) { const float mixed = gg * (acc[r] - c14[r]) + bbv * c24[r] + bs4[r]; up[(size_t)r * ZW] = (bf16_t)f2bf(bf2f(uvA[db][r]) * mixed); } }
                        asm volatile("" ::: "memory");
                        if (gi < 3) BRA_LOAD_UV(gi + 1, uvA);
                        __syncthreads();
                    }
#undef BRA_LOAD_TW
#undef BRA_LOAD_UV
                }
            }
                __syncthreads();
                { pg8::GemmT<ZW, 1024, 1024, 256L * ZW, 0L, 2048L * 1024, 256L * 1024> g{Z + ZQX, (const bf16_t*)(wsb + (l < 2 ? WS_VW01 + (size_t)l * 16 * MiB : WS_VW23 + (size_t)(l - 2) * 16 * MiB))};
                  pg8::StaticOrder<T, D, 4> S; S.init(176, F.bid - 80); pg8::EpiGate<0> E{Z + ZG + 4096, MRG};
                  pg8::gemm_phase(F.lds, g, S, E, F.tid); }
            }
        }
        GRID_BAR();
        if (IN(pb + 2)) {
            LAYER_CTX
            const int xb_ = 8192 * (F.bid & 7) + (F.bid >> 3) * 8 + F.wave;
            for (int it0 = 0; it0 < 32; it0 += 4) {
                u32x4 hw[4], ow[4]; float g0_[4], g1_[4], g2_[4], dnr[4]; f32x4 ga[4], gb[4];
#pragma unroll
                for (int q = 0; q < 4; ++q) { const int it = xb_ + 256 * (it0 + q); const size_t r = (size_t)(it >> 2); const int hq = it & 3; const int c0 = hq * 512 + 8 * F.lane;
                    hw[q] = *(const u32x4*)(HRAW + r * 2048 + c0); ow[q] = *(const u32x4*)(Z + r * ZW + ZO + c0);
                    const int bh = (int)(r >> 12) * 4 + hq, tp = (int)(r & 4095), pos = bh * 4096 + tp;
                    g0_[q] = GS[GS_BCUM + pos]; g1_[q] = GS[GS_PMAX + pos]; g2_[q] = GS[GS_MPREV + bh * 64 + (tp >> 6)]; dnr[q] = DEN[r * 4 + hq];
                    ga[q] = *(const f32x4*)(PAR + PAR_MNG + l * 2048 + c0); gb[q] = *(const f32x4*)(PAR + PAR_MNG + l * 2048 + c0 + 4); }
#pragma unroll
                for (int q = 0; q < 4; ++q) { const int it = xb_ + 256 * (it0 + q); const size_t r = (size_t)(it >> 2); const int hq = it & 3; const int c0 = hq * 512 + 8 * F.lane;
                    f32x4 a = (f32x4){bflo(hw[q].x), bfhi(hw[q].x), bflo(hw[q].y), bfhi(hw[q].y)}, b4 = (f32x4){bflo(hw[q].z), bfhi(hw[q].z), bflo(hw[q].w), bfhi(hw[q].w)};
                    { const float mrow = g0_[q] + fmaxf(g1_[q], g2_[q]); const float dn = 1.f / fmaxf(fabsf(dnr[q]), expf(-mrow)); a = a * dn; b4 = b4 * dn; }
                    const float mean = wave_sum((a.x + a.y) + (a.z + a.w) + (b4.x + b4.y) + (b4.z + b4.w), F.lane) * (1.f / 512.f);
                    const f32x4 da = a - mean, db = b4 - mean;
                    const float var = wave_sum((da.x * da.x + da.y * da.y) + (da.z * da.z + da.w * da.w) + (db.x * db.x + db.y * db.y) + (db.z * db.z + db.w * db.w), F.lane) * (1.f / 512.f);
                    const float rstd = 1.f / sqrtf(var + LN_EPS);
                    const f32x4 ya = da * rstd * ga[q], yb = db * rstd * gb[q]; const u32x4 o4 = ow[q];
                    u32x4 w; w.x = pk2(ya.x * bflo(o4.x), ya.y * bfhi(o4.x)); w.y = pk2(ya.z * bflo(o4.y), ya.w * bfhi(o4.y)); w.z = pk2(yb.x * bflo(o4.z), yb.y * bfhi(o4.z)); w.w = pk2(yb.z * bflo(o4.w), yb.w * bfhi(o4.w));
                    *(u32x4*)(Z + r * ZW + ZO + c0) = w; }
            }
        }
        SEAM(pb + 2);
        if (IN(pb + 4)) {
            LAYER_CTX
            int og = (F.bid >> 3) & 1; asm volatile("" : "+s"(og));
            if (og == 0) {
                { pg8::GemmStd<ZW, 1024, 1024> g{Z + ZU, (const bf16_t*)(wl + WL_PA)}; pg8::StaticOrder<T, D, 4> S; S.init(F.G, F.bid); pg8::EpiGate<1> E{Z + ZG, MRG};
                  pg8::gemm_phase(F.lds, g, S, E, F.tid); }
                { pg8::GemmStd<ZW, 2048, 2048> g{Z + ZO, (const bf16_t*)(wl + WL_PB)}; pg8::StaticOrder<T, D, 4> S; S.init(F.G, F.bid); pg8::EpiGate<1> E{Z + ZG + 2048, MRG};
                  pg8::gemm_phase(F.lds, g, S, E, F.tid); }
            } else {
                { pg8::GemmStd<ZW, 2048, 2048> g{Z + ZO, (const bf16_t*)(wl + WL_PB)}; pg8::StaticOrder<T, D, 4> S; S.init(F.G, F.bid); pg8::EpiGate<1> E{Z + ZG + 2048, MRG};
                  pg8::gemm_phase(F.lds, g, S, E, F.tid); }
                { pg8::GemmStd<ZW, 1024, 1024> g{Z + ZU, (const bf16_t*)(wl + WL_PA)}; pg8::StaticOrder<T, D, 4> S; S.init(F.G, F.bid); pg8::EpiGate<1> E{Z + ZG, MRG};
                  pg8::gemm_phase(F.lds, g, S, E, F.tid); }
            }
        }
        SEAM(pb + 4);
        if (IN(pb + 5)) {
            LAYER_CTX
            pg8::GemmStd<D, D, D> g{MRG, (const bf16_t*)(wl + WL_OUT)}; pg8::StaticOrder<T, D, 4> S; S.init(F.G, F.bid);
            pg8::EpiResid E{PF, STAT, l ? PAR + PAR_LN2G + (l - 1) * D : PAR + PAR_ONE, l ? PAR + PAR_LN2B + (l - 1) * D : PAR + PAR_ZERO};
            pg8::gemm_phase(F.lds, g, S, E, F.tid);
        }
        SEAM(pb + 5);
        if (IN(pb + 6)) {
            LAYER_CTX
            { f32x4 va[8], vb[8]; const int mb_ = 2048 * (F.bid & 7) + (F.bid >> 3) * 8 + F.wave; int m = mb_; row_load(PF + (size_t)m * D, va, F.lane);
              for (int k_ = 0; k_ < 8; ++k_, m += 256) { const int mn = (k_ < 7) ? m + 256 : m; row_load(PF + (size_t)mn * D, vb, F.lane);
                  row_finish(va, true, PAR + PAR_LN1G + l * D, PAR + PAR_LN1B + l * D, nullptr, XB + (size_t)m * D, nullptr, nullptr, nullptr, F.lane, STAT + 2 * (size_t)m);
#pragma unroll
                  for (int j = 0; j < 8; ++j) va[j] = vb[j]; } }
        }
        SEAM(pb + 6);
        if (IN(pb + 7)) {
            LAYER_CTX
            pg8::GemmStd<D, D, D> g{XB, (const bf16_t*)(wl + WL_GU)}; pg8::RevOrder<T, 2 * FF, 8> S; S.init(F.G, F.bid); pg8::EpiSwiglu E{HFF};
            pg8::gemm_phase(F.lds, g, S, E, F.tid);
        }
        SEAM(pb + 7);
        if (IN(pb + 8)) {
            LAYER_CTX
            pg8::GemmStd<FF, FF, FF> g{HFF, (const bf16_t*)(wl + WL_DN)}; pg8::StaticOrder<T, D, 4> S; S.init(F.G, F.bid); pg8::EpiResid E{PF, STAT, PAR + PAR_LN1G + l * D, PAR + PAR_LN1B + l * D};
            pg8::gemm_phase(F.lds, g, S, E, F.tid);
        }
        SEAM(pb + 8);
        if (IN(pb + 9)) {
            LAYER_CTX
            const bool lastl = (l == DEPTH - 1);
            if (!lastl) load_gate_w(F, WG + (size_t)(l + 1) * 8 * D);
            { f32x4 va[8], vb[8]; const int mb_ = 2048 * (F.bid & 7) + (F.bid >> 3) * 8 + F.wave; int m = mb_; row_load(PF + (size_t)m * D, va, F.lane);
              for (int k_ = 0; k_ < 8; ++k_, m += 256) { const int mn = (k_ < 7) ? m + 256 : m; row_load(PF + (size_t)mn * D, vb, F.lane);
                  row_finish(va, true, PAR + PAR_LN2G + l * D, PAR + PAR_LN2B + l * D, lastl ? args.out + (size_t)m * D : nullptr, lastl ? nullptr : XB + (size_t)m * D,
                             (const LAS float*)F.lds, lastl ? nullptr : PAR + PAR_GBIAS + (l + 1) * 8, lastl ? nullptr : GATES + (size_t)m * 8, F.lane, STAT + 2 * (size_t)m);
#pragma unroll
                  for (int j = 0; j < 8; ++j) va[j] = vb[j]; } }
            __syncthreads();
        }
        if (lyr != DEPTH - 1) GRID_BAR();
    }
#undef IN
#undef SEAM
#undef GRID_BAR
#undef PHASE_CTX
#undef LAYER_CTX
#undef WG
#undef BIN
#undef GATES
#undef STAT
#undef MEMN
#undef KMEM
#undef VMEM
#undef WQK
#undef WQN
#undef BQK
#undef WKT
#undef WVT
#undef PAR
#undef XF
#undef PF
#undef XB
#undef Z
#undef HFF
#undef MRG
#undef HRAW
#undef QF
#undef KF
#undef PFR
#undef VF
#undef GS
#undef DEN
#undef VSTAT
#undef WIG
#undef WF32
#undef C2A
}

extern "C" void kernel_launch(void* const* d_in, const int* in_sizes, int n_in, void* d_out, int out_size, void* d_ws, size_t ws_size, hipStream_t stream) {
    static int grid = 0;
    if (grid == 0) {
        if (n_in != 24 || out_size != T * D || ws_size < WS_END) { fprintf(stderr, "kernel_launch: unexpected shapes (n_in %d, out %d, ws %zu < %zu)\n", n_in, out_size, ws_size, (size_t)WS_END); grid = -1; return; }
        int dev = 0, cus = 0, per_cu = 0;
        if (hipGetDevice(&dev) != hipSuccess || hipDeviceGetAttribute(&cus, hipDeviceAttributeMultiprocessorCount, dev) != hipSuccess) { grid = -1; return; }
        if (hipFuncSetAttribute((const void*)fwd_kernel, hipFuncAttributeMaxDynamicSharedMemorySize, LDS_BYTES) != hipSuccess) { fprintf(stderr, "kernel_launch: hipFuncSetAttribute failed\n"); grid = -1; return; }
        if (hipOccupancyMaxActiveBlocksPerMultiprocessor(&per_cu, (const void*)fwd_kernel, 512, LDS_BYTES) != hipSuccess || per_cu < 1) fprintf(stderr, "kernel_launch: occupancy query says %d\n", per_cu);
        (void)hipGetLastError();
        grid = cus;
    }
    if (grid < 0) return;
    (void)hipMemsetAsync((char*)d_ws + WS_CTL, 0, CTL_ZERO_BYTES, stream);
    Args a{};
    for (int i = 0; i < 24; ++i) a.in[i] = (const float*)d_in[i];
    a.out = (float*)d_out; a.ws = (unsigned char*)d_ws;
    constexpr int NPH = 2 + 10 * DEPTH;
#if MK_PER_PHASE
    for (int p = 0; p < NPH; ++p) { a.ph_lo = p; a.ph_hi = p + 1; hipLaunchKernelGGL(fwd_kernel, dim3(grid), dim3(512), LDS_BYTES, stream, a); }
#else
    a.ph_lo = 0; a.ph_hi = NPH;
    hipLaunchKernelGGL(fwd_kernel, dim3(grid), dim3(512), LDS_BYTES, stream, a);
#endif
    const hipError_t le = hipPeekAtLastError();
    if (le != hipSuccess) fprintf(stderr, "kernel_launch: launch failed: %s\n", hipGetErrorName(le));
}
```
